# Optimizing an MI355X kernel written in HIP

```python
import jax, jax.numpy as jnp
from jax import lax
import numpy as np

D_MODEL = 2048
BATCH = 8
SEQ = 2048
DEPTH = 1
DEC_BATCH = 32
DEC_SEQ = 4
PAST_LEN = 8192
PAGE_SIZE = 128

A_HEADS = 16
A_HEAD_DIM = 64
A_WIDTH = A_HEADS * A_HEAD_DIM
DECAY_RANK = 64
ICLR_RANK = 64
A_COLS = 4 * A_WIDTH + DECAY_RANK + ICLR_RANK
GN_EPS = 64e-5
B_HEADS = 16
B_KV_HEADS = 4
B_GROUP = B_HEADS // B_KV_HEADS
B_HEAD_DIM = 64
B_WIDTH = B_HEADS * B_HEAD_DIM
B_KV_WIDTH = B_KV_HEADS * B_HEAD_DIM
B_COLS = 2 * B_WIDTH + 6 * B_KV_WIDTH + 3 * B_HEADS
CMP_BLOCK = 32
CMP_STRIDE = 16
SEL_BLOCK = 64
N_SELECT = 16
N_LOCAL = 2
WINDOW = 512
Q_BLOCK = 128
SEL_Q_BLOCK = 16
FORCED_SCORE = 1e4
ATTN_SCALE = B_HEAD_DIM ** -0.5
IN_COLS = A_COLS + B_COLS + 2 * D_MODEL
RMS_EPS = 1e-6
NEG = -1e30

kernel_name = 'hybrid_rwkv7_nsa_step'


def rms_norm(x, g):
    xf = x.astype(jnp.float32)
    y = xf * lax.rsqrt(jnp.mean(xf * xf, axis=-1, keepdims=True) + RMS_EPS)
    return (y * g.astype(jnp.float32)).astype(x.dtype)


def masked_softmax(s, mask):
    s = jnp.where(mask, s, NEG)
    m = jnp.max(s, axis=-1, keepdims=True)
    p = jnp.where(mask, jnp.exp(s - m), 0.0)
    return p / jnp.maximum(jnp.sum(p, axis=-1, keepdims=True), 1e-30)


def alibi_slopes():
    h = jnp.arange(1, B_HEADS + 1, dtype=jnp.float32)
    return jnp.exp2(-8.0 * h / B_HEADS).reshape(B_KV_HEADS, B_GROUP)


def rwkv7_mixer(u, u_prev0, S0, mu_shift, w0, w_up, a0, a_up, k_k, k_a, r_k, gn_w, gn_b):
    f32 = jnp.float32
    B, T, _ = u.shape
    H, N = A_HEADS, A_HEAD_DIM
    u_prev = jnp.concatenate([u_prev0[:, None].astype(u.dtype), u[:, :-1]], axis=1)
    us = u + mu_shift * (u_prev - u)
    r, k, v, g, wd, ad = jnp.split(us, [A_WIDTH, 2 * A_WIDTH, 3 * A_WIDTH, 4 * A_WIDTH,
                                        4 * A_WIDTH + DECAY_RANK], axis=-1)
    w_log = -jax.nn.softplus(-(w0 + jnp.tanh(wd) @ w_up).astype(f32)) - 0.5
    decay = jnp.exp(-jnp.exp(w_log))
    a = jax.nn.sigmoid((a0 + ad @ a_up).astype(f32))
    r, k, v = r.astype(f32), k.astype(f32), v.astype(f32)
    kk = (k * k_k).reshape(B, T, H, N)
    kk = kk * lax.rsqrt(jnp.maximum(jnp.sum(kk * kk, axis=-1, keepdims=True), 1e-24))
    k = k * (1.0 + (a - 1.0) * k_a)
    r, k, v, a, decay = (t.reshape(B, T, H, N) for t in (r, k, v, a, decay))

    def step(S, inp):
        r_t, k_t, v_t, kk_t, a_t, w_t = inp
        sa = jnp.einsum('bhij,bhj->bhi', S, kk_t)
        S = (S * w_t[:, :, None, :] - sa[..., None] * (kk_t * a_t)[:, :, None, :]
             + v_t[..., None] * k_t[:, :, None, :])
        return S, jnp.einsum('bhij,bhj->bhi', S, r_t)

    xs = tuple(jnp.moveaxis(t, 1, 0) for t in (r, k, v, kk, a, decay))
    S, o = lax.scan(step, S0.astype(f32), xs)
    o = jnp.moveaxis(o, 0, 1)
    mean = jnp.mean(o, axis=-1, keepdims=True)
    var = jnp.mean(jnp.square(o - mean), axis=-1, keepdims=True)
    o = (o - mean) * lax.rsqrt(var + GN_EPS) * gn_w.reshape(H, N) + gn_b.reshape(H, N)
    o = o + jnp.sum(r * k * r_k, axis=-1, keepdims=True) * v
    o = o.reshape(B, T, A_WIDTH) * jax.nn.silu(g.astype(f32))
    return o.astype(u.dtype), S.astype(u.dtype), u[:, -1]


def compress_blocks(rows, pos_w, w_c):
    B, L, G, D = rows.shape
    ratio = CMP_BLOCK // CMP_STRIDE
    n_ch = L // CMP_STRIDE
    n_cmp = n_ch - ratio + 1
    chunks = rows[:, :n_ch * CMP_STRIDE].reshape(B, n_ch, CMP_STRIDE, G, D)
    pw = pos_w.reshape(ratio, CMP_STRIDE, D)
    pooled = jnp.einsum('bnsgd,sd->bngd', chunks[:, :n_cmp], pw[0])
    for i in range(1, ratio):
        pooled = pooled + jnp.einsum('bnsgd,sd->bngd', chunks[:, i:i + n_cmp], pw[i])
    return jnp.einsum('bngd,de->bnge', pooled, w_c)


def compressed_attention(q, kv, t_pos, slopes, cmp_pos_k, cmp_pos_v, w_cmp_k, w_cmp_v):
    f32 = jnp.float32
    kc = compress_blocks(kv[:, :, 0], cmp_pos_k, w_cmp_k)
    vc = compress_blocks(kv[:, :, 1], cmp_pos_v, w_cmp_v)
    n_cmp = kc.shape[1]
    blk_end = jnp.arange(n_cmp) * CMP_STRIDE + (CMP_BLOCK - 1)
    dist = t_pos[:, None] - blk_end[None, :]
    s = jnp.einsum('btgrd,bngd->btgrn', q, kc, preferred_element_type=f32) * ATTN_SCALE
    s = s - slopes[None, None, :, :, None] * dist[None, :, None, None, :]
    p = masked_softmax(s, (dist >= 0)[None, :, None, None, :])
    o = jnp.einsum('btgrn,bngd->btgrd', p, vc.astype(f32))
    return o, p


def select_blocks(p_cmp, t_pos, L):
    f32 = jnp.float32
    n_cmp = p_cmp.shape[-1]
    n_sel = -(-L // SEL_BLOCK)
    cs = jnp.arange(n_cmp) * CMP_STRIDE
    ss = jnp.arange(n_sel) * SEL_BLOCK
    overlap = jnp.clip(jnp.minimum(cs[:, None] + CMP_BLOCK, ss[None, :] + SEL_BLOCK)
                       - jnp.maximum(cs[:, None], ss[None, :]), 0, None).astype(f32) / CMP_BLOCK
    imp = jnp.einsum('btgrn,nj->btgj', p_cmp, overlap)
    j = jnp.arange(n_sel)
    back = (t_pos // SEL_BLOCK)[:, None] - j[None, :]
    forced = (j[None, :] == 0) | ((back >= 0) & (back < N_LOCAL))
    score = jnp.where(forced[None, :, None], FORCED_SCORE,
                      jnp.where((back >= 0)[None, :, None], imp, -1.0))
    top_s, top_i = lax.top_k(score, min(N_SELECT, n_sel))
    return top_i, top_s >= 0


def selected_attention(q, kv, top_i, top_ok, t_pos, slopes):
    f32 = jnp.float32
    B, T, G, R, D = q.shape
    L = kv.shape[1]
    n_sel = -(-L // SEL_BLOCK)
    kv = jnp.pad(kv, ((0, 0), (0, n_sel * SEL_BLOCK - L), (0, 0), (0, 0), (0, 0)))
    blocks = kv.reshape(B, n_sel, SEL_BLOCK, 2, G, D).transpose(0, 4, 1, 2, 3, 5)
    qb = SEL_Q_BLOCK if T % SEL_Q_BLOCK == 0 else T
    nqb = T // qb
    b_idx = jnp.arange(B)[:, None, None, None]
    g_idx = jnp.arange(G)[None, None, :, None]
    offs = jnp.arange(SEL_BLOCK)

    def to_blocks(a):
        return jnp.moveaxis(a.reshape((B, nqb, qb) + a.shape[2:]), 1, 0)

    def one_block(args):
        q_b, i_b, ok_b, pos_b = args
        nk = i_b.shape[-1] * SEL_BLOCK
        kvg = blocks[b_idx, g_idx, i_b]
        k_pos = i_b[..., None] * SEL_BLOCK + offs
        dist = (pos_b[None, :, None, None, None] - k_pos).reshape(B, qb, G, 1, nk)
        mask = (dist >= 0) & ok_b[..., None].repeat(SEL_BLOCK, axis=-1).reshape(B, qb, G, 1, nk)
        kg = kvg[..., 0, :].reshape(B, qb, G, nk, D)
        vg = kvg[..., 1, :].reshape(B, qb, G, nk, D)
        s = jnp.einsum('bqgrd,bqgnd->bqgrn', q_b, kg, preferred_element_type=f32) * ATTN_SCALE
        s = s - slopes[None, None, :, :, None] * dist
        p = masked_softmax(s, mask)
        return jnp.einsum('bqgrn,bqgnd->bqgrd', p, vg.astype(f32))

    o = lax.map(one_block, (to_blocks(q), to_blocks(top_i), to_blocks(top_ok), t_pos.reshape(nqb, qb)))
    return jnp.moveaxis(o, 0, 1).reshape(B, T, G, R, D)


def window_attention(q, kv, q_pos0, slopes):
    f32 = jnp.float32
    B, T, G, R, D = q.shape
    Lw = kv.shape[1]
    qb = Q_BLOCK if T % Q_BLOCK == 0 else T
    nqb = T // qb
    band = WINDOW + qb
    kvp = jnp.pad(kv, ((0, 0), (WINDOW, 0), (0, 0), (0, 0), (0, 0)))
    k_pos0 = q_pos0 + T - Lw
    q_blocks = jnp.moveaxis(q.reshape(B, nqb, qb, G, R, D), 1, 0)

    def one_block(args):
        i, q_b = args
        start = Lw - T + i * qb
        kv_b = lax.dynamic_slice_in_dim(kvp, start, band, axis=1)
        k_pos = k_pos0 - WINDOW + start + jnp.arange(band)
        q_pos = q_pos0 + i * qb + jnp.arange(qb)
        dist = q_pos[:, None] - k_pos[None, :]
        mask = (dist >= 0) & (dist <= WINDOW) & (k_pos >= k_pos0)[None, :]
        s = jnp.einsum('bqgrd,bkgd->bqgrk', q_b, kv_b[:, :, 0], preferred_element_type=f32) * ATTN_SCALE
        s = s - slopes[None, None, :, :, None] * dist[None, :, None, None, :]
        p = masked_softmax(s, mask[None, :, None, None, :])
        return jnp.einsum('bqgrk,bkgd->bqgrd', p, kv_b[:, :, 1].astype(f32))

    o = lax.map(one_block, (jnp.arange(nqb), q_blocks))
    return jnp.moveaxis(o, 0, 1).reshape(B, T, G, R, D)


def nsa_mixer(q, gates, cmp_kv, sel_kv, win_kv, q_pos0, cmp_pos_k, cmp_pos_v, w_cmp_k, w_cmp_v):
    f32 = jnp.float32
    B, T, _ = q.shape
    q = q.reshape(B, T, B_KV_HEADS, B_GROUP, B_HEAD_DIM)
    t_pos = q_pos0 + jnp.arange(T)
    slopes = alibi_slopes()
    o_cmp, p_cmp = compressed_attention(q, cmp_kv, t_pos, slopes, cmp_pos_k, cmp_pos_v, w_cmp_k, w_cmp_v)
    top_i, top_ok = select_blocks(p_cmp, t_pos, sel_kv.shape[1])
    o_sel = selected_attention(q, sel_kv, top_i, top_ok, t_pos, slopes)
    o_win = window_attention(q, win_kv, q_pos0, slopes)
    g = jax.nn.sigmoid(gates.astype(f32)).reshape(B, T, 3, B_KV_HEADS, B_GROUP, 1)
    o = g[:, :, 0] * o_cmp + g[:, :, 1] * o_sel + g[:, :, 2] * o_win
    return o.reshape(B, T, B_WIDTH)


def hybrid_layer(x, u_prev0, S0, cmp_past, sel_past, win_buf, q_pos0, win_keep,
                 norm_in, w_in, mu_shift, w0, w_up, a0, a_up, k_k, k_a, r_k, gn_w, gn_b,
                 cmp_pos_k, cmp_pos_v, w_cmp_k, w_cmp_v, w_pa, w_pb, w_o):
    f32 = jnp.float32
    B, T, _ = x.shape
    xn = rms_norm(x, norm_in)
    u = jnp.einsum('btd,dc->btc', xn, w_in)
    u_a, u_b, u_m = jnp.split(u, [A_COLS, A_COLS + B_COLS], axis=-1)
    o_a, S_new, shift_new = rwkv7_mixer(u_a, u_prev0, S0, mu_shift, w0, w_up, a0, a_up,
                                        k_k, k_a, r_k, gn_w, gn_b)
    q, g_b, kv_c, kv_s, kv_w, nsa_gates = jnp.split(
        u_b, [B_WIDTH, 2 * B_WIDTH, 2 * B_WIDTH + 2 * B_KV_WIDTH,
              2 * B_WIDTH + 4 * B_KV_WIDTH, 2 * B_WIDTH + 6 * B_KV_WIDTH], axis=-1)
    new_c = kv_c.reshape(B, T, 2, B_KV_HEADS, B_HEAD_DIM)
    new_s = kv_s.reshape(B, T, 2, B_KV_HEADS, B_HEAD_DIM)
    new_w = kv_w.reshape(B, T, 2, B_KV_HEADS, B_HEAD_DIM)
    cmp_all = jnp.concatenate([cmp_past.astype(x.dtype), new_c], axis=1)
    sel_all = jnp.concatenate([sel_past.astype(x.dtype), new_s], axis=1)
    win_all = jnp.concatenate([win_buf.astype(x.dtype), new_w], axis=1)
    o_b = nsa_mixer(q, nsa_gates, cmp_all, sel_all, win_all, q_pos0, cmp_pos_k, cmp_pos_v, w_cmp_k, w_cmp_v)
    o_b = (o_b * jax.nn.silu(g_b.astype(f32))).astype(x.dtype)
    gate_a, gate_b = jnp.split(jax.nn.sigmoid(u_m.astype(f32)), 2, axis=-1)
    merged = gate_a * (o_a @ w_pa) + gate_b * (o_b @ w_pb)
    h = x + merged.astype(x.dtype) @ w_o
    return h, new_c, new_s, win_all[:, win_all.shape[1] - win_keep:], S_new, shift_new


def setup_inputs(seed: int = 0) -> dict:
    key = jax.random.key(seed)
    ks = jax.random.split(key, 32)
    f32 = jnp.float32

    def nrm(k, shape, scale):
        return scale * jax.random.normal(k, shape, f32)

    n_pages = PAST_LEN // PAGE_SIZE
    n_used = DEC_BATCH * n_pages
    n_pool = n_used + n_used // 4
    win_keep = min(WINDOW, PAST_LEN)
    L = DEPTH
    kvs = (2, B_KV_HEADS, B_HEAD_DIM)
    return {
        'x_prompt': nrm(ks[0], (BATCH, SEQ, D_MODEL), 1.0),
        'x_sample': nrm(ks[1], (DEC_BATCH, DEC_SEQ, D_MODEL), 1.0),
        'cache_cmp_kv': nrm(ks[2], (L, n_pool, PAGE_SIZE) + kvs, 1.0),
        'cache_sel_kv': nrm(ks[3], (L, n_pool, PAGE_SIZE) + kvs, 1.0),
        'cache_win_kv': nrm(ks[4], (L, DEC_BATCH, win_keep) + kvs, 1.0),
        'state_rwkv': nrm(ks[5], (L, DEC_BATCH, A_HEADS, A_HEAD_DIM, A_HEAD_DIM), 0.5),
        'state_shift': nrm(ks[6], (L, DEC_BATCH, A_COLS), 1.0),
        'page_table': jax.random.permutation(ks[7], n_pool)[:n_used].reshape(DEC_BATCH, n_pages).astype(jnp.int32),
        'norm_in': 1.0 + nrm(ks[8], (L, D_MODEL), 0.05),
        'w_in': nrm(ks[9], (L, D_MODEL, IN_COLS), D_MODEL ** -0.5),
        'mu_shift': jax.random.uniform(ks[10], (L, A_COLS), f32, 0.1, 0.9),
        'w0': jax.random.uniform(ks[11], (L, A_WIDTH), f32, -6.0, -1.0),
        'w_up': nrm(ks[12], (L, DECAY_RANK, A_WIDTH), 0.1 * DECAY_RANK ** -0.5),
        'a0': nrm(ks[13], (L, A_WIDTH), 0.5),
        'a_up': nrm(ks[14], (L, ICLR_RANK, A_WIDTH), ICLR_RANK ** -0.5),
        'k_k': 0.85 + nrm(ks[15], (L, A_WIDTH), 0.05),
        'k_a': 1.0 + nrm(ks[16], (L, A_WIDTH), 0.05),
        'r_k': nrm(ks[17], (L, A_HEADS, A_HEAD_DIM), 0.1),
        'gn_w': 1.0 + nrm(ks[18], (L, A_WIDTH), 0.05),
        'gn_b': nrm(ks[19], (L, A_WIDTH), 0.02),
        'cmp_pos_k': (1.0 + nrm(ks[20], (L, CMP_BLOCK, B_HEAD_DIM), 0.1)) * CMP_BLOCK ** -0.5,
        'cmp_pos_v': (1.0 + nrm(ks[21], (L, CMP_BLOCK, B_HEAD_DIM), 0.1)) * CMP_BLOCK ** -0.5,
        'w_cmp_k': nrm(ks[22], (L, B_HEAD_DIM, B_HEAD_DIM), B_HEAD_DIM ** -0.5),
        'w_cmp_v': nrm(ks[23], (L, B_HEAD_DIM, B_HEAD_DIM), B_HEAD_DIM ** -0.5),
        'w_pa': nrm(ks[24], (L, A_WIDTH, D_MODEL), A_WIDTH ** -0.5),
        'w_pb': nrm(ks[25], (L, B_WIDTH, D_MODEL), B_WIDTH ** -0.5),
        'w_o': nrm(ks[26], (L, D_MODEL, D_MODEL), D_MODEL ** -0.5),
        'norm_out': 1.0 + nrm(ks[27], (D_MODEL,), 0.05),
    }


def reference(x_prompt, x_sample, cache_cmp_kv, cache_sel_kv, cache_win_kv, state_rwkv, state_shift,
              page_table, norm_in, w_in, mu_shift, w0, w_up, a0, a_up, k_k, k_a, r_k, gn_w, gn_b,
              cmp_pos_k, cmp_pos_v, w_cmp_k, w_cmp_v, w_pa, w_pb, w_o, norm_out):
    f32 = jnp.float32
    B, T, _ = x_prompt.shape
    DB = x_sample.shape[0]
    n_pages = page_table.shape[1]
    past_len = n_pages * PAGE_SIZE
    dt = x_prompt.dtype
    empty = jnp.zeros((B, 0, 2, B_KV_HEADS, B_HEAD_DIM), dt)
    h_p, h_s = x_prompt, x_sample
    outs_p = [[] for _ in range(5)]
    outs_s = [[] for _ in range(5)]
    for l in range(DEPTH):
        lw = (norm_in[l], w_in[l], mu_shift[l], w0[l], w_up[l], a0[l], a_up[l], k_k[l], k_a[l], r_k[l],
              gn_w[l], gn_b[l], cmp_pos_k[l], cmp_pos_v[l], w_cmp_k[l], w_cmp_v[l], w_pa[l], w_pb[l], w_o[l])
        res_p = hybrid_layer(h_p, jnp.zeros((B, A_COLS), dt),
                             jnp.zeros((B, A_HEADS, A_HEAD_DIM, A_HEAD_DIM), f32),
                             empty, empty, empty, 0, min(WINDOW, T), *lw)
        h_p = res_p[0]
        for acc, val in zip(outs_p, res_p[1:]):
            acc.append(val)
        past_c = cache_cmp_kv[l][page_table].reshape(DB, past_len, 2, B_KV_HEADS, B_HEAD_DIM)
        past_s = cache_sel_kv[l][page_table].reshape(DB, past_len, 2, B_KV_HEADS, B_HEAD_DIM)
        res_s = hybrid_layer(h_s, state_shift[l], state_rwkv[l], past_c, past_s, cache_win_kv[l],
                             past_len, cache_win_kv.shape[2], *lw)
        h_s = res_s[0]
        for acc, val in zip(outs_s, res_s[1:]):
            acc.append(val)
    y_prompt = rms_norm(h_p, norm_out)
    y_sample = rms_norm(h_s, norm_out)
    return (y_prompt, y_sample,
            jnp.stack(outs_p[0]), jnp.stack(outs_p[1]), jnp.stack(outs_p[2]), jnp.stack(outs_p[3]), jnp.stack(outs_p[4]),
            jnp.stack(outs_s[0]), jnp.stack(outs_s[1]), jnp.stack(outs_s[2]), jnp.stack(outs_s[3]), jnp.stack(outs_s[4]))
```

```cpp
#include <hip/hip_runtime.h>
#include <stdint.h>
#include <stdio.h>

#define LAS __attribute__((address_space(3)))
typedef unsigned short bf16;
typedef float f32x4 __attribute__((ext_vector_type(4)));
typedef unsigned u32x4 __attribute__((ext_vector_type(4)));
typedef unsigned u32x2 __attribute__((ext_vector_type(2)));

constexpr int D = 2048, BATCH = 8, SEQ = 2048, DB = 32, DS = 4, PAST = 8192, PAGE = 128, NPAGES = PAST / PAGE;
constexpr int MP = BATCH * SEQ, MS = DB * DS, MT = MP + MS, MPAD = 16640;
constexpr int AH = 16, AN = 64, AW = 1024, ACOLS = 4224;
constexpr int NIN = 12032, IN_COLS = 11952, UA_LD = 4352;
constexpr int WINDOW = 512;
constexpr float RMS_EPS = 1e-6f, GN_EPS = 64e-5f, ATTN_SCALE = 0.125f;
constexpr int NCMP_P = 127, NCMP_S = 511, NCB_P = 128, NCB_S = 512;
constexpr int NSEL_P = 32, NSEL_S = 129;
constexpr int LDS_BYTES = 147456;

constexpr size_t O_YP = 0, O_YS = O_YP + (size_t)MP * D, O_PCMP = O_YS + (size_t)MS * D, O_PSEL = O_PCMP + (size_t)MP * 512, O_PWIN = O_PSEL + (size_t)MP * 512,
                 O_PRWKV = O_PWIN + (size_t)BATCH * 512 * 512, O_PSHIFT = O_PRWKV + (size_t)BATCH * AH * 64 * 64, O_SCMP = O_PSHIFT + (size_t)BATCH * ACOLS,
                 O_SSEL = O_SCMP + (size_t)MS * 512, O_SWIN = O_SSEL + (size_t)MS * 512, O_SRWKV = O_SWIN + (size_t)DB * 512 * 512, O_SSHIFT = O_SRWKV + (size_t)DB * AH * 64 * 64,
                 O_END = O_SSHIFT + (size_t)DB * ACOLS;
static_assert(O_END == 64001024, "output size");

constexpr size_t al256(size_t x) { return (x + 255) & ~(size_t)255; }
constexpr size_t WS_CTL = 0, CTL_BYTES = 65536;
constexpr size_t WS_WIN_T = WS_CTL + CTL_BYTES;
constexpr size_t WS_WPAB_T = al256(WS_WIN_T + (size_t)NIN * D * 2);
constexpr size_t WS_WO_T = al256(WS_WPAB_T + (size_t)4096 * 1024 * 2);
constexpr size_t WS_XN = al256(WS_WO_T + (size_t)D * D * 2);
constexpr size_t WS_UA = al256(WS_XN + (size_t)MPAD * D * 2);
constexpr size_t WS_QG = al256(WS_UA + (size_t)MPAD * UA_LD * 2);
constexpr size_t WS_KVW = al256(WS_QG + (size_t)MPAD * 2048 * 2);
constexpr size_t WS_GATES = al256(WS_KVW + (size_t)MPAD * 512 * 4);
constexpr size_t WS_PREP = al256(WS_GATES + (size_t)MPAD * 4096 * 2);
constexpr size_t WS_SG = al256(WS_PREP + (size_t)MT * 16 * 384 * 4);
constexpr size_t WS_BONUS = al256(WS_SG + (size_t)MT * 1024 * 2);
constexpr size_t WS_ORAW = al256(WS_BONUS + (size_t)MT * 16 * 4);
constexpr size_t WS_OAB = al256(WS_ORAW + (size_t)MT * 1024 * 4);
constexpr size_t WS_MERGED = al256(WS_OAB + (size_t)2 * MPAD * 1024 * 2);
constexpr size_t WS_SUMSQ = al256(WS_MERGED + (size_t)MPAD * 2048 * 2);
constexpr size_t WS_KCP = al256(WS_SUMSQ + (size_t)MPAD * 32 * 4);
constexpr size_t WS_VCP = al256(WS_KCP + (size_t)BATCH * NCB_P * 256 * 4);
constexpr size_t WS_KCS = al256(WS_VCP + (size_t)BATCH * NCB_P * 256 * 4);
constexpr size_t WS_VCS = al256(WS_KCS + (size_t)DB * NCB_S * 256 * 4);
constexpr size_t WS_END = al256(WS_VCS + (size_t)DB * NCB_S * 256 * 4);
constexpr int CW_BAR = 0;
constexpr int CW_QUEUE = 4096;

struct Args {
    const float* in[28];
    float* out;
    unsigned char* ws;
    int ph_lo, ph_hi;
};
static_assert(sizeof(Args) == 30 * 8 + 8, "Args has no holes");

__device__ __forceinline__ float bf2f(unsigned short b) { return __uint_as_float(((unsigned)b) << 16); }
__device__ __forceinline__ unsigned short f2bf(float f) { unsigned u = __float_as_uint(f); u += 0x7FFFu + ((u >> 16) & 1u); return (unsigned short)(u >> 16); }
__device__ __forceinline__ unsigned pk2bf(float lo, float hi) { return (unsigned)f2bf(lo) | ((unsigned)f2bf(hi) << 16); }
__device__ __forceinline__ float sigmoidf_(float x) { return 1.0f / (1.0f + __expf(-x)); }
__device__ __forceinline__ float wave_sum(float v) {
#pragma unroll
    for (int o = 32; o >= 1; o >>= 1) v += __shfl_xor(v, o);
    return v;
}
__device__ __forceinline__ float wave_max(float v) {
#pragma unroll
    for (int o = 32; o >= 1; o >>= 1) v = fmaxf(v, __shfl_xor(v, o));
    return v;
}

#define XB_TMO      128
#define XB_XCNT(j)  (256  + 64 * (j))
#define XB_XSUB(j)  (1280 + 64 * (j))
#define XB_XGEN(j)  (2304 + 64 * (j))
#define XB_TOP      3328
#define XB_TOPGEN   3392
#define XCD_BAR_WORDS 3456
#define XB_SPIN_CAP (1u << 18)
#define LAS __attribute__((address_space(3)))

__device__ __forceinline__ unsigned xb_ld(unsigned* p)              { return __hip_atomic_load(p, __ATOMIC_RELAXED, __HIP_MEMORY_SCOPE_AGENT); }
__device__ __forceinline__ unsigned xb_add(unsigned* p, unsigned v) { return __hip_atomic_fetch_add(p, v, __ATOMIC_RELAXED, __HIP_MEMORY_SCOPE_AGENT); }
__device__ __forceinline__ unsigned xb_xcc_id() { return (unsigned)__builtin_amdgcn_s_getreg((3 << 11) | 20) & 0xFu; }
#define XB_SPIN(cond, bar) do { unsigned _sp = 0; while (cond) { __builtin_amdgcn_s_sleep(1); \
    if ((++_sp & 255u) == 0u) { if (xb_ld(&(bar)[XB_TMO])) break; if (_sp > XB_SPIN_CAP) { atomicAdd(&(bar)[XB_TMO], 1u); break; } } } } while (0)

struct XcdBarrier {
    unsigned* bar; unsigned x;
    volatile LAS unsigned* st;
};

__device__ __forceinline__ XcdBarrier xcd_barrier_post(unsigned* bar, volatile LAS unsigned* st) {
    XcdBarrier b; b.bar = bar; b.x = xb_xcc_id(); b.st = st;
    if (threadIdx.x == 0) (void)xb_add(&bar[XB_XCNT(b.x)], 1u);
    return b;
}
__device__ __forceinline__ void xcd_barrier_complete(unsigned* bar, unsigned x, unsigned& nloc, unsigned& nx) {
    const unsigned G = gridDim.x * gridDim.y * gridDim.z;
    unsigned sum, cnt, mine, sp = 0u;
    for (;;) {
        sum = 0u; cnt = 0u; mine = 0u;
#pragma unroll
        for (unsigned j = 0; j < 16; ++j) { const unsigned c = xb_ld(&bar[XB_XCNT(j)]); sum += c; cnt += (c > 0u) ? 1u : 0u; mine = (j == x) ? c : mine; }
        if (sum == G) break;
        __builtin_amdgcn_s_sleep(1);
        if ((++sp & 255u) == 0u) { if (xb_ld(&bar[XB_TMO])) break; if (sp > XB_SPIN_CAP) { atomicAdd(&bar[XB_TMO], 1u); break; } }
    }
    nloc = mine > 0u ? mine : 1u; nx = cnt > 0u ? cnt : 1u;
}

__device__ __forceinline__ void xcd_barrier(const XcdBarrier& b) {
    asm volatile("s_waitcnt vmcnt(0)" ::: "memory");
    __syncthreads();
    if (threadIdx.x == 0) {
        unsigned* bar = b.bar;
        __builtin_amdgcn_s_waitcnt(0);
        unsigned nloc = b.st[0], nx = b.st[1];
        if (nloc == 0u) { xcd_barrier_complete(bar, b.x, nloc, nx); b.st[0] = nloc; b.st[1] = nx; }
        const unsigned old = xb_add(&bar[XB_XSUB(b.x)], 1u);
        const unsigned gen = old / nloc;
        if (old + 1u == (gen + 1u) * nloc) {
            __builtin_amdgcn_fence(__ATOMIC_RELEASE, "agent");
            asm volatile("s_waitcnt vmcnt(0)" ::: "memory");
            const unsigned og = xb_add(&bar[XB_TOP], 1u);
            const unsigned tg = og / nx;
            if (og + 1u == (tg + 1u) * nx) xb_add(&bar[XB_TOPGEN], 1u);
            else XB_SPIN(xb_ld(&bar[XB_TOPGEN]) == tg, bar);
            __builtin_amdgcn_fence(__ATOMIC_ACQUIRE, "agent");
            xb_add(&bar[XB_XGEN(b.x)], 1u);
            asm volatile("s_waitcnt vmcnt(0)" ::: "memory");
        } else {
            XB_SPIN(xb_ld(&bar[XB_XGEN(b.x)]) == gen, bar);
            __builtin_amdgcn_fence(__ATOMIC_ACQUIRE, "agent");
            asm volatile("s_waitcnt vmcnt(0)" ::: "memory");
        }
    }
    __syncthreads();
}

namespace pg8 {
#define PG8_LAS __attribute__((address_space(3)))
typedef unsigned short bf16_t;
typedef short bf16x8 __attribute__((ext_vector_type(8)));
typedef float f32x4 __attribute__((ext_vector_type(4)));
typedef unsigned u32x4 __attribute__((ext_vector_type(4)));
constexpr int BM = 256, BK = 64, HALF = 128, HTB = HALF * BK * 2  , STAGE_BYTES = 8 * HTB, NXCD = 8, WGM = 8;

__host__ __device__ __forceinline__ int lds_byte(int r, int c) { const int st = (r >> 4) * 2 + (c >> 5), rr = r & 15, cc = c & 31, ob = rr * 64 + cc * 2; return st * 1024 + (ob ^ (((ob >> 9) & 1) << 5)); }
__host__ __device__ __forceinline__ void stage_rc(int b, int& R, int& C) { const int st = b / 1024, sb = b % 1024, swz = sb ^ (((sb >> 9) & 1) << 5); R = (st >> 1) * 16 + swz / 64; C = (st & 1) * 32 + (swz % 64) / 2; }
__host__ __device__ __forceinline__ int perm32(int rho) { const int n = rho >> 4, i = rho & 15; return 8 * (i >> 2) + 4 * n + (i & 3); }

struct Unit { int pm, pn; };
struct Gemm { const bf16_t* A; const bf16_t* Bt; int M, N, K; };
struct StaticOrder {
    int nM, nN, nwg, G, c;
    __host__ __device__ void init(int M, int N, int G_, int c_) { nM = M / BM; nN = N / BM; nwg = nM * nN; G = G_; c = c_; }
    __host__ __device__ bool next(int i, Unit& u) const {
        const long L = (long)i * G + c; if (L >= nwg) return false;
        int wgid = (int)L; { const int q = nwg / NXCD, r = nwg % NXCD, xcd = wgid % NXCD, off = wgid / NXCD; wgid = (xcd < r ? xcd * (q + 1) : r * (q + 1) + (xcd - r) * q) + off; }
        const int nig = WGM * nN, gid = wgid / nig, fm = gid * WGM, gsz = (nM - fm) < WGM ? (nM - fm) : WGM;
        u.pm = fm + ((wgid % nig) % gsz); u.pn = (wgid % nig) / gsz; return true;
    }
    __device__ __forceinline__ void a_ready(const Unit&) const {}
    __device__ __forceinline__ void done(const Unit&) const {}
};
__device__ __forceinline__ unsigned cvt_pk_bf16(float lo, float hi) { unsigned r; asm volatile("v_cvt_pk_bf16_f32 %0, %1, %2" : "=v"(r) : "v"(lo), "v"(hi)); return r; }
template <class Epi, class Sched, bool STAMP = false>
__device__ __forceinline__ void gemm_phase(PG8_LAS unsigned char* lds, const Gemm g, const Sched& S, const Epi& E, unsigned long long* stamps) {
    const int tid = threadIdx.x, wid = __builtin_amdgcn_readfirstlane(tid >> 6), lane = tid & 63, wr = wid >> 2, wc = wid & 3, fr = lane & 15, fq = lane >> 4;
    const int K = g.K, nt = K / BK;
    int ts_lo = 0, ts_hi = 0, nts = 0; const unsigned long long rt_entry = STAMP ? (unsigned long long)wall_clock64() : 0ull;
#define PG8_STAMP() do { if (STAMP && wid == 0 && nts < 64) { const unsigned long long _c = (unsigned long long)clock64(); \
        ts_lo = (lane == nts) ? (int)(unsigned)_c : ts_lo; ts_hi = (lane == nts) ? (int)(unsigned)(_c >> 32) : ts_hi; ++nts; } } while (0)
    PG8_STAMP();
    unsigned voffA[2], voffB[2];
#pragma unroll
    for (int i = 0; i < 2; ++i) { int R, C; stage_rc(tid * 16 + i * 8192, R, C); const int Rb = Epi::PERM ? ((R & ~31) + perm32(R & 31)) : R;
        voffA[i] = (unsigned)(R * K + C) * 2u; voffB[i] = (unsigned)(Rb * K + C) * 2u; }
    const size_t kstep = (size_t)(BK * 2);
    const size_t hstep = (size_t)HALF * K * 2;
    const size_t tstep = 2 * hstep;
    const unsigned ldsw = (unsigned)wid * 1024u;
    const int aoff = lds_byte(wr * 64 + fr, fq * 8), boff = lds_byte(wc * 32 + fr, fq * 8);
#define PG8_SA(b, h) (((b) * 2 + (h)) * HTB)
#define PG8_SB(b, h) ((4 + (b) * 2 + (h)) * HTB)
#define PG8_STAGE(bufoff, gbase, voff) do { _Pragma("unroll") for (int _i = 0; _i < 2; ++_i) \
        __builtin_amdgcn_global_load_lds((const unsigned*)((const char*)(gbase) + (voff)[_i]), (PG8_LAS unsigned*)(lds + (bufoff) + ldsw + _i * 8192), 16, 0, 0); } while (0)
#define PG8_LDA(dst, b, h) do { _Pragma("unroll") for (int m = 0; m < 4; ++m) _Pragma("unroll") for (int k = 0; k < 2; ++k) dst[m][k] = *(const PG8_LAS bf16x8*)(lds + PG8_SA(b, h) + aoff + m * 2048 + k * 1024); } while (0)
#define PG8_LDB(dst, b, h) do { _Pragma("unroll") for (int n = 0; n < 2; ++n) _Pragma("unroll") for (int k = 0; k < 2; ++k) dst[n][k] = *(const PG8_LAS bf16x8*)(lds + PG8_SB(b, h) + boff + n * 2048 + k * 1024); } while (0)
#define PG8_MMA(ai, bj, At, Bt) do { __builtin_amdgcn_s_setprio(1); _Pragma("unroll") for (int m = 0; m < 4; ++m) _Pragma("unroll") for (int n = 0; n < 2; ++n) _Pragma("unroll") for (int k = 0; k < 2; ++k) \
        acc[ai][bj][m][n] = __builtin_amdgcn_mfma_f32_16x16x32_bf16(Bt[n][k], At[m][k], acc[ai][bj][m][n], 0, 0, 0); __builtin_amdgcn_s_setprio(0); } while (0)
#define PG8_WAIT_V(n) asm volatile("s_waitcnt vmcnt(" #n ")" ::: "memory")
#define PG8_WAIT_L(n) asm volatile("s_waitcnt lgkmcnt(" #n ")" ::: "memory")
#define PG8_BAR __builtin_amdgcn_s_barrier()
#define PG8_SCHED __builtin_amdgcn_sched_barrier(0)
    Unit cur, nxt; int ui = 0;
    if (!S.next(0, cur)) return;
    f32x4 acc[2][2][4][2];
#pragma unroll
    for (int a = 0; a < 2; ++a)
#pragma unroll
        for (int b = 0; b < 2; ++b)
#pragma unroll
            for (int m = 0; m < 4; ++m)
#pragma unroll
                for (int n = 0; n < 2; ++n) acc[a][b][m][n] = (f32x4){0.f, 0.f, 0.f, 0.f};
    bf16x8 At[4][2], B0[2][2], B1[2][2];
    const char* cA = (const char*)g.A + (size_t)cur.pm * tstep; const char* cB = (const char*)g.Bt + (size_t)cur.pn * tstep;
    S.a_ready(cur);
    PG8_STAGE(PG8_SB(0, 0), cB, voffB); PG8_STAGE(PG8_SA(0, 0), cA, voffA); PG8_STAGE(PG8_SB(0, 1), cB + hstep, voffB); PG8_STAGE(PG8_SA(0, 1), cA + hstep, voffA);
    if (wr == 1) PG8_BAR;
    PG8_WAIT_V(4); PG8_BAR;
    PG8_STAGE(PG8_SB(1, 0), cB + kstep, voffB); PG8_STAGE(PG8_SA(1, 0), cA + kstep, voffA); PG8_STAGE(PG8_SB(1, 1), cB + hstep + kstep, voffB);
    PG8_WAIT_V(6); PG8_BAR;
    PG8_STAMP();
    for (;;) {
        const bool has_next = S.next(ui + 1, nxt);
        const char* nA = has_next ? (const char*)g.A + (size_t)nxt.pm * tstep : cA; const char* nB = has_next ? (const char*)g.Bt + (size_t)nxt.pn * tstep : cB;
        for (int t = 0; t < nt; t += 2) {
            const bool last = (t == nt - 2);
            const char* a1 = cA + (size_t)(t + 1) * kstep;
            const char* a2 = last ? nA : cA + (size_t)(t + 2) * kstep; const char* b2 = last ? nB : cB + (size_t)(t + 2) * kstep;
            const char* a3 = a2 + kstep; const char* b3 = b2 + kstep;
            if (last && has_next) S.a_ready(nxt);
            PG8_LDB(B0, 0, 0); PG8_SCHED; PG8_LDA(At, 0, 0); PG8_STAGE(PG8_SA(1, 1), a1 + hstep, voffA);
            PG8_WAIT_L(8); PG8_BAR; PG8_WAIT_L(0); PG8_MMA(0, 0, At, B0); PG8_BAR; PG8_SCHED;
            PG8_LDB(B1, 0, 1); PG8_STAGE(PG8_SB(0, 0), b2, voffB);
            PG8_BAR; PG8_WAIT_L(0); PG8_MMA(0, 1, At, B1); PG8_BAR;
            PG8_LDA(At, 0, 1); PG8_STAGE(PG8_SA(0, 0), a2, voffA);
            PG8_BAR; PG8_WAIT_L(0); PG8_MMA(1, 0, At, B0); PG8_BAR; PG8_SCHED;
            PG8_STAGE(PG8_SB(0, 1), b2 + hstep, voffB);
            PG8_WAIT_V(6); PG8_BAR; PG8_MMA(1, 1, At, B1); PG8_BAR;
            PG8_LDB(B0, 1, 0); PG8_SCHED; PG8_LDA(At, 1, 0); PG8_STAGE(PG8_SA(0, 1), a2 + hstep, voffA);
            PG8_WAIT_L(8); PG8_BAR; PG8_WAIT_L(0); PG8_MMA(0, 0, At, B0); PG8_BAR; PG8_SCHED;
            PG8_LDB(B1, 1, 1); PG8_STAGE(PG8_SB(1, 0), b3, voffB);
            PG8_BAR; PG8_WAIT_L(0); PG8_MMA(0, 1, At, B1); PG8_BAR;
            PG8_LDA(At, 1, 1); PG8_STAGE(PG8_SA(1, 0), a3, voffA);
            PG8_BAR; PG8_WAIT_L(0); PG8_MMA(1, 0, At, B0); PG8_BAR; PG8_SCHED;
            PG8_STAGE(PG8_SB(1, 1), b3 + hstep, voffB);
            PG8_WAIT_V(6); PG8_BAR; PG8_MMA(1, 1, At, B1); PG8_BAR;
        }
        PG8_STAMP();
        if constexpr (!Epi::AFTER_DRAIN) { E(acc, cur, wr, wc, fr, fq); S.done(cur); }
        PG8_STAMP();
        if (!has_next) break;
#pragma unroll
        for (int a = 0; a < 2; ++a)
#pragma unroll
            for (int b = 0; b < 2; ++b)
#pragma unroll
                for (int m = 0; m < 4; ++m)
#pragma unroll
                    for (int n = 0; n < 2; ++n) acc[a][b][m][n] = (f32x4){0.f, 0.f, 0.f, 0.f};
        cur = nxt; cA = nA; cB = nB; ++ui;
    }
    PG8_WAIT_V(0);
    if (wr == 0) PG8_BAR;
    PG8_BAR;
    if constexpr (Epi::AFTER_DRAIN) { E.fused(acc, cur, wr, wc, fr, fq, lds, wid, lane); S.done(cur); }
    PG8_STAMP();
    if (STAMP && wid == 0) { stamps[lane] = lane < nts ? (((unsigned long long)(unsigned)ts_hi << 32) | (unsigned)ts_lo) : 0ull;
        if (lane == 62) stamps[62] = rt_entry; if (lane == 63) stamps[63] = (unsigned long long)wall_clock64(); }
#undef PG8_STAMP
#undef PG8_SA
#undef PG8_SB
#undef PG8_STAGE
#undef PG8_LDA
#undef PG8_LDB
#undef PG8_MMA
#undef PG8_WAIT_V
#undef PG8_WAIT_L
#undef PG8_BAR
#undef PG8_SCHED
}
}

__device__ __forceinline__ int win_src_col(int n) {
    if (n < 4224) return n;
    if (n < 4272) return 7808 + (n - 4224);
    if (n < 4352) return -1;
    if (n < 7936) return 4224 + (n - 4352);
    return 7856 + (n - 7936);
}
template <int MODE>
__device__ __forceinline__ void transpose_tiles(const float* __restrict__ src, int K, int ldsrc, bf16* __restrict__ dst, int N, LAS float* tile, int bid, int nb) {
    const int tid = threadIdx.x;
    const int tk = K / 64, tn = N / 64;
    for (int it = bid; it < tk * tn; it += nb) {
        const int k0 = (it % tk) * 64, n0 = (it / tk) * 64;
        {
            const int nl = tid & 63, kg = tid >> 6;
            const int n = n0 + nl; const int c = MODE == 0 ? win_src_col(n) : n;
#pragma unroll
            for (int kk = 0; kk < 8; ++kk) { const int k = kg * 8 + kk; tile[k * 65 + nl] = c >= 0 ? src[(size_t)(k0 + k) * ldsrc + c] : 0.f; }
        }
        __syncthreads();
        {
            const int nn = tid >> 3, kc = tid & 7;
            float v[8];
#pragma unroll
            for (int i = 0; i < 8; ++i) v[i] = tile[(kc * 8 + i) * 65 + nn];
            u32x4 w; w.x = pk2bf(v[0], v[1]); w.y = pk2bf(v[2], v[3]); w.z = pk2bf(v[4], v[5]); w.w = pk2bf(v[6], v[7]);
            *(u32x4*)(dst + (size_t)(n0 + nn) * K + k0 + kc * 8) = w;
        }
        __syncthreads();
    }
}

template <bool SAMPLE>
__device__ __forceinline__ void compress_item(const Args& a, int b, int n0, int cnt, LAS float* pooled  ) {
    const int col = threadIdx.x, kv = col >> 8, g = (col >> 6) & 3, e = col & 63;
    const float* pos = a.in[kv ? 21 : 20];
    const int* pt = (const int*)a.in[7];
    float pw0[16], pw1[16];
#pragma unroll
    for (int s = 0; s < 16; ++s) { pw0[s] = pos[s * 64 + e]; pw1[s] = pos[(16 + s) * 64 + e]; }
    float prevP0 = 0.f;
    for (int c = n0; c <= n0 + cnt; ++c) {
        float x[16];
        if (SAMPLE) {
            const int r0 = 16 * c;
            const float* rp = a.in[2] + ((size_t)pt[b * NPAGES + (r0 >> 7)] * PAGE + (r0 & 127)) * 512 + col;
#pragma unroll
            for (int s = 0; s < 16; ++s) x[s] = rp[(size_t)s * 512];
        } else {
            const float* rp = a.out + O_PCMP + ((size_t)b * SEQ + 16 * c) * 512 + col;
#pragma unroll
            for (int s = 0; s < 16; ++s) x[s] = rp[(size_t)s * 512];
        }
        float P0 = 0.f, P1 = 0.f;
#pragma unroll
        for (int s = 0; s < 16; ++s) { P0 += x[s] * pw0[s]; P1 += x[s] * pw1[s]; }
        if (c > n0) pooled[(c - 1 - n0) * 512 + col] = prevP0 + P1;
        prevP0 = P0;
    }
    __syncthreads();
    const float* wc = a.in[kv ? 23 : 22];
    float wcol[64];
#pragma unroll
    for (int d = 0; d < 64; ++d) wcol[d] = wc[d * 64 + e];
    float* dstb = (float*)(a.ws + (SAMPLE ? (kv ? WS_VCS : WS_KCS) : (kv ? WS_VCP : WS_KCP))) + (size_t)b * (SAMPLE ? NCB_S : NCB_P) * 256;
    for (int blk = 0; blk < cnt; ++blk) {
        const LAS float* pp = pooled + blk * 512 + (col & ~63);
        float acc = 0.f;
#pragma unroll
        for (int d = 0; d < 64; d += 4) { const f32x4 p4 = *(const LAS f32x4*)(pp + d); acc += p4.x * wcol[d] + p4.y * wcol[d + 1] + p4.z * wcol[d + 2] + p4.w * wcol[d + 3]; }
        dstb[((size_t)(n0 + blk) * 4 + g) * 64 + e] = acc;
    }
    __syncthreads();
}

__device__ __forceinline__ void p0_prologue(const Args& a, LAS unsigned char* lds) {
    const int tid = threadIdx.x, lane = tid & 63, wave = tid >> 6, bid = blockIdx.x, nb = gridDim.x;
    LAS float* tile = (LAS float*)lds;
    transpose_tiles<0>(a.in[9], D, IN_COLS, (bf16*)(a.ws + WS_WIN_T), NIN, tile, bid, nb);
    transpose_tiles<1>(a.in[24], 1024, D, (bf16*)(a.ws + WS_WPAB_T), D, tile, bid, nb);
    transpose_tiles<1>(a.in[25], 1024, D, (bf16*)(a.ws + WS_WPAB_T) + (size_t)D * 1024, D, tile, bid, nb);
    transpose_tiles<1>(a.in[26], D, D, (bf16*)(a.ws + WS_WO_T), D, tile, bid, nb);
    {
        bf16* XN = (bf16*)(a.ws + WS_XN);
        const float* gin = a.in[8];
        for (int r = bid * 8 + wave; r < MPAD; r += nb * 8) {
            bf16* dst = XN + (size_t)r * D;
            if (r >= MT) {
#pragma unroll
                for (int i = 0; i < 4; ++i) *(u32x4*)(dst + i * 512 + lane * 8) = (u32x4){0u, 0u, 0u, 0u};
            } else {
                const float* x = r < MP ? a.in[0] + (size_t)r * D : a.in[1] + (size_t)(r - MP) * D;
                f32x4 v[8]; float ss = 0.f;
#pragma unroll
                for (int i = 0; i < 8; ++i) { v[i] = *(const f32x4*)(x + i * 256 + lane * 4); ss += v[i].x * v[i].x + v[i].y * v[i].y + v[i].z * v[i].z + v[i].w * v[i].w; }
                ss = wave_sum(ss);
                const float rs = rsqrtf(ss * (1.0f / D) + RMS_EPS);
#pragma unroll
                for (int i = 0; i < 8; ++i) { const f32x4 gg = *(const f32x4*)(gin + i * 256 + lane * 4);
                    u32x2 w; w.x = pk2bf(v[i].x * rs * gg.x, v[i].y * rs * gg.y); w.y = pk2bf(v[i].z * rs * gg.z, v[i].w * rs * gg.w);
                    *(u32x2*)(dst + i * 256 + lane * 4) = w; }
            }
        }
    }
    {
        const f32x4* src = (const f32x4*)a.in[4]; f32x4* dst = (f32x4*)(a.out + O_SWIN);
        const size_t n4 = (size_t)DB * 508 * 128;
        for (size_t i = (size_t)bid * 512 + tid; i < n4; i += (size_t)nb * 512) { const size_t bb = i / (508 * 128), rem = i % (508 * 128); dst[bb * 512 * 128 + rem] = src[bb * 512 * 128 + 4 * 128 + rem]; }
        bf16* OAB = (bf16*)(a.ws + WS_OAB);
        for (int i = bid * 512 + tid; i < 2 * 128 * 128; i += nb * 512) { const int hf = i / (128 * 128), rem = i % (128 * 128); *(u32x4*)(OAB + ((size_t)hf * MPAD + MT) * 1024 + (size_t)rem * 8) = (u32x4){0u, 0u, 0u, 0u}; }
    }
    __syncthreads();
    for (int it = bid; it < DB * 16; it += nb) { const int b = it >> 4, n0 = (it & 15) * 32; const int cnt = (NCMP_S - n0) < 32 ? (NCMP_S - n0) : 32; compress_item<true>(a, b, n0, cnt, tile); }
}

struct EpiG1 {
    static constexpr bool PERM = true, AFTER_DRAIN = false;
    bf16* UA; bf16* QG; float* KVW; bf16* GATES; float* out;
    __device__ __forceinline__ void operator()(const pg8::f32x4 (&acc)[2][2][4][2], const pg8::Unit& u, int wr, int wc, int fr, int fq) const {
        const int pn = u.pn;
        const int row0 = u.pm * 256 + wr * 64 + fr, cl0 = wc * 32 + fq * 8;
        if (pn <= 16) {
#pragma unroll
            for (int ai = 0; ai < 2; ++ai)
#pragma unroll
                for (int m = 0; m < 4; ++m) {
                    const int row = row0 + ai * 128 + m * 16;
                    const bool lastp = row < MP && (row & (SEQ - 1)) == SEQ - 1, lasts = row >= MP && row < MT && ((row - MP) & 3) == 3;
#pragma unroll
                    for (int bj = 0; bj < 2; ++bj) {
                        const int col = pn * 256 + bj * 128 + cl0;
                        const pg8::f32x4 v0 = acc[ai][bj][m][0], v1 = acc[ai][bj][m][1];
                        u32x4 w; w.x = pg8::cvt_pk_bf16(v0[0], v0[1]); w.y = pg8::cvt_pk_bf16(v0[2], v0[3]); w.z = pg8::cvt_pk_bf16(v1[0], v1[1]); w.w = pg8::cvt_pk_bf16(v1[2], v1[3]);
                        *(u32x4*)(UA + (size_t)row * UA_LD + col) = w;
                        if ((lastp || lasts) && col < ACOLS) {
                            float* d = lastp ? out + O_PSHIFT + (size_t)(row >> 11) * ACOLS + col : out + O_SSHIFT + (size_t)((row - MP) >> 2) * ACOLS + col;
                            *(pg8::f32x4*)d = v0; *(pg8::f32x4*)(d + 4) = v1;
                        }
                    }
                }
        } else if (pn <= 24) {
#pragma unroll
            for (int ai = 0; ai < 2; ++ai)
#pragma unroll
                for (int m = 0; m < 4; ++m) {
                    const int row = row0 + ai * 128 + m * 16;
#pragma unroll
                    for (int bj = 0; bj < 2; ++bj) {
                        const int col = (pn - 17) * 256 + bj * 128 + cl0;
                        const pg8::f32x4 v0 = acc[ai][bj][m][0], v1 = acc[ai][bj][m][1];
                        u32x4 w; w.x = pg8::cvt_pk_bf16(v0[0], v0[1]); w.y = pg8::cvt_pk_bf16(v0[2], v0[3]); w.z = pg8::cvt_pk_bf16(v1[0], v1[1]); w.w = pg8::cvt_pk_bf16(v1[2], v1[3]);
                        *(u32x4*)(QG + (size_t)row * 2048 + col) = w;
                    }
                }
        } else if (pn <= 30) {
#pragma unroll
            for (int ai = 0; ai < 2; ++ai)
#pragma unroll
                for (int m = 0; m < 4; ++m) {
                    const int row = row0 + ai * 128 + m * 16;
#pragma unroll
                    for (int bj = 0; bj < 2; ++bj) {
                        const int cb = (pn - 25) * 256 + bj * 128 + cl0, which = cb >> 9, cc = cb & 511;
                        const pg8::f32x4 v0 = acc[ai][bj][m][0], v1 = acc[ai][bj][m][1];
                        float* d = nullptr;
                        if (which == 2) {
                            float* k = KVW + (size_t)row * 512 + cc; *(pg8::f32x4*)k = v0; *(pg8::f32x4*)(k + 4) = v1;
                            if (row < MP) { const int t = row & (SEQ - 1); if (t >= SEQ - 512) d = out + O_PWIN + ((size_t)(row >> 11) * 512 + (t - (SEQ - 512))) * 512 + cc; }
                            else if (row < MT) { const int si = row - MP; d = out + O_SWIN + ((size_t)(si >> 2) * 512 + 508 + (si & 3)) * 512 + cc; }
                        } else {
                            if (row < MP) d = out + (which ? O_PSEL : O_PCMP) + (size_t)row * 512 + cc;
                            else if (row < MT) d = out + (which ? O_SSEL : O_SCMP) + (size_t)(row - MP) * 512 + cc;
                        }
                        if (d) { *(pg8::f32x4*)d = v0; *(pg8::f32x4*)(d + 4) = v1; }
                    }
                }
        } else {
#pragma unroll
            for (int ai = 0; ai < 2; ++ai)
#pragma unroll
                for (int m = 0; m < 4; ++m) {
                    const int row = row0 + ai * 128 + m * 16;
#pragma unroll
                    for (int bj = 0; bj < 2; ++bj) {
                        const int col = (pn - 31) * 256 + bj * 128 + cl0;
                        const pg8::f32x4 v0 = acc[ai][bj][m][0], v1 = acc[ai][bj][m][1];
                        u32x4 w; w.x = pg8::cvt_pk_bf16(sigmoidf_(v0[0]), sigmoidf_(v0[1])); w.y = pg8::cvt_pk_bf16(sigmoidf_(v0[2]), sigmoidf_(v0[3]));
                        w.z = pg8::cvt_pk_bf16(sigmoidf_(v1[0]), sigmoidf_(v1[1])); w.w = pg8::cvt_pk_bf16(sigmoidf_(v1[2]), sigmoidf_(v1[3]));
                        *(u32x4*)(GATES + (size_t)row * 4096 + col) = w;
                    }
                }
        }
    }
};

typedef short bf16x8v __attribute__((ext_vector_type(8)));
typedef float f32x16 __attribute__((ext_vector_type(16)));

__device__ __forceinline__ void unpack8(const u32x4 w, float (&f)[8]) {
    f[0] = __uint_as_float(w.x << 16); f[1] = __uint_as_float(w.x & 0xffff0000u); f[2] = __uint_as_float(w.y << 16); f[3] = __uint_as_float(w.y & 0xffff0000u);
    f[4] = __uint_as_float(w.z << 16); f[5] = __uint_as_float(w.z & 0xffff0000u); f[6] = __uint_as_float(w.w << 16); f[7] = __uint_as_float(w.w & 0xffff0000u);
}
__device__ __forceinline__ void shifted8(const Args& a, const bf16* UA, int row, int col, float (&us)[8]) {
    float u[8], p[8];
    unpack8(*(const u32x4*)(UA + (size_t)row * UA_LD + col), u);
    bool first;
    if (row < MP) first = (row & (SEQ - 1)) == 0; else first = ((row - MP) & 3) == 0;
    if (!first) unpack8(*(const u32x4*)(UA + (size_t)(row - 1) * UA_LD + col), p);
    else if (row < MP) {
#pragma unroll
        for (int i = 0; i < 8; ++i) p[i] = 0.f;
    } else { const float* sp = a.in[6] + (size_t)((row - MP) >> 2) * ACOLS + col; const f32x4 s0 = *(const f32x4*)sp, s1 = *(const f32x4*)(sp + 4);
        p[0] = s0.x; p[1] = s0.y; p[2] = s0.z; p[3] = s0.w; p[4] = s1.x; p[5] = s1.y; p[6] = s1.z; p[7] = s1.w; }
    const float* mu = a.in[10] + col; const f32x4 m0 = *(const f32x4*)mu, m1 = *(const f32x4*)(mu + 4);
    const float mm[8] = {m0.x, m0.y, m0.z, m0.w, m1.x, m1.y, m1.z, m1.w};
#pragma unroll
    for (int i = 0; i < 8; ++i) us[i] = u[i] + mm[i] * (p[i] - u[i]);
}

__device__ __forceinline__ void prep_item(const Args& a, int tt, int h, LAS unsigned char* lds) {
    const int tid = threadIdx.x, lane = tid & 63, wave = tid >> 6;
    const bf16* UA = (const bf16*)(a.ws + WS_UA);
    LAS bf16* Am = (LAS bf16*)lds;
    LAS bf16* Bm = Am + 2 * 64 * 72;
    LAS float* Lm = (LAS float*)(lds + 2 * 2 * 64 * 72 * 2);
    const int R0 = tt * 64;
    {
        const int rl = tid >> 3, cg = tid & 7, mat = cg >> 2;
        float us[8], us2[8];
        shifted8(a, UA, R0 + rl, 4096 + cg * 16, us); shifted8(a, UA, R0 + rl, 4096 + cg * 16 + 8, us2);
        LAS bf16* d = Am + (mat * 64 + rl) * 72 + (cg & 3) * 16;
#pragma unroll
        for (int i = 0; i < 8; ++i) { d[i] = f2bf(mat ? us[i] : tanhf(us[i])); d[8 + i] = f2bf(mat ? us2[i] : tanhf(us2[i])); }
#pragma unroll
        for (int rep = 0; rep < 16; ++rep) { const int e = rep * 512 + tid, mt = e >> 12, m = (e >> 6) & 63, c = e & 63;
            Bm[(mt * 64 + c) * 72 + m] = f2bf(a.in[mt ? 14 : 12][(size_t)m * AW + h * 64 + c]); }
    }
    __syncthreads();
    {
        const int mat = wave >> 2, rt = wave & 1, ct = (wave >> 1) & 1, r = lane & 31, hh = lane >> 5;
        f32x16 acc;
#pragma unroll
        for (int i = 0; i < 16; ++i) acc[i] = 0.f;
#pragma unroll
        for (int s = 0; s < 4; ++s) {
            const bf16x8v af = *(const LAS bf16x8v*)(Am + (mat * 64 + rt * 32 + r) * 72 + s * 16 + hh * 8);
            const bf16x8v bf = *(const LAS bf16x8v*)(Bm + (mat * 64 + ct * 32 + r) * 72 + s * 16 + hh * 8);
            acc = __builtin_amdgcn_mfma_f32_32x32x16_bf16(af, bf, acc, 0, 0, 0);
        }
#pragma unroll
        for (int i = 0; i < 16; ++i) { const int tok = rt * 32 + (i & 3) + 8 * (i >> 2) + 4 * hh; Lm[(mat * 64 + tok) * 65 + ct * 32 + r] = acc[i]; }
    }
    __syncthreads();
    {
        const int rl = tid >> 3, cg = tid & 7, row = R0 + rl, ch = h * 64 + cg * 8;
        float rs[8], ks[8], vs[8], gs[8];
        shifted8(a, UA, row, ch, rs); shifted8(a, UA, row, 1024 + ch, ks); shifted8(a, UA, row, 2048 + ch, vs); shifted8(a, UA, row, 3072 + ch, gs);
        float dec[8], kk[8], bb[8], kp[8], ssq = 0.f, bon = 0.f;
#pragma unroll
        for (int i = 0; i < 8; ++i) {
            const float lw = Lm[(0 * 64 + rl) * 65 + cg * 8 + i] + a.in[11][ch + i];
            const float la = Lm[(1 * 64 + rl) * 65 + cg * 8 + i] + a.in[13][ch + i];
            const float x = -lw;
            const float sp = fmaxf(x, 0.f) + log1pf(expf(-fabsf(x)));
            dec[i] = expf(-expf(-sp - 0.5f));
            const float av = 1.0f / (1.0f + expf(-la));
            const float kkv = ks[i] * a.in[15][ch + i];
            kk[i] = kkv; ssq += kkv * kkv;
            kp[i] = ks[i] * (1.0f + (av - 1.0f) * a.in[16][ch + i]);
            bb[i] = av;
            bon += rs[i] * kp[i] * a.in[17][ch + i];
        }
        ssq += __shfl_xor(ssq, 1); ssq += __shfl_xor(ssq, 2); ssq += __shfl_xor(ssq, 4);
        bon += __shfl_xor(bon, 1); bon += __shfl_xor(bon, 2); bon += __shfl_xor(bon, 4);
        const float rn = rsqrtf(fmaxf(ssq, 1e-24f));
#pragma unroll
        for (int i = 0; i < 8; ++i) { kk[i] *= rn; bb[i] *= kk[i]; }
        if (row < MT) {
            float* P = (float*)(a.ws + WS_PREP) + ((size_t)row * 16 + h) * 384 + cg * 8;
            *(f32x4*)(P + 0) = (f32x4){dec[0], dec[1], dec[2], dec[3]}; *(f32x4*)(P + 4) = (f32x4){dec[4], dec[5], dec[6], dec[7]};
            *(f32x4*)(P + 64) = (f32x4){kk[0], kk[1], kk[2], kk[3]}; *(f32x4*)(P + 68) = (f32x4){kk[4], kk[5], kk[6], kk[7]};
            *(f32x4*)(P + 128) = (f32x4){bb[0], bb[1], bb[2], bb[3]}; *(f32x4*)(P + 132) = (f32x4){bb[4], bb[5], bb[6], bb[7]};
            *(f32x4*)(P + 192) = (f32x4){kp[0], kp[1], kp[2], kp[3]}; *(f32x4*)(P + 196) = (f32x4){kp[4], kp[5], kp[6], kp[7]};
            *(f32x4*)(P + 256) = (f32x4){rs[0], rs[1], rs[2], rs[3]}; *(f32x4*)(P + 260) = (f32x4){rs[4], rs[5], rs[6], rs[7]};
            *(f32x4*)(P + 320) = (f32x4){vs[0], vs[1], vs[2], vs[3]}; *(f32x4*)(P + 324) = (f32x4){vs[4], vs[5], vs[6], vs[7]};
            float sg[8];
#pragma unroll
            for (int i = 0; i < 8; ++i) sg[i] = gs[i] / (1.0f + expf(-gs[i]));
            u32x4 w; w.x = pk2bf(sg[0], sg[1]); w.y = pk2bf(sg[2], sg[3]); w.z = pk2bf(sg[4], sg[5]); w.w = pk2bf(sg[6], sg[7]);
            *(u32x4*)((bf16*)(a.ws + WS_SG) + (size_t)row * 1024 + ch) = w;
            if (cg == 0) ((float*)(a.ws + WS_BONUS))[(size_t)row * 16 + h] = bon;
        }
    }
    __syncthreads();
}

__device__ __forceinline__ void scan_chain(const float* __restrict__ prep  , int T, const float* __restrict__ S0, float* __restrict__ Sout,
                                           float* __restrict__ oraw  , LAS float* sab  , LAS float* ob  ) {
    const int tid = threadIdx.x, lane = tid & 63, w = __builtin_amdgcn_readfirstlane(tid >> 6);
    constexpr size_t SS = (size_t)16 * 384;
    float S[8];
#pragma unroll
    for (int j = 0; j < 8; ++j) S[j] = S0 ? S0[lane * 64 + w * 8 + j] : 0.f;
    float ring[4][6];
#pragma unroll
    for (int d = 0; d < 4; ++d)
#pragma unroll
        for (int v = 0; v < 6; ++v) ring[d][v] = d < T ? prep[(size_t)d * SS + v * 64 + lane] : 0.f;
    for (int t0 = 0; t0 < T; t0 += 4) {
#pragma unroll
        for (int d = 0; d < 4; ++d) {
            const int t = t0 + d;
            float cw[8], ckk[8], cb[8], ck[8], cr[8];
#pragma unroll
            for (int j = 0; j < 8; ++j) {
                cw[j] = __int_as_float(__builtin_amdgcn_readlane(__float_as_int(ring[d][0]), w * 8 + j));
                ckk[j] = __int_as_float(__builtin_amdgcn_readlane(__float_as_int(ring[d][1]), w * 8 + j));
                cb[j] = __int_as_float(__builtin_amdgcn_readlane(__float_as_int(ring[d][2]), w * 8 + j));
                ck[j] = __int_as_float(__builtin_amdgcn_readlane(__float_as_int(ring[d][3]), w * 8 + j));
                cr[j] = __int_as_float(__builtin_amdgcn_readlane(__float_as_int(ring[d][4]), w * 8 + j));
            }
            const float vi = ring[d][5];
            if (t + 4 < T) {
#pragma unroll
                for (int v = 0; v < 6; ++v) ring[d][v] = prep[(size_t)(t + 4) * SS + v * 64 + lane];
            }
            float sap = 0.f;
#pragma unroll
            for (int j = 0; j < 8; ++j) sap += S[j] * ckk[j];
            sab[((t & 1) * 8 + w) * 64 + lane] = sap;
            __syncthreads();
            float sa = 0.f;
#pragma unroll
            for (int ww = 0; ww < 8; ++ww) sa += sab[((t & 1) * 8 + ww) * 64 + lane];
            if (t > 0) {
                float x = ob[(((t - 1) & 1) * 8 + (lane >> 3)) * 64 + w * 8 + (lane & 7)];
                x += __shfl_xor(x, 8); x += __shfl_xor(x, 16); x += __shfl_xor(x, 32);
                if (lane < 8) oraw[(size_t)(t - 1) * 1024 + w * 8 + lane] = x;
            }
            float op = 0.f;
#pragma unroll
            for (int j = 0; j < 8; ++j) { S[j] = S[j] * cw[j] + (vi * ck[j] - sa * cb[j]); op += S[j] * cr[j]; }
            ob[((t & 1) * 8 + w) * 64 + lane] = op;
        }
    }
    __syncthreads();
    {
        float x = ob[(((T - 1) & 1) * 8 + (lane >> 3)) * 64 + w * 8 + (lane & 7)];
        x += __shfl_xor(x, 8); x += __shfl_xor(x, 16); x += __shfl_xor(x, 32);
        if (lane < 8) oraw[(size_t)(T - 1) * 1024 + w * 8 + lane] = x;
    }
    *(f32x4*)(Sout + lane * 64 + w * 8) = (f32x4){S[0], S[1], S[2], S[3]};
    *(f32x4*)(Sout + lane * 64 + w * 8 + 4) = (f32x4){S[4], S[5], S[6], S[7]};
    __syncthreads();
}

constexpr float NEGF = -1e30f;
template <bool SAMPLE>
__device__ __forceinline__ void attn_item(const Args& a, int b, int g, int tile, LAS unsigned char* lds) {
    constexpr int TT = SAMPLE ? 4 : 8, NR = TT * 4, RPW = NR / 8, NCMP = SAMPLE ? NCMP_S : NCMP_P, NCB = SAMPLE ? NCB_S : NCB_P, NCT = NCB / 64, PBLD = NCB, NSEL = SAMPLE ? NSEL_S : NSEL_P;
    const int tid = threadIdx.x, lane = tid & 63, w = __builtin_amdgcn_readfirstlane(tid >> 6);
    LAS float* qs = (LAS float*)lds;
    LAS float* Ks = qs + 64 * 64;
    LAS float* Vs = Ks + 64 * 65;
    LAS float* Pb = Vs + 64 * 64;
    LAS float* imp = Pb + 8192;
    LAS int* selb = (LAS int*)(imp + 16 * 132);
    LAS int* ulist = selb + 16 * 132;
    const bf16* QG = (const bf16*)(a.ws + WS_QG);
    const bf16* UA = (const bf16*)(a.ws + WS_UA);
    const int* pt = (const int*)a.in[7];
    const int hr = w & 3, h = g * 4 + hr;
    const float slope = exp2f(-0.5f * (float)(h + 1));
    const int t0 = SAMPLE ? PAST : tile * TT;
    const int grow0 = SAMPLE ? MP + b * 4 : b * SEQ + t0;
    __syncthreads();
    {
        const int r = tid >> 3, c8 = tid & 7;
        if (r < NR) { float q[8]; unpack8(*(const u32x4*)(QG + (size_t)(grow0 + (r >> 2)) * 2048 + (g * 4 + (r & 3)) * 64 + c8 * 8), q);
#pragma unroll
            for (int i = 0; i < 8; ++i) qs[r * 64 + c8 * 8 + i] = q[i] * ATTN_SCALE; }
    }
    float accf[RPW], m_[RPW], l_[RPW], o_[RPW];
    auto load_tile = [&](auto kptr  , auto vptr, bool wantK, bool wantV) {
        const int key = tid >> 3, c8 = tid & 7;
        if (wantK) { const float* p = kptr(key); f32x4 x0 = {0.f, 0.f, 0.f, 0.f}, x1 = x0; if (p) { x0 = *(const f32x4*)(p + c8 * 8); x1 = *(const f32x4*)(p + c8 * 8 + 4); }
            LAS float* d = Ks + key * 65 + c8 * 8; d[0] = x0.x; d[1] = x0.y; d[2] = x0.z; d[3] = x0.w; d[4] = x1.x; d[5] = x1.y; d[6] = x1.z; d[7] = x1.w; }
        if (wantV) { const float* p = vptr(key); f32x4 x0 = {0.f, 0.f, 0.f, 0.f}, x1 = x0; if (p) { x0 = *(const f32x4*)(p + c8 * 8); x1 = *(const f32x4*)(p + c8 * 8 + 4); }
            *(LAS f32x4*)(Vs + key * 64 + c8 * 8) = x0; *(LAS f32x4*)(Vs + key * 64 + c8 * 8 + 4) = x1; }
    };
    auto score_rows = [&](float (&sc)[RPW]) {
        float kreg[64];
#pragma unroll
        for (int d = 0; d < 64; ++d) kreg[d] = Ks[lane * 65 + d];
#pragma unroll
        for (int k = 0; k < RPW; ++k) { const LAS float* q = qs + (w + 8 * k) * 64; float s = 0.f;
#pragma unroll
            for (int d = 0; d < 64; d += 4) { const f32x4 q4 = *(const LAS f32x4*)(q + d); s += q4.x * kreg[d] + q4.y * kreg[d + 1] + q4.z * kreg[d + 2] + q4.w * kreg[d + 3]; }
            sc[k] = s; }
    };
    auto pv_rows = [&](const LAS float* pbase, int pld) {
#pragma unroll 4
        for (int key = 0; key < 64; key += 4) {
            const float v0 = Vs[(key + 0) * 64 + lane], v1 = Vs[(key + 1) * 64 + lane], v2 = Vs[(key + 2) * 64 + lane], v3 = Vs[(key + 3) * 64 + lane];
#pragma unroll
            for (int k = 0; k < RPW; ++k) { const f32x4 p4 = *(const LAS f32x4*)(pbase + (w + 8 * k) * pld + key); o_[k] += p4.x * v0 + p4.y * v1 + p4.z * v2 + p4.w * v3; }
        }
    };
#pragma unroll
    for (int k = 0; k < RPW; ++k) { accf[k] = 0.f; m_[k] = NEGF; l_[k] = 0.f; o_[k] = 0.f; }
    const float* KC = (const float*)(a.ws + (SAMPLE ? WS_KCS : WS_KCP)) + (size_t)b * NCB * 256 + g * 64;
    const float* VC = (const float*)(a.ws + (SAMPLE ? WS_VCS : WS_VCP)) + (size_t)b * NCB * 256 + g * 64;
    for (int kt = 0; kt < NCT; ++kt) {
        __syncthreads();
        load_tile([&](int key) -> const float* { const int n = kt * 64 + key; return n < NCMP ? KC + (size_t)n * 256 : nullptr; }, [&](int) -> const float* { return nullptr; }, true, false);
        __syncthreads();
        float sc[RPW]; score_rows(sc);
        const int n = kt * 64 + lane;
#pragma unroll
        for (int k = 0; k < RPW; ++k) { const int t = t0 + (w >> 2) + 2 * k; const int dist = t - (16 * n + 31); const bool valid = n < NCMP && dist >= 0;
            const float s = valid ? sc[k] - slope * (float)dist : NEGF; Pb[(w + 8 * k) * PBLD + n] = s; m_[k] = fmaxf(m_[k], s); }
    }
#pragma unroll
    for (int k = 0; k < RPW; ++k) {
        const float m = wave_max(m_[k]); float ls = 0.f; LAS float* pr = Pb + (w + 8 * k) * PBLD;
        float pv[NCT];
#pragma unroll
        for (int i = 0; i < NCT; ++i) { const float s = pr[i * 64 + lane]; pv[i] = s > -1e29f ? __expf(s - m) : 0.f; ls += pv[i]; }
        ls = wave_sum(ls); const float inv = 1.0f / fmaxf(ls, 1e-30f);
#pragma unroll
        for (int i = 0; i < NCT; ++i) pr[i * 64 + lane] = pv[i] * inv;
    }
    for (int kt = 0; kt < NCT; ++kt) {
        __syncthreads();
        load_tile([&](int) -> const float* { return nullptr; }, [&](int key) -> const float* { const int n = kt * 64 + key; return n < NCMP ? VC + (size_t)n * 256 : nullptr; }, false, true);
        __syncthreads();
        pv_rows(Pb + kt * 64, PBLD);
    }
#pragma unroll
    for (int k = 0; k < RPW; ++k) { const int grow = grow0 + (w >> 2) + 2 * k; accf[k] = sigmoidf_(bf2f(UA[(size_t)grow * UA_LD + ACOLS + 0 * 16 + h])) * o_[k]; }
    for (int idx = tid; idx < TT * NSEL; idx += 512) {
        const int tok = idx / NSEL, j = idx % NSEL; float v = 0.f;
#pragma unroll
        for (int r4 = 0; r4 < 4; ++r4) { const LAS float* pr = Pb + (tok * 4 + r4) * PBLD;
#pragma unroll
            for (int mm = 0; mm < 3; ++mm) { const int n = 4 * j + mm; if (n < NCMP) v += pr[n]; }
            { const int n = 4 * j + 3; if (n < NCMP) v += 0.5f * pr[n]; }
            { const int n = 4 * j - 1; if (n >= 0 && n < NCMP) v += 0.5f * pr[n]; } }
        imp[tok * 132 + j] = v;
    }
    __syncthreads();
    for (int idx = tid; idx < TT * NSEL; idx += 512) {
        const int tok = idx / NSEL, j = idx % NSEL, tb = (t0 + tok) >> 6;
        auto score = [&](int jj) -> float { const int back = tb - jj; const bool forced = jj == 0 || (back >= 0 && back < 2); return forced ? 1e4f : (back >= 0 ? imp[tok * 132 + jj] : -1.0f); };
        const float sj = score(j); int rank = 0;
        for (int jj = 0; jj < NSEL; ++jj) { const float s2 = score(jj); rank += (s2 > sj || (s2 == sj && jj < j)) ? 1 : 0; }
        selb[tok * 132 + j] = (rank < 16 && sj >= 0.f) ? 1 : 0;
    }
    __syncthreads();
    if (tid == 0) { int nu = 0; for (int j = 0; j < NSEL; ++j) { int any = 0; for (int tok = 0; tok < TT; ++tok) any |= selb[tok * 132 + j]; if (any) ulist[nu++] = j; } ulist[132] = nu; }
    __syncthreads();
    const int nu = ulist[132];
    LAS float* ps = Pb;
    auto online = [&](int k, float s, bool valid) {
        const float sv = valid ? s : NEGF; const float mn = fmaxf(m_[k], wave_max(sv)); const float p = valid ? __expf(sv - mn) : 0.f; const float corr = __expf(m_[k] - mn);
        l_[k] = l_[k] * corr + wave_sum(p); o_[k] *= corr; m_[k] = mn; ps[(w + 8 * k) * 64 + lane] = p;
    };
#pragma unroll
    for (int k = 0; k < RPW; ++k) { m_[k] = NEGF; l_[k] = 0.f; o_[k] = 0.f; }
    for (int ui = 0; ui < nu; ++ui) {
        const int j = ulist[ui];
        __syncthreads();
        auto kp = [&](int key) -> const float* {
            if (!SAMPLE) return a.out + O_PSEL + ((size_t)b * SEQ + j * 64 + key) * 512 + g * 64;
            if (j < 128) return a.in[3] + ((size_t)pt[b * NPAGES + (j >> 1)] * PAGE + (j & 1) * 64 + key) * 512 + g * 64;
            return key < 4 ? a.out + O_SSEL + ((size_t)b * 4 + key) * 512 + g * 64 : nullptr; };
        load_tile(kp, [&](int key) -> const float* { const float* p = kp(key); return p ? p + 256 : nullptr; }, true, true);
        __syncthreads();
        float sc[RPW]; score_rows(sc);
        const int kpos = j * 64 + lane;
#pragma unroll
        for (int k = 0; k < RPW; ++k) { const int tok = (w >> 2) + 2 * k, t = t0 + tok; const bool valid = selb[tok * 132 + j] != 0 && kpos <= t; online(k, sc[k] - slope * (float)(t - kpos), valid); }
        asm volatile("s_waitcnt lgkmcnt(0)" ::: "memory");
        pv_rows(ps, 64);
    }
#pragma unroll
    for (int k = 0; k < RPW; ++k) { const int grow = grow0 + (w >> 2) + 2 * k; accf[k] += sigmoidf_(bf2f(UA[(size_t)grow * UA_LD + ACOLS + 1 * 16 + h])) * o_[k] / fmaxf(l_[k], 1e-30f); }
#pragma unroll
    for (int k = 0; k < RPW; ++k) { m_[k] = NEGF; l_[k] = 0.f; o_[k] = 0.f; }
    const int kstart = SAMPLE ? PAST - WINDOW : (t0 - WINDOW > 0 ? t0 - WINDOW : 0), kend = t0 + TT - 1;
    for (int kb = kstart; kb <= kend; kb += 64) {
        __syncthreads();
        auto kp = [&](int key) -> const float* { const int kpos = kb + key; if (kpos > kend) return nullptr;
            if (!SAMPLE) return (const float*)(a.ws + WS_KVW) + ((size_t)b * SEQ + kpos) * 512 + g * 64;
            const int i = kpos - (PAST - WINDOW); return i < 512 ? a.in[4] + ((size_t)b * 512 + i) * 512 + g * 64 : a.out + O_SWIN + ((size_t)b * 512 + 508 + (i - 512)) * 512 + g * 64; };
        load_tile(kp, [&](int key) -> const float* { const float* p = kp(key); return p ? p + 256 : nullptr; }, true, true);
        __syncthreads();
        float sc[RPW]; score_rows(sc);
        const int kpos = kb + lane;
#pragma unroll
        for (int k = 0; k < RPW; ++k) { const int t = t0 + (w >> 2) + 2 * k; const int dist = t - kpos; const bool valid = kpos <= kend && dist >= 0 && dist <= WINDOW; online(k, sc[k] - slope * (float)dist, valid); }
        asm volatile("s_waitcnt lgkmcnt(0)" ::: "memory");
        pv_rows(ps, 64);
    }
    bf16* OB = (bf16*)(a.ws + WS_OAB) + (size_t)MPAD * 1024;
#pragma unroll
    for (int k = 0; k < RPW; ++k) { const int grow = grow0 + (w >> 2) + 2 * k;
        const float o = accf[k] + sigmoidf_(bf2f(UA[(size_t)grow * UA_LD + ACOLS + 2 * 16 + h])) * o_[k] / fmaxf(l_[k], 1e-30f);
        const float gb = bf2f(QG[(size_t)grow * 2048 + 1024 + h * 64 + lane]);
        OB[(size_t)grow * 1024 + h * 64 + lane] = f2bf(o * gb / (1.0f + __expf(-gb))); }
    __syncthreads();
}

__device__ __forceinline__ void p4_post(const Args& a) {
    const int tid = threadIdx.x, h = tid >> 5;
    const float* ORAW = (const float*)(a.ws + WS_ORAW); const float* PREP = (const float*)(a.ws + WS_PREP); const bf16* SG = (const bf16*)(a.ws + WS_SG); const float* BON = (const float*)(a.ws + WS_BONUS);
    bf16* OA = (bf16*)(a.ws + WS_OAB);
    const int c = (tid & 31) * 2, ch = h * 64 + c;
    const float gw0 = a.in[18][ch], gw1 = a.in[18][ch + 1], gb0 = a.in[19][ch], gb1 = a.in[19][ch + 1];
    for (int row = blockIdx.x; row < MT; row += gridDim.x) {
        const float o0 = ORAW[(size_t)row * 1024 + ch], o1 = ORAW[(size_t)row * 1024 + ch + 1];
        float s = o0 + o1;
#pragma unroll
        for (int of = 16; of >= 1; of >>= 1) s += __shfl_xor(s, of);
        const float mean = s * (1.0f / 64.0f), d0 = o0 - mean, d1 = o1 - mean;
        float q = d0 * d0 + d1 * d1;
#pragma unroll
        for (int of = 16; of >= 1; of >>= 1) q += __shfl_xor(q, of);
        const float rstd = rsqrtf(q * (1.0f / 64.0f) + GN_EPS);
        const float bon = BON[(size_t)row * 16 + h];
        const float* P = PREP + ((size_t)row * 16 + h) * 384 + 320 + c;
        const unsigned sgw = *(const unsigned*)(SG + (size_t)row * 1024 + ch);
        const float y0 = (d0 * rstd * gw0 + gb0 + bon * P[0]) * __uint_as_float(sgw << 16), y1 = (d1 * rstd * gw1 + gb1 + bon * P[1]) * __uint_as_float(sgw & 0xffff0000u);
        *(unsigned*)(OA + (size_t)row * 1024 + ch) = pk2bf(y0, y1);
    }
}

struct Sched2 {
    int G, c;
    __device__ bool next(int i, pg8::Unit& u) const { const int p = (i >> 1) * G + c; if (p >= 65 * 8) return false; const int hf = i & 1; u.pm = (p >> 3) + hf * 65; u.pn = (p & 7) + hf * 8; return true; }
    __device__ __forceinline__ void a_ready(const pg8::Unit&) const {}
    __device__ __forceinline__ void done(const pg8::Unit&) const {}
};
struct EpiG2 {
    static constexpr bool PERM = true, AFTER_DRAIN = false;
    const bf16* GATES; bf16* MERGED;
    __device__ __forceinline__ void operator()(const pg8::f32x4 (&acc)[2][2][4][2], const pg8::Unit& u, int wr, int wc, int fr, int fq) const {
        const int hf = u.pm >= 65 ? 1 : 0, pm = u.pm - 65 * hf, pn = u.pn - 8 * hf;
        const int row0 = pm * 256 + wr * 64 + fr, cl0 = pn * 256 + wc * 32 + fq * 8;
#pragma unroll
        for (int ai = 0; ai < 2; ++ai)
#pragma unroll
            for (int m = 0; m < 4; ++m) {
                const int row = row0 + ai * 128 + m * 16;
#pragma unroll
                for (int bj = 0; bj < 2; ++bj) {
                    const int col = cl0 + bj * 128;
                    float gt[8], pv[8];
                    unpack8(*(const u32x4*)(GATES + (size_t)row * 4096 + hf * 2048 + col), gt);
                    const pg8::f32x4 v0 = acc[ai][bj][m][0], v1 = acc[ai][bj][m][1];
                    float r[8] = {gt[0] * v0[0], gt[1] * v0[1], gt[2] * v0[2], gt[3] * v0[3], gt[4] * v1[0], gt[5] * v1[1], gt[6] * v1[2], gt[7] * v1[3]};
                    bf16* d = MERGED + (size_t)row * 2048 + col;
                    if (hf) { unpack8(*(const u32x4*)d, pv);
#pragma unroll
                        for (int i = 0; i < 8; ++i) r[i] += pv[i]; }
                    u32x4 w; w.x = pg8::cvt_pk_bf16(r[0], r[1]); w.y = pg8::cvt_pk_bf16(r[2], r[3]); w.z = pg8::cvt_pk_bf16(r[4], r[5]); w.w = pg8::cvt_pk_bf16(r[6], r[7]);
                    *(u32x4*)d = w;
                }
            }
    }
};
struct EpiG3 {
    static constexpr bool PERM = true, AFTER_DRAIN = false;
    const float* xp; const float* xs; float* y; float* sumsq;
    __device__ __forceinline__ void operator()(const pg8::f32x4 (&acc)[2][2][4][2], const pg8::Unit& u, int wr, int wc, int fr, int fq) const {
        const int row0 = u.pm * 256 + wr * 64 + fr, cl0 = u.pn * 256 + wc * 32 + fq * 8;
#pragma unroll
        for (int ai = 0; ai < 2; ++ai)
#pragma unroll
            for (int m = 0; m < 4; ++m) {
                const int row = row0 + ai * 128 + m * 16;
                float ss = 0.f;
                if (row < MT) {
                    const float* xr = row < MP ? xp + (size_t)row * D : xs + (size_t)(row - MP) * D;
#pragma unroll
                    for (int bj = 0; bj < 2; ++bj) {
                        const int col = cl0 + bj * 128;
                        const pg8::f32x4 h0 = acc[ai][bj][m][0] + *(const pg8::f32x4*)(xr + col), h1 = acc[ai][bj][m][1] + *(const pg8::f32x4*)(xr + col + 4);
                        *(pg8::f32x4*)(y + (size_t)row * D + col) = h0; *(pg8::f32x4*)(y + (size_t)row * D + col + 4) = h1;
                        ss += h0[0] * h0[0] + h0[1] * h0[1] + h0[2] * h0[2] + h0[3] * h0[3] + h1[0] * h1[0] + h1[1] * h1[1] + h1[2] * h1[2] + h1[3] * h1[3];
                    }
                }
                ss += __shfl_xor(ss, 16); ss += __shfl_xor(ss, 32);
                if (fq == 0 && row < MT) sumsq[(size_t)row * 32 + u.pn * 4 + wc] = ss;
            }
    }
};

__device__ __forceinline__ void p7_norm(const Args& a) {
    const int tid = threadIdx.x, lane = tid & 63, wave = tid >> 6;
    const float* sumsq = (const float*)(a.ws + WS_SUMSQ); const float* gout = a.in[27];
    for (int row = blockIdx.x * 8 + wave; row < MT; row += gridDim.x * 8) {
        float s = lane < 32 ? sumsq[(size_t)row * 32 + lane] : 0.f; s = wave_sum(s);
        const float rs = rsqrtf(s * (1.0f / D) + RMS_EPS);
        float* y = a.out + (size_t)row * D;
#pragma unroll
        for (int i = 0; i < 8; ++i) { f32x4 v = *(f32x4*)(y + i * 256 + lane * 4); const f32x4 gg = *(const f32x4*)(gout + i * 256 + lane * 4);
            v.x *= rs * gg.x; v.y *= rs * gg.y; v.z *= rs * gg.z; v.w *= rs * gg.w; *(f32x4*)(y + i * 256 + lane * 4) = v; }
    }
}

constexpr int N_PHASES = 8;
__global__ void __launch_bounds__(512, 2) fwd(Args a) {
    extern __shared__ __align__(16) unsigned char smem[];
    LAS unsigned char* lds = (LAS unsigned char*)smem;
    const int tid = threadIdx.x;
    volatile LAS unsigned* xbw = (volatile LAS unsigned*)(lds + LDS_BYTES - 16);
    LAS int* qitem = (LAS int*)(lds + LDS_BYTES - 32);
    if (tid < 4) xbw[tid] = 0u;
    __syncthreads();
    unsigned* ctl = (unsigned*)(a.ws + WS_CTL);
    const int lo = a.ph_lo, hi = a.ph_hi;
    XcdBarrier bar; bar.bar = ctl + CW_BAR; bar.x = 0; bar.st = xbw;
    if (hi - lo > 1) bar = xcd_barrier_post(ctl + CW_BAR, xbw);
#ifndef PH_MASK
#define PH_MASK 0xff
#endif
#define IN(k) (((PH_MASK >> (k)) & 1) && lo <= (k) && (k) < hi)
#define SEAM(k) do { if (IN(k) && IN((k) + 1)) xcd_barrier(bar); } while (0)

    if (IN(0)) p0_prologue(a, lds);
    SEAM(0);
    if (IN(1)) {
        pg8::Gemm g{(const bf16*)(a.ws + WS_XN), (const bf16*)(a.ws + WS_WIN_T), MPAD, NIN, D};
        pg8::StaticOrder S; S.init(MPAD, NIN, (int)gridDim.x, (int)blockIdx.x);
        EpiG1 E{(bf16*)(a.ws + WS_UA), (bf16*)(a.ws + WS_QG), (float*)(a.ws + WS_KVW), (bf16*)(a.ws + WS_GATES), a.out};
        pg8::gemm_phase<EpiG1, pg8::StaticOrder, false>(lds, g, S, E, nullptr);
    }
    SEAM(1);
    if (IN(2)) {
        for (int it = blockIdx.x; it < 258 * 16; it += gridDim.x) prep_item(a, it >> 4, it & 15, lds);
        __syncthreads();
        for (int it = blockIdx.x; it < BATCH * 4; it += gridDim.x) { const int b = it >> 2, n0 = (it & 3) * 32; const int cnt = (NCMP_P - n0) < 32 ? (NCMP_P - n0) : 32; compress_item<false>(a, b, n0, cnt, (LAS float*)lds); }
    }
    SEAM(2);
    if (IN(3)) {
        constexpr int N_CH = BATCH * AH + DB * AH, N_PA = BATCH * 4 * 256, N_SA = DB * 4;
#ifndef P3_MASK
#define P3_MASK 7
#endif
        if (P3_MASK & 1) for (;;) {
            __syncthreads();
            if (tid == 0) *qitem = (int)atomicAdd(ctl + CW_QUEUE, 1u);
            __syncthreads();
            const int it = *qitem;
            if (it >= N_CH) break;
            const bool smp = it >= BATCH * AH; const int ci = smp ? it - BATCH * AH : it, b = ci >> 4, h = ci & 15;
            const int row0 = smp ? MP + b * 4 : b * SEQ;
            scan_chain((const float*)(a.ws + WS_PREP) + ((size_t)row0 * 16 + h) * 384, smp ? DS : SEQ, smp ? a.in[5] + (size_t)ci * 4096 : nullptr,
                       a.out + (smp ? O_SRWKV : O_PRWKV) + (size_t)ci * 4096, (float*)(a.ws + WS_ORAW) + (size_t)row0 * 1024 + h * 64, (LAS float*)lds, (LAS float*)lds + 1024);
        }
        if (P3_MASK & 2) for (;;) {
            __syncthreads();
            if (tid == 0) *qitem = (int)atomicAdd(ctl + CW_QUEUE + 64, 1u);
            __syncthreads();
            const int ai = *qitem;
            if (ai >= N_PA) break;
            attn_item<false>(a, ai >> 10, (ai >> 8) & 3, ai & 255, lds);
        }
        if (P3_MASK & 4) for (;;) {
            __syncthreads();
            if (tid == 0) *qitem = (int)atomicAdd(ctl + CW_QUEUE + 128, 1u);
            __syncthreads();
            const int ai = *qitem;
            if (ai >= N_SA) break;
            attn_item<true>(a, ai >> 2, ai & 3, 0, lds);
        }
    }
    SEAM(3);
    if (IN(4)) p4_post(a);
    SEAM(4);
    if (IN(5)) {
        pg8::Gemm g{(const bf16*)(a.ws + WS_OAB), (const bf16*)(a.ws + WS_WPAB_T), 2 * MPAD, 4096, 1024};
        Sched2 S{(int)gridDim.x, (int)blockIdx.x};
        EpiG2 E{(const bf16*)(a.ws + WS_GATES), (bf16*)(a.ws + WS_MERGED)};
        pg8::gemm_phase<EpiG2, Sched2, false>(lds, g, S, E, nullptr);
    }
    SEAM(5);
    if (IN(6)) {
        pg8::Gemm g{(const bf16*)(a.ws + WS_MERGED), (const bf16*)(a.ws + WS_WO_T), MPAD, D, D};
        pg8::StaticOrder S; S.init(MPAD, D, (int)gridDim.x, (int)blockIdx.x);
        EpiG3 E{a.in[0], a.in[1], a.out, (float*)(a.ws + WS_SUMSQ)};
        pg8::gemm_phase<EpiG3, pg8::StaticOrder, false>(lds, g, S, E, nullptr);
    }
    SEAM(6);
    if (IN(7)) p7_norm(a);
#undef IN
#undef SEAM
}

#ifndef MK_ONE_LAUNCH
#define MK_ONE_LAUNCH 0
#endif
extern "C" void kernel_launch(void* const* d_in, const int* in_sizes, int n_in, void* d_out, int out_size, void* d_ws, size_t ws_size, hipStream_t stream) {
    static int grid = 0;
    if (grid == 0) {
        int dev = 0, cus = 0;
        if (n_in != 28 || (size_t)out_size != O_END || ws_size < WS_END) { fprintf(stderr, "kernel_launch: unexpected shapes (n_in %d out %d ws %zu, need %zu)\n", n_in, out_size, ws_size, (size_t)WS_END); grid = -1; return; }
        if (hipGetDevice(&dev) != hipSuccess || hipDeviceGetAttribute(&cus, hipDeviceAttributeMultiprocessorCount, dev) != hipSuccess) { grid = -1; return; }
        if (hipFuncSetAttribute((const void*)fwd, hipFuncAttributeMaxDynamicSharedMemorySize, LDS_BYTES) != hipSuccess) { fprintf(stderr, "kernel_launch: hipFuncSetAttribute failed\n"); grid = -1; return; }
        int per_cu = 0;
        if (hipOccupancyMaxActiveBlocksPerMultiprocessor(&per_cu, (const void*)fwd, 512, LDS_BYTES) != hipSuccess || per_cu < 1) fprintf(stderr, "kernel_launch: occupancy query says %d\n", per_cu);
        (void)hipGetLastError();
        grid = cus;
    }
    if (grid < 0) return;
    hipMemsetAsync((char*)d_ws + WS_CTL, 0, CTL_BYTES, stream);
    Args a{};
    for (int i = 0; i < 28; ++i) a.in[i] = (const float*)d_in[i];
    a.out = (float*)d_out; a.ws = (unsigned char*)d_ws;
#if MK_ONE_LAUNCH
    a.ph_lo = 0; a.ph_hi = N_PHASES;
    hipLaunchKernelGGL(fwd, dim3(grid), dim3(512), LDS_BYTES, stream, a);
#else
    for (int p = 0; p < N_PHASES; ++p) { a.ph_lo = p; a.ph_hi = p + 1; hipLaunchKernelGGL(fwd, dim3(grid), dim3(512), LDS_BYTES, stream, a); }
#endif
}
```

```cpp
#include <hip/hip_runtime.h>
#include <stdint.h>
#include <stdio.h>

#define LAS __attribute__((address_space(3)))
typedef unsigned short bf16;
typedef float f32x4 __attribute__((ext_vector_type(4)));
typedef unsigned u32x4 __attribute__((ext_vector_type(4)));
typedef unsigned u32x2 __attribute__((ext_vector_type(2)));

constexpr int D = 2048, BATCH = 8, SEQ = 2048, DB = 32, DS = 4, PAST = 8192, PAGE = 128, NPAGES = PAST / PAGE;
constexpr int MP = BATCH * SEQ, MS = DB * DS, MT = MP + MS, MPAD = 16640;
constexpr int AH = 16, AN = 64, AW = 1024, ACOLS = 4224;
constexpr int NIN = 12032, IN_COLS = 11952, UA_LD = 4352;
constexpr int WINDOW = 512;
constexpr float RMS_EPS = 1e-6f, GN_EPS = 64e-5f, ATTN_SCALE = 0.125f;
constexpr int NCMP_P = 127, NCMP_S = 511, NCB_P = 128, NCB_S = 512;
constexpr int NSEL_P = 32, NSEL_S = 129;
constexpr int LDS_BYTES = 147456;

constexpr size_t O_YP = 0, O_YS = O_YP + (size_t)MP * D, O_PCMP = O_YS + (size_t)MS * D, O_PSEL = O_PCMP + (size_t)MP * 512, O_PWIN = O_PSEL + (size_t)MP * 512,
                 O_PRWKV = O_PWIN + (size_t)BATCH * 512 * 512, O_PSHIFT = O_PRWKV + (size_t)BATCH * AH * 64 * 64, O_SCMP = O_PSHIFT + (size_t)BATCH * ACOLS,
                 O_SSEL = O_SCMP + (size_t)MS * 512, O_SWIN = O_SSEL + (size_t)MS * 512, O_SRWKV = O_SWIN + (size_t)DB * 512 * 512, O_SSHIFT = O_SRWKV + (size_t)DB * AH * 64 * 64,
                 O_END = O_SSHIFT + (size_t)DB * ACOLS;
static_assert(O_END == 64001024, "output size");

constexpr size_t al256(size_t x) { return (x + 255) & ~(size_t)255; }
constexpr size_t WS_CTL = 0, CTL_BYTES = 65536;
constexpr size_t WS_WIN_T = WS_CTL + CTL_BYTES;
constexpr size_t WS_WPAB_T = al256(WS_WIN_T + (size_t)NIN * D * 2);
constexpr size_t WS_WO_T = al256(WS_WPAB_T + (size_t)4096 * 1024 * 2);
constexpr size_t WS_XN = al256(WS_WO_T + (size_t)D * D * 2);
constexpr size_t WS_UA = al256(WS_XN + (size_t)MPAD * D * 2);
constexpr size_t WS_QG = al256(WS_UA + (size_t)MPAD * UA_LD * 2);
constexpr size_t WS_KVW = al256(WS_QG + (size_t)MPAD * 2048 * 2);
constexpr size_t WS_GATES = al256(WS_KVW + (size_t)MPAD * 512 * 4);
constexpr size_t WS_PREP = al256(WS_GATES + (size_t)MPAD * 4096 * 2);
constexpr size_t WS_SG = al256(WS_PREP + (size_t)MT * 16 * 384 * 4);
constexpr size_t WS_BONUS = al256(WS_SG + (size_t)MT * 1024 * 2);
constexpr size_t WS_ORAW = al256(WS_BONUS + (size_t)MT * 16 * 4);
constexpr size_t WS_OAB = al256(WS_ORAW + (size_t)MT * 1024 * 4);
constexpr size_t WS_MERGED = al256(WS_OAB + (size_t)2 * MPAD * 1024 * 2);
constexpr size_t WS_SUMSQ = al256(WS_MERGED + (size_t)MPAD * 2048 * 2);
constexpr size_t WS_KCP = al256(WS_SUMSQ + (size_t)MPAD * 32 * 4);
constexpr size_t WS_VCP = al256(WS_KCP + (size_t)BATCH * NCB_P * 256 * 4);
constexpr size_t WS_KCS = al256(WS_VCP + (size_t)BATCH * NCB_P * 256 * 4);
constexpr size_t WS_VCS = al256(WS_KCS + (size_t)DB * NCB_S * 256 * 4);
constexpr size_t WS_KVSB = al256(WS_VCS + (size_t)DB * NCB_S * 256 * 4);
constexpr size_t WS_KVWB = al256(WS_KVSB + (size_t)MPAD * 512 * 2);
constexpr size_t WS_WUPT = al256(WS_KVWB + (size_t)MPAD * 512 * 2);
constexpr size_t WS_PAB = al256(WS_WUPT + (size_t)2 * 1024 * 64 * 2);
constexpr size_t WS_DELTA = al256(WS_PAB + (size_t)MPAD * 4096 * 2);
constexpr size_t WS_CHUNK = al256(WS_DELTA + (size_t)MPAD * 2048 * 2);
constexpr size_t WS_VB = al256(WS_CHUNK + (size_t)BATCH * AH * 128 * 12288);
constexpr size_t WS_END = al256(WS_VB + (size_t)MT * 1024 * 2);
constexpr int CW_BAR = 0;
constexpr int CW_QUEUE = 4096;

struct Args {
    const float* in[28];
    float* out;
    unsigned char* ws;
    int ph_lo, ph_hi, p3mask, pad_;
};
static_assert(sizeof(Args) == 30 * 8 + 16, "Args has no holes");

__device__ __forceinline__ float bf2f(unsigned short b) { return __uint_as_float(((unsigned)b) << 16); }
typedef __bf16 bf16n2 __attribute__((ext_vector_type(2)));
typedef float f32n2 __attribute__((ext_vector_type(2)));
__device__ __forceinline__ unsigned short f2bf(float f) { const __bf16 h = (__bf16)f; return __builtin_bit_cast(unsigned short, h); }
__device__ __forceinline__ unsigned pk2bf(float lo, float hi) { const f32n2 v = {lo, hi}; const bf16n2 h = __builtin_convertvector(v, bf16n2); return __builtin_bit_cast(unsigned, h); }
__device__ __forceinline__ float sigmoidf_(float x) { return 1.0f / (1.0f + __expf(-x)); }
#define DPPF(x, ctrl) __int_as_float(__builtin_amdgcn_update_dpp(0, __float_as_int(x), (ctrl), 0xf, 0xf, false))
__device__ __forceinline__ float xhalf_sum(float x) { const auto r = __builtin_amdgcn_permlane32_swap(__float_as_uint(x), __float_as_uint(x), false, false); return __uint_as_float(r[0]) + __uint_as_float(r[1]); }
__device__ __forceinline__ float xhalf_max(float x) { const auto r = __builtin_amdgcn_permlane32_swap(__float_as_uint(x), __float_as_uint(x), false, false); return fmaxf(__uint_as_float(r[0]), __uint_as_float(r[1])); }
__device__ __forceinline__ float wave_sum(float v) {
    v += DPPF(v, 0xB1); v += DPPF(v, 0x4E); v += DPPF(v, 0x141); v += DPPF(v, 0x140);
    { const auto r = __builtin_amdgcn_permlane16_swap(__float_as_uint(v), __float_as_uint(v), false, false); v = __uint_as_float(r[0]) + __uint_as_float(r[1]); }
    return xhalf_sum(v);
}
__device__ __forceinline__ float wave_max(float v) {
    v = fmaxf(v, DPPF(v, 0xB1)); v = fmaxf(v, DPPF(v, 0x4E)); v = fmaxf(v, DPPF(v, 0x141)); v = fmaxf(v, DPPF(v, 0x140));
    { const auto r = __builtin_amdgcn_permlane16_swap(__float_as_uint(v), __float_as_uint(v), false, false); v = fmaxf(__uint_as_float(r[0]), __uint_as_float(r[1])); }
    return xhalf_max(v);
}
__device__ __forceinline__ float x16_sum(float v) { const auto r = __builtin_amdgcn_permlane16_swap(__float_as_uint(v), __float_as_uint(v), false, false); return __uint_as_float(r[0]) + __uint_as_float(r[1]); }
__device__ __forceinline__ float oct_sum(float v) { v += DPPF(v, 0xB1); v += DPPF(v, 0x4E); v += DPPF(v, 0x141); return v; }
__device__ __forceinline__ float row16_allsum(float v) { v += DPPF(v, 0xB1); v += DPPF(v, 0x4E); v += DPPF(v, 0x141); v += DPPF(v, 0x140); return v; }
__device__ __forceinline__ float xhalf_other(float x, bool hi) { const auto r = __builtin_amdgcn_permlane32_swap(__float_as_uint(x), __float_as_uint(x), false, false); return __uint_as_float(hi ? r[0] : r[1]); }

#define XB_TMO      128
#define XB_XCNT(j)  (256  + 64 * (j))
#define XB_XSUB(j)  (1280 + 64 * (j))
#define XB_XGEN(j)  (2304 + 64 * (j))
#define XB_TOP      3328
#define XB_TOPGEN   3392
#define XCD_BAR_WORDS 3456
#define XB_SPIN_CAP (1u << 18)
#define LAS __attribute__((address_space(3)))

__device__ __forceinline__ unsigned xb_ld(unsigned* p)              { return __hip_atomic_load(p, __ATOMIC_RELAXED, __HIP_MEMORY_SCOPE_AGENT); }
__device__ __forceinline__ unsigned xb_add(unsigned* p, unsigned v) { return __hip_atomic_fetch_add(p, v, __ATOMIC_RELAXED, __HIP_MEMORY_SCOPE_AGENT); }
__device__ __forceinline__ unsigned xb_xcc_id() { return (unsigned)__builtin_amdgcn_s_getreg((3 << 11) | 20) & 0xFu; }
#define XB_SPIN(cond, bar) do { unsigned _sp = 0; while (cond) { __builtin_amdgcn_s_sleep(1); \
    if ((++_sp & 255u) == 0u) { if (xb_ld(&(bar)[XB_TMO])) break; if (_sp > XB_SPIN_CAP) { atomicAdd(&(bar)[XB_TMO], 1u); break; } } } } while (0)

struct XcdBarrier {
    unsigned* bar; unsigned x;
    volatile LAS unsigned* st;
};

__device__ __forceinline__ XcdBarrier xcd_barrier_post(unsigned* bar, volatile LAS unsigned* st) {
    XcdBarrier b; b.bar = bar; b.x = xb_xcc_id(); b.st = st;
    if (threadIdx.x == 0) (void)xb_add(&bar[XB_XCNT(b.x)], 1u);
    return b;
}
__device__ __forceinline__ void xcd_barrier_complete(unsigned* bar, unsigned x, unsigned& nloc, unsigned& nx) {
    const unsigned G = gridDim.x * gridDim.y * gridDim.z;
    unsigned sum, cnt, mine, sp = 0u;
    for (;;) {
        sum = 0u; cnt = 0u; mine = 0u;
#pragma unroll
        for (unsigned j = 0; j < 16; ++j) { const unsigned c = xb_ld(&bar[XB_XCNT(j)]); sum += c; cnt += (c > 0u) ? 1u : 0u; mine = (j == x) ? c : mine; }
        if (sum == G) break;
        __builtin_amdgcn_s_sleep(1);
        if ((++sp & 255u) == 0u) { if (xb_ld(&bar[XB_TMO])) break; if (sp > XB_SPIN_CAP) { atomicAdd(&bar[XB_TMO], 1u); break; } }
    }
    nloc = mine > 0u ? mine : 1u; nx = cnt > 0u ? cnt : 1u;
}

__device__ __forceinline__ void xcd_barrier(const XcdBarrier& b) {
    asm volatile("s_waitcnt vmcnt(0)" ::: "memory");
    __syncthreads();
    if (threadIdx.x == 0) {
        unsigned* bar = b.bar;
        __builtin_amdgcn_s_waitcnt(0);
        unsigned nloc = b.st[0], nx = b.st[1];
        if (nloc == 0u) { xcd_barrier_complete(bar, b.x, nloc, nx); b.st[0] = nloc; b.st[1] = nx; }
        const unsigned old = xb_add(&bar[XB_XSUB(b.x)], 1u);
        const unsigned gen = old / nloc;
        if (old + 1u == (gen + 1u) * nloc) {
            __builtin_amdgcn_fence(__ATOMIC_RELEASE, "agent");
            asm volatile("s_waitcnt vmcnt(0)" ::: "memory");
            const unsigned og = xb_add(&bar[XB_TOP], 1u);
            const unsigned tg = og / nx;
            if (og + 1u == (tg + 1u) * nx) xb_add(&bar[XB_TOPGEN], 1u);
            else XB_SPIN(xb_ld(&bar[XB_TOPGEN]) == tg, bar);
            __builtin_amdgcn_fence(__ATOMIC_ACQUIRE, "agent");
            xb_add(&bar[XB_XGEN(b.x)], 1u);
            asm volatile("s_waitcnt vmcnt(0)" ::: "memory");
        } else {
            XB_SPIN(xb_ld(&bar[XB_XGEN(b.x)]) == gen, bar);
            __builtin_amdgcn_fence(__ATOMIC_ACQUIRE, "agent");
            asm volatile("s_waitcnt vmcnt(0)" ::: "memory");
        }
    }
    __syncthreads();
}

namespace pg8 {
#define PG8_LAS __attribute__((address_space(3)))
typedef unsigned short bf16_t;
typedef short bf16x8 __attribute__((ext_vector_type(8)));
typedef float f32x4 __attribute__((ext_vector_type(4)));
typedef unsigned u32x4 __attribute__((ext_vector_type(4)));
constexpr int BM = 256, BK = 64, HALF = 128, HTB = HALF * BK * 2  , STAGE_BYTES = 8 * HTB, NXCD = 8, WGM = 8;

__host__ __device__ __forceinline__ int lds_byte(int r, int c) { const int st = (r >> 4) * 2 + (c >> 5), rr = r & 15, cc = c & 31, ob = rr * 64 + cc * 2; return st * 1024 + (ob ^ (((ob >> 9) & 1) << 5)); }
__host__ __device__ __forceinline__ void stage_rc(int b, int& R, int& C) { const int st = b / 1024, sb = b % 1024, swz = sb ^ (((sb >> 9) & 1) << 5); R = (st >> 1) * 16 + swz / 64; C = (st & 1) * 32 + (swz % 64) / 2; }
__host__ __device__ __forceinline__ int perm32(int rho) { const int n = rho >> 4, i = rho & 15; return 8 * (i >> 2) + 4 * n + (i & 3); }

struct Unit { int pm, pn; };
struct Gemm { const bf16_t* A; const bf16_t* Bt; int M, N, K; };
struct StaticOrder {
    int nM, nN, nwg, G, c;
    __host__ __device__ void init(int M, int N, int G_, int c_) { nM = M / BM; nN = N / BM; nwg = nM * nN; G = G_; c = c_; }
    __host__ __device__ bool next(int i, Unit& u) const {
        const long L = (long)i * G + c; if (L >= nwg) return false;
        int wgid = (int)L; { const int q = nwg / NXCD, r = nwg % NXCD, xcd = wgid % NXCD, off = wgid / NXCD; wgid = (xcd < r ? xcd * (q + 1) : r * (q + 1) + (xcd - r) * q) + off; }
        const int nig = WGM * nN, gid = wgid / nig, fm = gid * WGM, gsz = (nM - fm) < WGM ? (nM - fm) : WGM;
        u.pm = fm + ((wgid % nig) % gsz); u.pn = (wgid % nig) / gsz; return true;
    }
    __device__ __forceinline__ void a_ready(const Unit&) const {}
    __device__ __forceinline__ void done(const Unit&) const {}
};
__device__ __forceinline__ unsigned cvt_pk_bf16(float lo, float hi) { unsigned r; asm volatile("v_cvt_pk_bf16_f32 %0, %1, %2" : "=v"(r) : "v"(lo), "v"(hi)); return r; }
template <class Epi, class Sched, bool STAMP = false>
__device__ __forceinline__ void gemm_phase(PG8_LAS unsigned char* lds, const Gemm g, const Sched& S, const Epi& E, unsigned long long* stamps) {
    const int tid = threadIdx.x, wid = __builtin_amdgcn_readfirstlane(tid >> 6), lane = tid & 63, wr = wid >> 2, wc = wid & 3, fr = lane & 15, fq = lane >> 4;
    const int K = g.K, nt = K / BK;
    int ts_lo = 0, ts_hi = 0, nts = 0; const unsigned long long rt_entry = STAMP ? (unsigned long long)wall_clock64() : 0ull;
#define PG8_STAMP() do { if (STAMP && wid == 0 && nts < 64) { const unsigned long long _c = (unsigned long long)clock64(); \
        ts_lo = (lane == nts) ? (int)(unsigned)_c : ts_lo; ts_hi = (lane == nts) ? (int)(unsigned)(_c >> 32) : ts_hi; ++nts; } } while (0)
    PG8_STAMP();
    unsigned voffA[2], voffB[2];
#pragma unroll
    for (int i = 0; i < 2; ++i) { int R, C; stage_rc(tid * 16 + i * 8192, R, C); const int Rb = Epi::PERM ? ((R & ~31) + perm32(R & 31)) : R;
        voffA[i] = (unsigned)(R * K + C) * 2u; voffB[i] = (unsigned)(Rb * K + C) * 2u; }
    const size_t kstep = (size_t)(BK * 2);
    const size_t hstep = (size_t)HALF * K * 2;
    const size_t tstep = 2 * hstep;
    const unsigned ldsw = (unsigned)wid * 1024u;
    const int aoff = lds_byte(wr * 64 + fr, fq * 8), boff = lds_byte(wc * 32 + fr, fq * 8);
#define PG8_SA(b, h) (((b) * 2 + (h)) * HTB)
#define PG8_SB(b, h) ((4 + (b) * 2 + (h)) * HTB)
#define PG8_STAGE(bufoff, gbase, voff) do { _Pragma("unroll") for (int _i = 0; _i < 2; ++_i) \
        __builtin_amdgcn_global_load_lds((const unsigned*)((const char*)(gbase) + (voff)[_i]), (PG8_LAS unsigned*)(lds + (bufoff) + ldsw + _i * 8192), 16, 0, 0); } while (0)
#define PG8_LDA(dst, b, h) do { _Pragma("unroll") for (int m = 0; m < 4; ++m) _Pragma("unroll") for (int k = 0; k < 2; ++k) dst[m][k] = *(const PG8_LAS bf16x8*)(lds + PG8_SA(b, h) + aoff + m * 2048 + k * 1024); } while (0)
#define PG8_LDB(dst, b, h) do { _Pragma("unroll") for (int n = 0; n < 2; ++n) _Pragma("unroll") for (int k = 0; k < 2; ++k) dst[n][k] = *(const PG8_LAS bf16x8*)(lds + PG8_SB(b, h) + boff + n * 2048 + k * 1024); } while (0)
#define PG8_MMA(ai, bj, At, Bt) do { __builtin_amdgcn_s_setprio(1); _Pragma("unroll") for (int m = 0; m < 4; ++m) _Pragma("unroll") for (int n = 0; n < 2; ++n) _Pragma("unroll") for (int k = 0; k < 2; ++k) \
        acc[ai][bj][m][n] = __builtin_amdgcn_mfma_f32_16x16x32_bf16(Bt[n][k], At[m][k], acc[ai][bj][m][n], 0, 0, 0); __builtin_amdgcn_s_setprio(0); } while (0)
#define PG8_WAIT_V(n) asm volatile("s_waitcnt vmcnt(" #n ")" ::: "memory")
#define PG8_WAIT_L(n) asm volatile("s_waitcnt lgkmcnt(" #n ")" ::: "memory")
#define PG8_BAR __builtin_amdgcn_s_barrier()
#define PG8_SCHED __builtin_amdgcn_sched_barrier(0)
    Unit cur, nxt; int ui = 0;
    if (!S.next(0, cur)) return;
    f32x4 acc[2][2][4][2];
#pragma unroll
    for (int a = 0; a < 2; ++a)
#pragma unroll
        for (int b = 0; b < 2; ++b)
#pragma unroll
            for (int m = 0; m < 4; ++m)
#pragma unroll
                for (int n = 0; n < 2; ++n) acc[a][b][m][n] = (f32x4){0.f, 0.f, 0.f, 0.f};
    bf16x8 At[4][2], B0[2][2], B1[2][2];
    const char* cA = (const char*)g.A + (size_t)cur.pm * tstep; const char* cB = (const char*)g.Bt + (size_t)cur.pn * tstep;
    S.a_ready(cur);
    PG8_STAGE(PG8_SB(0, 0), cB, voffB); PG8_STAGE(PG8_SA(0, 0), cA, voffA); PG8_STAGE(PG8_SB(0, 1), cB + hstep, voffB); PG8_STAGE(PG8_SA(0, 1), cA + hstep, voffA);
    if (wr == 1) PG8_BAR;
    PG8_WAIT_V(4); PG8_BAR;
    PG8_STAGE(PG8_SB(1, 0), cB + kstep, voffB); PG8_STAGE(PG8_SA(1, 0), cA + kstep, voffA); PG8_STAGE(PG8_SB(1, 1), cB + hstep + kstep, voffB);
    PG8_WAIT_V(6); PG8_BAR;
    PG8_STAMP();
    for (;;) {
        const bool has_next = S.next(ui + 1, nxt);
        const char* nA = has_next ? (const char*)g.A + (size_t)nxt.pm * tstep : cA; const char* nB = has_next ? (const char*)g.Bt + (size_t)nxt.pn * tstep : cB;
        for (int t = 0; t < nt; t += 2) {
            const bool last = (t == nt - 2);
            const char* a1 = cA + (size_t)(t + 1) * kstep;
            const char* a2 = last ? nA : cA + (size_t)(t + 2) * kstep; const char* b2 = last ? nB : cB + (size_t)(t + 2) * kstep;
            const char* a3 = a2 + kstep; const char* b3 = b2 + kstep;
            if (last && has_next) S.a_ready(nxt);
            PG8_LDB(B0, 0, 0); PG8_SCHED; PG8_LDA(At, 0, 0); PG8_STAGE(PG8_SA(1, 1), a1 + hstep, voffA);
            PG8_WAIT_L(8); PG8_BAR; PG8_WAIT_L(0); PG8_MMA(0, 0, At, B0); PG8_BAR; PG8_SCHED;
            PG8_LDB(B1, 0, 1); PG8_STAGE(PG8_SB(0, 0), b2, voffB);
            PG8_BAR; PG8_WAIT_L(0); PG8_MMA(0, 1, At, B1); PG8_BAR;
            PG8_LDA(At, 0, 1); PG8_STAGE(PG8_SA(0, 0), a2, voffA);
            PG8_BAR; PG8_WAIT_L(0); PG8_MMA(1, 0, At, B0); PG8_BAR; PG8_SCHED;
            PG8_STAGE(PG8_SB(0, 1), b2 + hstep, voffB);
            PG8_WAIT_V(6); PG8_BAR; PG8_MMA(1, 1, At, B1); PG8_BAR;
            PG8_LDB(B0, 1, 0); PG8_SCHED; PG8_LDA(At, 1, 0); PG8_STAGE(PG8_SA(0, 1), a2 + hstep, voffA);
            PG8_WAIT_L(8); PG8_BAR; PG8_WAIT_L(0); PG8_MMA(0, 0, At, B0); PG8_BAR; PG8_SCHED;
            PG8_LDB(B1, 1, 1); PG8_STAGE(PG8_SB(1, 0), b3, voffB);
            PG8_BAR; PG8_WAIT_L(0); PG8_MMA(0, 1, At, B1); PG8_BAR;
            PG8_LDA(At, 1, 1); PG8_STAGE(PG8_SA(1, 0), a3, voffA);
            PG8_BAR; PG8_WAIT_L(0); PG8_MMA(1, 0, At, B0); PG8_BAR; PG8_SCHED;
            PG8_STAGE(PG8_SB(1, 1), b3 + hstep, voffB);
            PG8_WAIT_V(6); PG8_BAR; PG8_MMA(1, 1, At, B1); PG8_BAR;
        }
        PG8_STAMP();
        if constexpr (!Epi::AFTER_DRAIN) { E(acc, cur, wr, wc, fr, fq); S.done(cur); }
        PG8_STAMP();
        if (!has_next) break;
#pragma unroll
        for (int a = 0; a < 2; ++a)
#pragma unroll
            for (int b = 0; b < 2; ++b)
#pragma unroll
                for (int m = 0; m < 4; ++m)
#pragma unroll
                    for (int n = 0; n < 2; ++n) acc[a][b][m][n] = (f32x4){0.f, 0.f, 0.f, 0.f};
        cur = nxt; cA = nA; cB = nB; ++ui;
    }
    PG8_WAIT_V(0);
    if (wr == 0) PG8_BAR;
    PG8_BAR;
    if constexpr (Epi::AFTER_DRAIN) { E.fused(acc, cur, wr, wc, fr, fq, lds, wid, lane); S.done(cur); }
    PG8_STAMP();
    if (STAMP && wid == 0) { stamps[lane] = lane < nts ? (((unsigned long long)(unsigned)ts_hi << 32) | (unsigned)ts_lo) : 0ull;
        if (lane == 62) stamps[62] = rt_entry; if (lane == 63) stamps[63] = (unsigned long long)wall_clock64(); }
#undef PG8_STAMP
#undef PG8_SA
#undef PG8_SB
#undef PG8_STAGE
#undef PG8_LDA
#undef PG8_LDB
#undef PG8_MMA
#undef PG8_WAIT_V
#undef PG8_WAIT_L
#undef PG8_BAR
#undef PG8_SCHED
}
}

__device__ __forceinline__ int win_src_col(int n) {
    if (n < 4224) return n;
    if (n < 4272) return 7808 + (n - 4224);
    if (n < 4352) return -1;
    if (n < 7936) return 4224 + (n - 4352);
    return 7856 + (n - 7936);
}
template <int MODE>
__device__ __forceinline__ void transpose_tiles(const float* __restrict__ src, int K, int ldsrc, bf16* __restrict__ dst, int N, LAS float* tile, int bid, int nb) {
    const int tid = threadIdx.x;
    const int tk = K / 64, tn = N / 64;
    const int total = tk * tn;
    constexpr int TPT = 4;
    for (int it0 = bid; it0 < total; it0 += TPT * nb) {
#pragma unroll
        for (int u = 0; u < TPT; ++u) {
            const int it = it0 + u * nb;
            if (it < total) {
                const int k0 = (it % tk) * 64, n0 = (it / tk) * 64;
                const int nl = tid & 63, kg = tid >> 6;
                const int n = n0 + nl; const int c = MODE == 0 ? win_src_col(n) : n;
#pragma unroll
                for (int kk = 0; kk < 8; ++kk) { const int k = kg * 8 + kk; tile[u * 64 * 65 + k * 65 + nl] = c >= 0 ? src[(size_t)(k0 + k) * ldsrc + c] : 0.f; }
            }
        }
        __syncthreads();
#pragma unroll
        for (int u = 0; u < TPT; ++u) {
            const int it = it0 + u * nb;
            if (it < total) {
                const int k0 = (it % tk) * 64, n0 = (it / tk) * 64;
                const int nn = tid >> 3, kc = tid & 7;
                float v[8];
#pragma unroll
                for (int i = 0; i < 8; ++i) v[i] = tile[u * 64 * 65 + (kc * 8 + i) * 65 + nn];
                u32x4 w; w.x = pk2bf(v[0], v[1]); w.y = pk2bf(v[2], v[3]); w.z = pk2bf(v[4], v[5]); w.w = pk2bf(v[6], v[7]);
                *(u32x4*)(dst + (size_t)(n0 + nn) * K + k0 + kc * 8) = w;
            }
        }
        __syncthreads();
    }
}

template <bool SAMPLE>
__device__ __forceinline__ void compress_item(const Args& a, int b, int n0, int cnt, LAS float* pooled  ) {
    const int col = threadIdx.x, kv = col >> 8, g = (col >> 6) & 3, e = col & 63;
    const int* pt = (const int*)a.in[7];
    LAS float* pwl = pooled + 32 * 512;
#pragma unroll
    for (int i = 0; i < 8; ++i) { const int idx = i * 512 + col; pwl[idx] = a.in[(idx >> 11) ? 21 : 20][idx & 2047]; }
    __syncthreads();
    const LAS float* pw = pwl + kv * 2048 + e;
    float prevP0 = 0.f;
    const int last = n0 + cnt;
#define CMP_LD(cc, x) { const int c_ = (cc); const float* rp; \
        if (SAMPLE) { const int r0 = 16 * c_; rp = a.in[2] + ((size_t)pt[b * NPAGES + (r0 >> 7)] * PAGE + (r0 & 127)) * 512 + col; } \
        else rp = a.out + O_PCMP + ((size_t)b * SEQ + 16 * c_) * 512 + col; \
        _Pragma("unroll") for (int s = 0; s < 16; ++s) x[s] = rp[(size_t)s * 512]; }
#define CMP_PROC(cc, x) { const int c_ = (cc); float P0 = 0.f, P1 = 0.f; \
        _Pragma("unroll") for (int s = 0; s < 16; ++s) { P0 += x[s] * pw[s * 64]; P1 += x[s] * pw[(16 + s) * 64]; } \
        if (c_ > n0) pooled[(c_ - 1 - n0) * 512 + col] = prevP0 + P1; \
        prevP0 = P0; }
    float xa[16], xb[16], xc[16];
    CMP_LD(n0, xa)
    CMP_LD(n0 + 1 < last ? n0 + 1 : last, xb)
    for (int c = n0; c <= last; c += 3) {
        CMP_LD(c + 2 < last ? c + 2 : last, xc)
        CMP_PROC(c, xa)
        CMP_LD(c + 3 < last ? c + 3 : last, xa)
        if (c + 1 <= last) CMP_PROC(c + 1, xb)
        CMP_LD(c + 4 < last ? c + 4 : last, xb)
        if (c + 2 <= last) CMP_PROC(c + 2, xc)
    }
#undef CMP_LD
#undef CMP_PROC
    __syncthreads();
    const float* wc = a.in[kv ? 23 : 22];
    float wcol[64];
#pragma unroll
    for (int d = 0; d < 64; ++d) wcol[d] = wc[d * 64 + e];
    float* dstb = (float*)(a.ws + (SAMPLE ? (kv ? WS_VCS : WS_KCS) : (kv ? WS_VCP : WS_KCP))) + (size_t)b * (SAMPLE ? NCB_S : NCB_P) * 256;
    for (int blk = 0; blk < cnt; ++blk) {
        const LAS float* pp = pooled + blk * 512 + (col & ~63);
        float acc = 0.f;
#pragma unroll
        for (int d = 0; d < 64; d += 4) { const f32x4 p4 = *(const LAS f32x4*)(pp + d); acc += p4.x * wcol[d] + p4.y * wcol[d + 1] + p4.z * wcol[d + 2] + p4.w * wcol[d + 3]; }
        if (SAMPLE) dstb[((size_t)(n0 + blk) * 4 + g) * 64 + e] = acc;
        else ((bf16*)(a.ws + (kv ? WS_VCP : WS_KCP)))[((size_t)(b * 4 + g) * 128 + (n0 + blk)) * 64 + e] = f2bf(acc);
    }
    __syncthreads();
}

__device__ __forceinline__ void p0_prologue(const Args& a, LAS unsigned char* lds) {
    const int tid = threadIdx.x, lane = tid & 63, wave = tid >> 6, bid = blockIdx.x, nb = gridDim.x;
    LAS float* tile = (LAS float*)lds;
    transpose_tiles<0>(a.in[9], D, IN_COLS, (bf16*)(a.ws + WS_WIN_T), NIN, tile, bid, nb);
    transpose_tiles<1>(a.in[24], 1024, D, (bf16*)(a.ws + WS_WPAB_T), D, tile, bid, nb);
    transpose_tiles<1>(a.in[25], 1024, D, (bf16*)(a.ws + WS_WPAB_T) + (size_t)D * 1024, D, tile, bid, nb);
    transpose_tiles<1>(a.in[26], D, D, (bf16*)(a.ws + WS_WO_T), D, tile, bid, nb);
    {
        bf16* XN = (bf16*)(a.ws + WS_XN);
        const float* gin = a.in[8];
        for (int r = bid * 8 + wave; r < MPAD; r += nb * 8) {
            bf16* dst = XN + (size_t)r * D;
            if (r >= MT) {
#pragma unroll
                for (int i = 0; i < 4; ++i) *(u32x4*)(dst + i * 512 + lane * 8) = (u32x4){0u, 0u, 0u, 0u};
            } else {
                const float* x = r < MP ? a.in[0] + (size_t)r * D : a.in[1] + (size_t)(r - MP) * D;
                f32x4 v[8]; float ss = 0.f;
#pragma unroll
                for (int i = 0; i < 8; ++i) { v[i] = *(const f32x4*)(x + i * 256 + lane * 4); ss += v[i].x * v[i].x + v[i].y * v[i].y + v[i].z * v[i].z + v[i].w * v[i].w; }
                ss = wave_sum(ss);
                const float rs = rsqrtf(ss * (1.0f / D) + RMS_EPS);
#pragma unroll
                for (int i = 0; i < 8; ++i) { const f32x4 gg = *(const f32x4*)(gin + i * 256 + lane * 4);
                    u32x2 w; w.x = pk2bf(v[i].x * rs * gg.x, v[i].y * rs * gg.y); w.y = pk2bf(v[i].z * rs * gg.z, v[i].w * rs * gg.w);
                    *(u32x2*)(dst + i * 256 + lane * 4) = w; }
            }
        }
    }
    {
        const f32x4* src = (const f32x4*)a.in[4]; f32x4* dst = (f32x4*)(a.out + O_SWIN);
        const size_t n4 = (size_t)DB * 508 * 128;
        const size_t step = (size_t)nb * 512;
        for (size_t i0 = (size_t)bid * 512 + tid; i0 < n4; i0 += 8 * step) {
            f32x4 v[8];
#pragma unroll
            for (int u = 0; u < 8; ++u) { const size_t i = i0 + u * step; if (i < n4) { const size_t bb = i / (508 * 128), rem = i % (508 * 128); v[u] = src[bb * 512 * 128 + 4 * 128 + rem]; } }
#pragma unroll
            for (int u = 0; u < 8; ++u) { const size_t i = i0 + u * step; if (i < n4) { const size_t bb = i / (508 * 128), rem = i % (508 * 128); dst[bb * 512 * 128 + rem] = v[u]; } }
        }
        bf16* OAB = (bf16*)(a.ws + WS_OAB);
        for (int i = bid * 512 + tid; i < 2 * 128 * 128; i += nb * 512) { const int hf = i / (128 * 128), rem = i % (128 * 128); *(u32x4*)(OAB + ((size_t)hf * MPAD + MT) * 1024 + (size_t)rem * 8) = (u32x4){0u, 0u, 0u, 0u}; }
    }
    {
        bf16* WUPT = (bf16*)(a.ws + WS_WUPT);
        for (int i = bid * 512 + tid; i < 2 * 1024 * 8; i += nb * 512) { const int mat = i >> 13, c = (i >> 3) & 1023, m8 = (i & 7) * 8; const float* src = a.in[mat ? 14 : 12] + (size_t)m8 * AW + c;
            u32x4 w; w.x = pk2bf(src[0], src[AW]); w.y = pk2bf(src[2 * AW], src[3 * AW]); w.z = pk2bf(src[4 * AW], src[5 * AW]); w.w = pk2bf(src[6 * AW], src[7 * AW]);
            *(u32x4*)(WUPT + ((size_t)mat * 1024 + c) * 64 + m8) = w; }
    }
    __syncthreads();
    for (int it = bid; it < DB * 16; it += nb) { const int b = it >> 4, n0 = (it & 15) * 32; const int cnt = (NCMP_S - n0) < 32 ? (NCMP_S - n0) : 32; compress_item<true>(a, b, n0, cnt, tile); }
}

struct EpiG1 {
    static constexpr bool PERM = true, AFTER_DRAIN = false;
    bf16* UA; bf16* QG; float* KVW; bf16* GATES; float* out; bf16* KVSB; bf16* KVWB;
    __device__ __forceinline__ void operator()(const pg8::f32x4 (&acc)[2][2][4][2], const pg8::Unit& u, int wr, int wc, int fr, int fq) const {
        const int pn = u.pn;
        const int row0 = u.pm * 256 + wr * 64 + fr, cl0 = wc * 32 + fq * 8;
        if (pn <= 16) {
#pragma unroll
            for (int ai = 0; ai < 2; ++ai)
#pragma unroll
                for (int m = 0; m < 4; ++m) {
                    const int row = row0 + ai * 128 + m * 16;
                    const bool lastp = row < MP && (row & (SEQ - 1)) == SEQ - 1, lasts = row >= MP && row < MT && ((row - MP) & 3) == 3;
#pragma unroll
                    for (int bj = 0; bj < 2; ++bj) {
                        const int col = pn * 256 + bj * 128 + cl0;
                        const pg8::f32x4 v0 = acc[ai][bj][m][0], v1 = acc[ai][bj][m][1];
                        u32x4 w; w.x = pg8::cvt_pk_bf16(v0[0], v0[1]); w.y = pg8::cvt_pk_bf16(v0[2], v0[3]); w.z = pg8::cvt_pk_bf16(v1[0], v1[1]); w.w = pg8::cvt_pk_bf16(v1[2], v1[3]);
                        *(u32x4*)(UA + (size_t)row * UA_LD + col) = w;
                        if ((lastp || lasts) && col < ACOLS) {
                            float* d = lastp ? out + O_PSHIFT + (size_t)(row >> 11) * ACOLS + col : out + O_SSHIFT + (size_t)((row - MP) >> 2) * ACOLS + col;
                            *(pg8::f32x4*)d = v0; *(pg8::f32x4*)(d + 4) = v1;
                        }
                    }
                }
        } else if (pn <= 24) {
#pragma unroll
            for (int ai = 0; ai < 2; ++ai)
#pragma unroll
                for (int m = 0; m < 4; ++m) {
                    const int row = row0 + ai * 128 + m * 16;
#pragma unroll
                    for (int bj = 0; bj < 2; ++bj) {
                        const int col = (pn - 17) * 256 + bj * 128 + cl0;
                        const pg8::f32x4 v0 = acc[ai][bj][m][0], v1 = acc[ai][bj][m][1];
                        u32x4 w; w.x = pg8::cvt_pk_bf16(v0[0], v0[1]); w.y = pg8::cvt_pk_bf16(v0[2], v0[3]); w.z = pg8::cvt_pk_bf16(v1[0], v1[1]); w.w = pg8::cvt_pk_bf16(v1[2], v1[3]);
                        *(u32x4*)(QG + (size_t)row * 2048 + col) = w;
                    }
                }
        } else if (pn <= 30) {
#pragma unroll
            for (int ai = 0; ai < 2; ++ai)
#pragma unroll
                for (int m = 0; m < 4; ++m) {
                    const int row = row0 + ai * 128 + m * 16;
#pragma unroll
                    for (int bj = 0; bj < 2; ++bj) {
                        const int cb = (pn - 25) * 256 + bj * 128 + cl0, which = cb >> 9, cc = cb & 511;
                        const pg8::f32x4 v0 = acc[ai][bj][m][0], v1 = acc[ai][bj][m][1];
                        float* d = nullptr;
                        if (which >= 1) {
                            const float ks = cc < 256 ? 0.125f * 1.4426950408889634f : 1.0f;
                            u32x4 w; w.x = pg8::cvt_pk_bf16(v0[0] * ks, v0[1] * ks); w.y = pg8::cvt_pk_bf16(v0[2] * ks, v0[3] * ks); w.z = pg8::cvt_pk_bf16(v1[0] * ks, v1[1] * ks); w.w = pg8::cvt_pk_bf16(v1[2] * ks, v1[3] * ks);
                            *(u32x4*)((which == 1 ? KVSB : KVWB) + (size_t)row * 512 + cc) = w; }
                        if (which == 2) {
                            if (row < MP) { const int t = row & (SEQ - 1); if (t >= SEQ - 512) d = out + O_PWIN + ((size_t)(row >> 11) * 512 + (t - (SEQ - 512))) * 512 + cc; }
                            else if (row < MT) { const int si = row - MP; d = out + O_SWIN + ((size_t)(si >> 2) * 512 + 508 + (si & 3)) * 512 + cc; }
                        } else {
                            if (row < MP) d = out + (which ? O_PSEL : O_PCMP) + (size_t)row * 512 + cc;
                            else if (row < MT) d = out + (which ? O_SSEL : O_SCMP) + (size_t)(row - MP) * 512 + cc;
                        }
                        if (d) { *(pg8::f32x4*)d = v0; *(pg8::f32x4*)(d + 4) = v1; }
                    }
                }
        } else {
#pragma unroll
            for (int ai = 0; ai < 2; ++ai)
#pragma unroll
                for (int m = 0; m < 4; ++m) {
                    const int row = row0 + ai * 128 + m * 16;
#pragma unroll
                    for (int bj = 0; bj < 2; ++bj) {
                        const int col = (pn - 31) * 256 + bj * 128 + cl0;
                        const pg8::f32x4 v0 = acc[ai][bj][m][0], v1 = acc[ai][bj][m][1];
                        u32x4 w; w.x = pg8::cvt_pk_bf16(v0[0], v0[1]); w.y = pg8::cvt_pk_bf16(v0[2], v0[3]); w.z = pg8::cvt_pk_bf16(v1[0], v1[1]); w.w = pg8::cvt_pk_bf16(v1[2], v1[3]);
                        *(u32x4*)(GATES + (size_t)row * 4096 + col) = w;
                    }
                }
        }
    }
};

typedef short bf16x8v __attribute__((ext_vector_type(8)));
typedef float f32x16 __attribute__((ext_vector_type(16)));

__device__ __forceinline__ void unpack8(const u32x4 w, float (&f)[8]) {
    f[0] = __uint_as_float(w.x << 16); f[1] = __uint_as_float(w.x & 0xffff0000u); f[2] = __uint_as_float(w.y << 16); f[3] = __uint_as_float(w.y & 0xffff0000u);
    f[4] = __uint_as_float(w.z << 16); f[5] = __uint_as_float(w.z & 0xffff0000u); f[6] = __uint_as_float(w.w << 16); f[7] = __uint_as_float(w.w & 0xffff0000u);
}
constexpr int CK_PT = 0;
constexpr int CK_VT = 4096;
constexpr int CK_KB = 6144;
constexpr int CK_AO = 10240;
constexpr int CK_WM = 11264;
constexpr int CK_GC = 11776;
constexpr int CK_BYTES = 12288;
typedef float f32x4v __attribute__((ext_vector_type(4)));
#define DPPO(x, ctrl, oldv) __int_as_float(__builtin_amdgcn_update_dpp(__float_as_int(oldv), __float_as_int(x), (ctrl), 0xf, 0xf, false))

__device__ __forceinline__ void chunk_core(float (&w)[16], float (&kk)[16], float (&bb)[16], float (&kx)[16], float (&rx)[16], const float (&vs)[16], unsigned char* __restrict__ rec  ,
                                           LAS unsigned char* wl  , int lane) {
    const int s = lane & 15, q = lane >> 4;
    u32x4 fat[2], fbt[2], fkt[2], frt[2];
    unsigned short hkb[16], hbb[16], hat[16];
    float gg[16], ig[16];
    typedef __attribute__((address_space(1))) unsigned char gbyte;
    typedef __attribute__((address_space(1))) bf16 gbf16;
    typedef __attribute__((address_space(1))) float gf32;
    gbyte* gcb = (gbyte*)(rec + CK_GC + 8 * q * 4);
    gbyte* kbb = (gbyte*)(rec + CK_KB + (8 * q * 32 + s) * 2);
    gbyte* vtb = (gbyte*)(rec + CK_VT + (8 * q * 16 + s) * 2);
    gbyte* ptb = (gbyte*)(rec + CK_PT + ((16 + 4 * q) * 64 + s) * 2);
    gbyte* wmb = (gbyte*)(rec + CK_WM + (4 * q * 16 + s) * 2);
    asm volatile("" : "+v"(gcb), "+v"(kbb), "+v"(vtb), "+v"(ptb), "+v"(wmb));
#pragma unroll
    for (int e = 0; e < 16; ++e) {
        float g = w[e];
        g *= DPPO(g, 0x111, 1.0f); g *= DPPO(g, 0x112, 1.0f); g *= DPPO(g, 0x114, 1.0f); g *= DPPO(g, 0x118, 1.0f);
        gg[e] = g;
    }
#pragma unroll
    for (int e = 0; e < 16; e += 4) {
        const float p01 = gg[e] * gg[e + 1], p23 = gg[e + 2] * gg[e + 3], inv = 1.0f / (p01 * p23), i01 = p23 * inv, i23 = p01 * inv;
        ig[e] = gg[e + 1] * i01; ig[e + 1] = gg[e] * i01; ig[e + 2] = gg[e + 3] * i23; ig[e + 3] = gg[e + 2] * i23;
    }
#pragma unroll
    for (int e = 0; e < 16; ++e) {
        const float g = gg[e];
        const float gp = DPPO(g, 0x111, 1.0f);
        const float g16 = __shfl(g, (lane & 48) | 15);
        const float at = kk[e] * gp, bt = bb[e] * ig[e], kt = kx[e] * ig[e], rt = rx[e] * g, rr = g16 * ig[e];
        hat[e] = f2bf(at); hkb[e] = f2bf(kx[e] * rr); hbb[e] = f2bf(bb[e] * rr);
        w[e] = at; kk[e] = bt; bb[e] = kt; kx[e] = rt;
        if (s == 15) *(gf32*)(gcb + (32 * (e >> 3) + (e & 7)) * 4) = g;
    }
#pragma unroll
    for (int u = 0; u < 2; ++u) {
        fat[u] = (u32x4){pk2bf(w[8 * u], w[8 * u + 1]), pk2bf(w[8 * u + 2], w[8 * u + 3]), pk2bf(w[8 * u + 4], w[8 * u + 5]), pk2bf(w[8 * u + 6], w[8 * u + 7])};
        fbt[u] = (u32x4){pk2bf(kk[8 * u], kk[8 * u + 1]), pk2bf(kk[8 * u + 2], kk[8 * u + 3]), pk2bf(kk[8 * u + 4], kk[8 * u + 5]), pk2bf(kk[8 * u + 6], kk[8 * u + 7])};
        fkt[u] = (u32x4){pk2bf(bb[8 * u], bb[8 * u + 1]), pk2bf(bb[8 * u + 2], bb[8 * u + 3]), pk2bf(bb[8 * u + 4], bb[8 * u + 5]), pk2bf(bb[8 * u + 6], bb[8 * u + 7])};
        frt[u] = (u32x4){pk2bf(kx[8 * u], kx[8 * u + 1]), pk2bf(kx[8 * u + 2], kx[8 * u + 3]), pk2bf(kx[8 * u + 4], kx[8 * u + 5]), pk2bf(kx[8 * u + 6], kx[8 * u + 7])};
        *(u32x4*)(rec + CK_PT + s * 128 + (32 * u + 8 * q) * 2) = frt[u];
    }
    {
#pragma unroll
        for (int e = 0; e < 16; ++e) { const int jo = 32 * (e >> 3) + (e & 7); *(gbf16*)(kbb + jo * 64) = hkb[e]; *(gbf16*)(kbb + jo * 64 + 32) = hbb[e]; }
#pragma unroll
        for (int e = 0; e < 16; ++e) *(gbf16*)(vtb + (32 * (e >> 3) + (e & 7)) * 32) = f2bf(vs[e]);
    }
    typedef float f32x4c __attribute__((ext_vector_type(4)));
    f32x4c aba = {0.f, 0.f, 0.f, 0.f}, aka = aba, abr = aba, akr = aba;
#pragma unroll
    for (int u = 0; u < 2; ++u) {
        const bf16x8v Bt_ = __builtin_bit_cast(bf16x8v, fbt[u]), Kt_ = __builtin_bit_cast(bf16x8v, fkt[u]), At_ = __builtin_bit_cast(bf16x8v, fat[u]), Rt_ = __builtin_bit_cast(bf16x8v, frt[u]);
        aba = __builtin_amdgcn_mfma_f32_16x16x32_bf16(Bt_, At_, aba, 0, 0, 0); aka = __builtin_amdgcn_mfma_f32_16x16x32_bf16(Kt_, At_, aka, 0, 0, 0);
        abr = __builtin_amdgcn_mfma_f32_16x16x32_bf16(Bt_, Rt_, abr, 0, 0, 0); akr = __builtin_amdgcn_mfma_f32_16x16x32_bf16(Kt_, Rt_, akr, 0, 0, 0);
    }
    LAS float* Aba = (LAS float*)wl;
    LAS float* Aka = Aba + 256;
    LAS float* Tm = Aka + 256;
    LAS bf16* AtT = (LAS bf16*)(Tm + 256);
    {
        const int t = s;
        u32x2 wkr, wbr;
        float vkr[4], vbr[4];
#pragma unroll
        for (int e = 0; e < 4; ++e) { const int sr = 4 * q + e; Aba[sr * 16 + t] = sr < t ? aba[e] : 0.f; Aka[sr * 16 + t] = sr < t ? aka[e] : 0.f; vkr[e] = sr <= t ? akr[e] : 0.f; vbr[e] = sr <= t ? abr[e] : 0.f; }
        wkr = (u32x2){pk2bf(vkr[0], vkr[1]), pk2bf(vkr[2], vkr[3])}; wbr = (u32x2){pk2bf(vbr[0], vbr[1]), pk2bf(vbr[2], vbr[3])};
        *(u32x2*)(rec + CK_AO + t * 64 + (4 * q) * 2) = wkr; *(u32x2*)(rec + CK_AO + t * 64 + (16 + 4 * q) * 2) = wbr;
#pragma unroll
        for (int e = 0; e < 16; ++e) { const int j = 32 * (e >> 3) + 8 * q + (e & 7); AtT[j * 16 + s] = hat[e]; }
    }
    asm volatile("s_waitcnt lgkmcnt(0)" ::: "memory");
    float Tc[16];
#pragma unroll
    for (int t = 0; t < 16; ++t) {
        float c = s == t ? 1.0f : 0.f;
#pragma unroll
        for (int m = 0; m < t; ++m) c -= Tc[m] * Aba[m * 16 + t];
        Tc[t] = c;
    }
    if (q == 0) {
#pragma unroll
        for (int t = 0; t < 16; ++t) Tm[s * 16 + t] = Tc[t];
    }
    asm volatile("s_waitcnt lgkmcnt(0)" ::: "memory");
    {
        float wm[4] = {0.f, 0.f, 0.f, 0.f};
#pragma unroll
        for (int m = 0; m < 16; ++m) { const float am = Aka[s * 16 + m];
#pragma unroll
            for (int e = 0; e < 4; ++e) wm[e] += am * Tm[m * 16 + 4 * q + e]; }
#pragma unroll
        for (int e = 0; e < 4; ++e) *(gbf16*)(wmb + e * 32) = f2bf(wm[e]);
    }
    {
        u32x4 ta = {0u, 0u, 0u, 0u};
        if (q < 2) { float tv[8];
#pragma unroll
            for (int e = 0; e < 8; ++e) tv[e] = Tm[(8 * q + e) * 16 + s];
            ta = (u32x4){pk2bf(tv[0], tv[1]), pk2bf(tv[2], tv[3]), pk2bf(tv[4], tv[5]), pk2bf(tv[6], tv[7])}; }
#pragma unroll
        for (int nt = 0; nt < 4; ++nt) {
            u32x4 tb = {0u, 0u, 0u, 0u};
            if (q < 2) tb = *(const LAS u32x4*)(AtT + (16 * nt + s) * 16 + 8 * q);
            f32x4c pa = {0.f, 0.f, 0.f, 0.f};
            pa = __builtin_amdgcn_mfma_f32_16x16x32_bf16(__builtin_bit_cast(bf16x8v, ta), __builtin_bit_cast(bf16x8v, tb), pa, 0, 0, 0);
#pragma unroll
            for (int e = 0; e < 4; ++e) *(gbf16*)(ptb + e * 128 + nt * 32) = f2bf(pa[e]);
        }
    }
}

__device__ __forceinline__ bool c_never(int tid) { int x = tid; asm volatile("" : "+v"(x)); return x < 0; }
constexpr int SQ_SSTR = 144, SQ_ASTR = 80;
__device__ __forceinline__ void chain_seq(const unsigned char* __restrict__ recsA, const unsigned char* __restrict__ recsB  , int nchunks,
                                          float* __restrict__ SoutA, float* __restrict__ SoutB, float* __restrict__ orawA, float* __restrict__ orawB  , LAS unsigned char* lds) {
    int tid_ = threadIdx.x; asm volatile("" : "+v"(tid_));
    const int tid = tid_, lane = tid & 63, w = tid >> 6, r = lane & 31, hh = lane >> 5;
    const int it = (w >> 1) & 1, jt = w & 1, cb = w >> 2;
    const unsigned char* recs = cb ? recsB : recsA; float* Sout = cb ? SoutB : SoutA; float* oraw = cb ? orawB : orawA;
    const bool act = true, xw = jt == 0;
    LAS unsigned char* Sb = lds + cb * (64 * SQ_SSTR + 2 * 64 * SQ_ASTR);
    LAS unsigned char* Av0 = Sb + 64 * SQ_SSTR;
    f32x16 S;
#pragma unroll
    for (int i = 0; i < 16; ++i) S[i] = 0.f;
    __syncthreads();
    bf16x8v pf[4], wmf, aof[2], kbf[2], vtf; float gc = 0.f; u32x4 vcp = {0u, 0u, 0u, 0u};
    bf16x8v n_pf[4], n_wmf, n_aof[2], n_kbf[2], n_vtf; float n_gc = 0.f; u32x4 n_vcp = {0u, 0u, 0u, 0u};
    const u32x4 z4 = {0u, 0u, 0u, 0u};
#define SQ_LOAD(rec, PF, WMF, AOF, KBF, VTF, GC, VCP) { \
        if (act) { _Pragma("unroll") for (int ks = 0; ks < 2; ++ks) KBF[ks] = *(const bf16x8v*)((rec) + CK_KB + (32 * jt + r) * 64 + (16 * ks + 8 * hh) * 2); \
            GC = ((const float*)((rec) + CK_GC))[32 * jt + r]; } \
        if (xw) { _Pragma("unroll") for (int ks = 0; ks < 4; ++ks) PF[ks] = *(const bf16x8v*)((rec) + CK_PT + r * 128 + (16 * ks + 8 * hh) * 2); \
            WMF = r >= 16 ? *(const bf16x8v*)((rec) + CK_WM + (r - 16) * 32 + 8 * hh * 2) : __builtin_bit_cast(bf16x8v, z4); \
            _Pragma("unroll") for (int ks = 0; ks < 2; ++ks) AOF[ks] = r < 16 ? *(const bf16x8v*)((rec) + CK_AO + r * 64 + (16 * ks + 8 * hh) * 2) : __builtin_bit_cast(bf16x8v, z4); \
            VTF = *(const bf16x8v*)((rec) + CK_VT + (32 * it + r) * 32 + 8 * hh * 2); } \
        if ((tid & 255) < 128) VCP = *(const u32x4*)((rec) + CK_VT + ((tid & 255) >> 1) * 32 + (tid & 1) * 16); }
    SQ_LOAD(recs, n_pf, n_wmf, n_aof, n_kbf, n_vtf, n_gc, n_vcp)
    unsigned tacc = 0u, tprev = 0u;
    for (int c = 0; c < nchunks; ++c) {
#pragma unroll
        for (int ks = 0; ks < 4; ++ks) pf[ks] = n_pf[ks];
        wmf = n_wmf; aof[0] = n_aof[0]; aof[1] = n_aof[1]; kbf[0] = n_kbf[0]; kbf[1] = n_kbf[1]; vtf = n_vtf; gc = n_gc; vcp = n_vcp;
        { const unsigned char* recn = recs + (size_t)(c + 1 < nchunks ? c + 1 : c) * CK_BYTES; SQ_LOAD(recn, n_pf, n_wmf, n_aof, n_kbf, n_vtf, n_gc, n_vcp) }
        tacc ^= tprev;
        if ((tid & 255) < 96) tprev = *(const unsigned*)(recs + (size_t)(c + 3 < nchunks ? c + 3 : nchunks - 1) * CK_BYTES + (tid & 255) * 128);
        LAS unsigned char* Av = Av0 + (c & 1) * 64 * SQ_ASTR;
        if (act) {
#pragma unroll
            for (int i = 0; i < 16; ++i) { const int row = 32 * it + (i & 3) + 8 * (i >> 2) + 4 * hh; *(LAS bf16*)(Sb + row * SQ_SSTR + (32 * jt + r) * 2) = f2bf(S[i]); }
        }
        if ((tid & 255) < 128) *(LAS u32x4*)(Av + ((tid & 255) >> 1) * SQ_ASTR + (tid & 1) * 16) = vcp;
        __syncthreads();
        f32x16 X;
        if (xw) {
#pragma unroll
            for (int i = 0; i < 16; ++i) X[i] = 0.f;
#pragma unroll
            for (int ks = 0; ks < 4; ++ks) { const bf16x8v sf = *(const LAS bf16x8v*)(Sb + (32 * it + r) * SQ_SSTR + (16 * ks + 8 * hh) * 2); X = __builtin_amdgcn_mfma_f32_32x32x16_bf16(sf, pf[ks], X, 0, 0, 0); }
            X = __builtin_amdgcn_mfma_f32_32x32x16_bf16(vtf, wmf, X, 0, 0, 0);
            if (r >= 16) {
#pragma unroll
                for (int i = 0; i < 16; ++i) { const int row = 32 * it + (i & 3) + 8 * (i >> 2) + 4 * hh; *(LAS bf16*)(Av + row * SQ_ASTR + (16 + (r - 16)) * 2) = f2bf(-X[i]); }
            }
        }
        __syncthreads();
        if (act) {
            bf16x8v af[2];
#pragma unroll
            for (int ks = 0; ks < 2; ++ks) af[ks] = *(const LAS bf16x8v*)(Av + (32 * it + r) * SQ_ASTR + (16 * ks + 8 * hh) * 2);
            if (xw) {
#pragma unroll
                for (int ks = 0; ks < 2; ++ks) X = __builtin_amdgcn_mfma_f32_32x32x16_bf16(af[ks], aof[ks], X, 0, 0, 0);
                if (r < 16) { float* od = oraw + (size_t)(c * 16 + r) * 1024 + 32 * it + 4 * hh;
#pragma unroll
                    for (int g4 = 0; g4 < 4; ++g4) *(f32x4*)(od + 8 * g4) = (f32x4){X[4 * g4], X[4 * g4 + 1], X[4 * g4 + 2], X[4 * g4 + 3]}; }
            }
#pragma unroll
            for (int i = 0; i < 16; ++i) S[i] *= gc;
#pragma unroll
            for (int ks = 0; ks < 2; ++ks) S = __builtin_amdgcn_mfma_f32_32x32x16_bf16(af[ks], kbf[ks], S, 0, 0, 0);
        }
    }
    __syncthreads();
    if (act) {
#pragma unroll
        for (int i = 0; i < 16; ++i) { const int row = 32 * it + (i & 3) + 8 * (i >> 2) + 4 * hh; Sout[row * 64 + 32 * jt + r] = S[i]; }
    }
    if ((tacc ^ tprev) == 0x9e3779b9u && c_never(tid)) Sout[0] = 0.f;
    __syncthreads();
#undef SQ_LOAD
}


__device__ __forceinline__ void shifted8(const Args& a, const bf16* UA, int row, int col, float (&us)[8]) {
    float u[8], p[8];
    unpack8(*(const u32x4*)(UA + (size_t)row * UA_LD + col), u);
    bool first;
    if (row < MP) first = (row & (SEQ - 1)) == 0; else first = ((row - MP) & 3) == 0;
    if (!first) unpack8(*(const u32x4*)(UA + (size_t)(row - 1) * UA_LD + col), p);
    else if (row < MP) {
#pragma unroll
        for (int i = 0; i < 8; ++i) p[i] = 0.f;
    } else { const float* sp = a.in[6] + (size_t)((row - MP) >> 2) * ACOLS + col; const f32x4 s0 = *(const f32x4*)sp, s1 = *(const f32x4*)(sp + 4);
        p[0] = s0.x; p[1] = s0.y; p[2] = s0.z; p[3] = s0.w; p[4] = s1.x; p[5] = s1.y; p[6] = s1.z; p[7] = s1.w; }
    const float* mu = a.in[10] + col; const f32x4 m0 = *(const f32x4*)mu, m1 = *(const f32x4*)(mu + 4);
    const float mm[8] = {m0.x, m0.y, m0.z, m0.w, m1.x, m1.y, m1.z, m1.w};
#pragma unroll
    for (int i = 0; i < 8; ++i) us[i] = u[i] + mm[i] * (p[i] - u[i]);
}

__device__ __forceinline__ void mix8(const Args& a, const u32x4 ur, const u32x4 pr, int row, int col, const LAS float* mu  , float (&us)[8]) {
    float u[8], p[8];
    unpack8(ur, u);
    bool first;
    if (row < MP) first = (row & (SEQ - 1)) == 0; else first = ((row - MP) & 3) == 0;
    if (!first) unpack8(pr, p);
    else if (row < MP) {
#pragma unroll
        for (int i = 0; i < 8; ++i) p[i] = 0.f;
    } else { const float* sp = a.in[6] + (size_t)((row - MP) >> 2) * ACOLS + col; const f32x4 s0 = *(const f32x4*)sp, s1 = *(const f32x4*)(sp + 4);
        p[0] = s0.x; p[1] = s0.y; p[2] = s0.z; p[3] = s0.w; p[4] = s1.x; p[5] = s1.y; p[6] = s1.z; p[7] = s1.w; }
    const f32x4 m0 = *(const LAS f32x4*)mu, m1 = *(const LAS f32x4*)(mu + 4);
    const float mm[8] = {m0.x, m0.y, m0.z, m0.w, m1.x, m1.y, m1.z, m1.w};
#pragma unroll
    for (int i = 0; i < 8; ++i) us[i] = u[i] + mm[i] * (p[i] - u[i]);
}

constexpr size_t WS_AM = WS_KVW;
__device__ __forceinline__ void p2_pre(const Args& a) {
    const bf16* UA = (const bf16*)(a.ws + WS_UA); bf16* AM = (bf16*)(a.ws + WS_AM);
    for (int idx = blockIdx.x * 512 + threadIdx.x; idx < MT * 8; idx += gridDim.x * 512) {
        const int row = idx >> 3, cg = idx & 7, mat = cg >> 2;
        float us[8], us2[8];
        shifted8(a, UA, row, 4096 + cg * 16, us); shifted8(a, UA, row, 4096 + cg * 16 + 8, us2);
        float oa[8], ob[8];
#pragma unroll
        for (int i0 = 0; i0 < 8; i0 += 4) {
            float dA[4], dB[4];
#pragma unroll
            for (int i = 0; i < 4; ++i) { dA[i] = 1.0f + __expf(2.0f * fminf(us[i0 + i], 9.0f)); dB[i] = 1.0f + __expf(2.0f * fminf(us2[i0 + i], 9.0f)); }
            const float a01 = dA[0] * dA[1], a23 = dA[2] * dA[3], ia = 1.0f / (a01 * a23), b01 = dB[0] * dB[1], b23 = dB[2] * dB[3], ib = 1.0f / (b01 * b23);
            const float rA[4] = {dA[1] * a23 * ia, dA[0] * a23 * ia, dA[3] * a01 * ia, dA[2] * a01 * ia}, rB[4] = {dB[1] * b23 * ib, dB[0] * b23 * ib, dB[3] * b01 * ib, dB[2] * b01 * ib};
#pragma unroll
            for (int i = 0; i < 4; ++i) { oa[i0 + i] = mat ? us[i0 + i] : 1.0f - 2.0f * rA[i]; ob[i0 + i] = mat ? us2[i0 + i] : 1.0f - 2.0f * rB[i]; }
        }
        u32x4* d = (u32x4*)(AM + (size_t)row * 128 + cg * 16);
        d[0] = (u32x4){pk2bf(oa[0], oa[1]), pk2bf(oa[2], oa[3]), pk2bf(oa[4], oa[5]), pk2bf(oa[6], oa[7])};
        d[1] = (u32x4){pk2bf(ob[0], ob[1]), pk2bf(ob[2], ob[3]), pk2bf(ob[4], ob[5]), pk2bf(ob[6], ob[7])};
    }
}

constexpr int PREP_W2 = 0, PREP_WSTR = 144, PREP_WL = 2 * 2 * 64 * PREP_WSTR  , PREP_CT = PREP_WL + 8 * 5120;
__device__ __forceinline__ void prep_consts(const Args& a, int hp, LAS unsigned char* lds) {
    LAS float* CT = (LAS float*)(lds + PREP_CT);
    for (int idx = threadIdx.x; idx < 2 * 9 * 64; idx += 512) {
        const int grp = idx / 576, k = (idx % 576) >> 6, c = idx & 63, h = hp + 8 * grp;
        const float* src = k < 4 ? a.in[10] + k * 1024 : (k == 4 ? a.in[11] : k == 5 ? a.in[13] : k == 6 ? a.in[15] : k == 7 ? a.in[16] : a.in[17]);
        CT[idx] = src[h * 64 + c];
    }
    for (int idx = threadIdx.x; idx < 2 * 2 * 64 * 8; idx += 512) {
        const int grp = idx >> 10, mat = (idx >> 9) & 1, col = (idx >> 3) & 63, pc = idx & 7;
        const u32x4 wv = *(const u32x4*)((const bf16*)(a.ws + WS_WUPT) + ((size_t)mat * 1024 + (hp + 8 * grp) * 64 + col) * 64 + pc * 8);
        *(LAS u32x4*)(lds + PREP_W2 + ((grp * 2 + mat) * 64 + col) * PREP_WSTR + pc * 16) = wv;
    }
}
__device__ __forceinline__ void prep_pair(const Args& a, int tt, int hp, LAS unsigned char* lds) {
    int tid_ = threadIdx.x; asm volatile("" : "+v"(tid_));
    const int tid = tid_, lane = tid & 63, wave = tid >> 6;
    const bf16* UA = (const bf16*)(a.ws + WS_UA);
    LAS unsigned char* WL = lds + PREP_WL;
    const int R0 = tt * 64;
    const bool prompt_tile = tt < MP / 64;
    const int grp = wave >> 2, cw = wave & 3, s = lane & 15, q = lane >> 4, h = hp + 8 * grp;
    const int row = R0 + 16 * cw + s;
    bf16x8v amf[2][2];
#pragma unroll
    for (int mat = 0; mat < 2; ++mat)
#pragma unroll
        for (int ks = 0; ks < 2; ++ks) amf[mat][ks] = *(const bf16x8v*)((const bf16*)(a.ws + WS_AM) + (size_t)row * 128 + mat * 64 + ks * 32 + 8 * q);
    asm volatile("" ::: "memory");
    u32x4 raw[2][8];
    {
        const bool first = row < MP ? (row & (SEQ - 1)) == 0 : ((row - MP) & 3) == 0;
#pragma unroll
        for (int u = 0; u < 2; ++u) { const int ch = h * 64 + 32 * u + 8 * q; const bf16* pu = UA + (size_t)row * UA_LD + ch; const bf16* pp = first ? pu : pu - UA_LD;
#pragma unroll
            for (int v4 = 0; v4 < 4; ++v4) { raw[u][v4] = *(const u32x4*)(pu + v4 * 1024); raw[u][4 + v4] = *(const u32x4*)(pp + v4 * 1024); } }
    }
    asm volatile("" ::: "memory");
    typedef float f32x4c_ __attribute__((ext_vector_type(4)));
    f32x4c_ lo[2][4];
    {
        const int wrow = 8 * (s >> 2) + (s & 3);
#pragma unroll
        for (int mat = 0; mat < 2; ++mat)
#pragma unroll
            for (int n = 0; n < 4; ++n) {
                f32x4c_ c = {0.f, 0.f, 0.f, 0.f};
#pragma unroll
                for (int ks = 0; ks < 2; ++ks) {
                    const bf16x8v wf = *(const LAS bf16x8v*)(lds + PREP_W2 + ((grp * 2 + mat) * 64 + 32 * (n >> 1) + 4 * (n & 1) + wrow) * PREP_WSTR + (ks * 32 + 8 * q) * 2);
                    c = __builtin_amdgcn_mfma_f32_16x16x32_bf16(wf, amf[mat][ks], c, 0, 0, 0);
                }
                lo[mat][n] = c;
            }
    }
    {
        float dec[16], kk[16], bb[16], kp[16], rs[16], vs[16];
        float ssq = 0.f, bon = 0.f;
#pragma unroll
        for (int u = 0; u < 2; ++u) {
            const int j0 = 32 * u + 8 * q, ch = h * 64 + j0;
            float r8[8], k8[8], v8[8], g8[8];
            const LAS float* CT = (const LAS float*)(lds + PREP_CT) + grp * 576 + j0;
            mix8(a, raw[u][0], raw[u][4], row, ch, CT, r8); mix8(a, raw[u][1], raw[u][5], row, 1024 + ch, CT + 64, k8); mix8(a, raw[u][2], raw[u][6], row, 2048 + ch, CT + 128, v8); mix8(a, raw[u][3], raw[u][7], row, 3072 + ch, CT + 192, g8);
            float sg[8];
            float c_w0[8], c_a0[8], c_kk[8], c_ka[8], c_rk[8];
            { const f32x4 x0 = *(const LAS f32x4*)(CT + 256), x1 = *(const LAS f32x4*)(CT + 260), y0 = *(const LAS f32x4*)(CT + 320), y1 = *(const LAS f32x4*)(CT + 324),
                          z0 = *(const LAS f32x4*)(CT + 384), z1 = *(const LAS f32x4*)(CT + 388), u0 = *(const LAS f32x4*)(CT + 448), u1 = *(const LAS f32x4*)(CT + 452),
                          t0 = *(const LAS f32x4*)(CT + 512), t1 = *(const LAS f32x4*)(CT + 516);
#pragma unroll
              for (int i = 0; i < 4; ++i) { c_w0[i] = x0[i]; c_w0[4 + i] = x1[i]; c_a0[i] = y0[i]; c_a0[4 + i] = y1[i]; c_kk[i] = z0[i]; c_kk[4 + i] = z1[i]; c_ka[i] = u0[i]; c_ka[4 + i] = u1[i]; c_rk[i] = t0[i]; c_rk[4 + i] = t1[i]; } }
#pragma unroll
            for (int i = 0; i < 8; ++i) {
                const int e = 8 * u + i;
                const float lw = lo[0][2 * u + (i >> 2)][i & 3] + c_w0[i];
                const float la = lo[1][2 * u + (i >> 2)][i & 3] + c_a0[i];
                const float d1 = 1.0f + __expf(-fmaxf(lw, -25.0f)), d2 = 1.0f + __expf(-fmaxf(la, -25.0f)), d3 = 1.0f + __expf(-fmaxf(g8[i], -25.0f));
                const float d12 = d1 * d2, inv = 1.0f / (d12 * d3);
                const float s_lw = d2 * d3 * inv, av = d1 * d3 * inv, s_g = d12 * inv;
                dec[e] = __expf(-0.60653066f * s_lw);
                const float kkv = k8[i] * c_kk[i];
                kk[e] = kkv; ssq += kkv * kkv;
                kp[e] = k8[i] * (1.0f + (av - 1.0f) * c_ka[i]);
                bb[e] = av; rs[e] = r8[i]; vs[e] = v8[i];
                bon += r8[i] * kp[e] * c_rk[i];
                sg[i] = g8[i] * s_g;
            }
            if (row < MT) {
                u32x4 wv; wv.x = pk2bf(v8[0], v8[1]); wv.y = pk2bf(v8[2], v8[3]); wv.z = pk2bf(v8[4], v8[5]); wv.w = pk2bf(v8[6], v8[7]);
                *(u32x4*)((bf16*)(a.ws + WS_VB) + (size_t)row * 1024 + ch) = wv;
                u32x4 ws_; ws_.x = pk2bf(sg[0], sg[1]); ws_.y = pk2bf(sg[2], sg[3]); ws_.z = pk2bf(sg[4], sg[5]); ws_.w = pk2bf(sg[6], sg[7]);
                *(u32x4*)((bf16*)(a.ws + WS_SG) + (size_t)row * 1024 + ch) = ws_;
            }
        }
        ssq = xhalf_sum(x16_sum(ssq)); bon = xhalf_sum(x16_sum(bon));
        const float rn = rsqrtf(fmaxf(ssq, 1e-24f));
#pragma unroll
        for (int e = 0; e < 16; ++e) { kk[e] *= rn; bb[e] *= kk[e]; }
        if (row < MT && q == 0) ((float*)(a.ws + WS_BONUS))[(size_t)row * 16 + h] = bon;
        if (prompt_tile) {
            const int b = R0 / SEQ, c = (R0 % SEQ) / 16 + cw;
            chunk_core(dec, kk, bb, kp, rs, vs, a.ws + WS_CHUNK + ((size_t)(b * 16 + h) * 128 + c) * CK_BYTES, WL + wave * 5120, lane);
        } else if (row < MT) {
            float* P = (float*)(a.ws + WS_PREP) + ((size_t)row * 16 + h) * 384;
#pragma unroll
            for (int u = 0; u < 2; ++u) { const int j0 = 32 * u + 8 * q;
#pragma unroll
                for (int x4 = 0; x4 < 2; ++x4) { const int e = 8 * u + 4 * x4, j = j0 + 4 * x4;
                    *(f32x4*)(P + j) = (f32x4){dec[e], dec[e + 1], dec[e + 2], dec[e + 3]}; *(f32x4*)(P + 64 + j) = (f32x4){kk[e], kk[e + 1], kk[e + 2], kk[e + 3]};
                    *(f32x4*)(P + 128 + j) = (f32x4){bb[e], bb[e + 1], bb[e + 2], bb[e + 3]}; *(f32x4*)(P + 192 + j) = (f32x4){kp[e], kp[e + 1], kp[e + 2], kp[e + 3]};
                    *(f32x4*)(P + 256 + j) = (f32x4){rs[e], rs[e + 1], rs[e + 2], rs[e + 3]}; *(f32x4*)(P + 320 + j) = (f32x4){vs[e], vs[e + 1], vs[e + 2], vs[e + 3]}; } }
        }
    }
}

__device__ __forceinline__ float row16_sum(float x) {
    x += DPPF(x, 0xB1);
    x += DPPF(x, 0x4E);
    x += DPPF(x, 0x141);
    x += DPPF(x, 0x140);
    return x;
}
constexpr int SC_NB = 16, SC_STEP = 384;
typedef float f32x2l __attribute__((ext_vector_type(2)));
__device__ __forceinline__ f32x2l splat2(float x) { return (f32x2l){x, x}; }
__device__ __forceinline__ f32x2l pair_row16_sum(f32x2l v) {
    float x = v.x, y = v.y;
#define SC_STAGE(ctrl) x += DPPF(x, ctrl); asm volatile("" : "+v"(x)); y += DPPF(y, ctrl); asm volatile("" : "+v"(y));
    SC_STAGE(0xB1) SC_STAGE(0x4E) SC_STAGE(0x141) SC_STAGE(0x140)
#undef SC_STAGE
    return (f32x2l){x, y};
}
__device__ __forceinline__ float SFMA(float a, float b, float c) { float d; asm("v_fma_f32 %0, %1, %2, %3" : "=v"(d) : "v"(a), "v"(b), "v"(c)); return d; }
__device__ __forceinline__ float SMUL(float a, float b) { float d; asm("v_mul_f32 %0, %1, %2" : "=v"(d) : "v"(a), "v"(b)); return d; }
__device__ __forceinline__ float row16_sum1(float x) {
    x += DPPF(x, 0xB1); x += DPPF(x, 0x4E); x += DPPF(x, 0x141); x += DPPF(x, 0x140);
    return x;
}
template <int NS>
__device__ __forceinline__ void scan_half(const float* __restrict__ prep  , int T, const float* __restrict__ S0, float* __restrict__ Sout,
                                          float* __restrict__ oraw  , int hf, LAS float* lds) {
    int tid_ = threadIdx.x; asm volatile("" : "+v"(tid_));
    const int tid = tid_, lane = tid & 63, w = tid >> 6, rg = lane >> 4, jl = lane & 15;
    const int rl = w * 4 + rg, row = hf * 32 + rl;
    constexpr size_t SS = (size_t)16 * 384;
    LAS float* stg = lds;
    f32x2l P0 = {0.f, 0.f}, P1 = {0.f, 0.f};
    if (S0) { const f32x4 s4 = *(const f32x4*)(S0 + row * 64 + 4 * jl); P0 = (f32x2l){s4.x, s4.y}; P1 = (f32x2l){s4.z, s4.w}; }
    constexpr int NF4 = NS * 96, NLD = (NF4 + 511) / 512;
    f32x4 sr[2][NLD];
    auto gload = [&](f32x4 (&r)[NLD], int t0) {
#pragma unroll
        for (int i = 0; i < NLD; ++i) { const int e = tid + 512 * i; if (e < NF4) { const int st = e / 96, o4 = e % 96; int t = t0 + st; t = t < T ? t : T - 1; r[i] = *(const f32x4*)(prep + (size_t)t * SS + o4 * 4); } }
    };
    auto lstore = [&](const f32x4 (&r)[NLD], int buf) {
#pragma unroll
        for (int i = 0; i < NLD; ++i) { const int e = tid + 512 * i; if (e < NF4) { const int st = e / 96, o4 = e % 96; *(LAS f32x4*)(stg + (buf * SC_NB + st) * SC_STEP + o4 * 4) = r[i]; } }
    };
    auto batch = [&](int t0, int buf) {
        const LAS float* sb = stg + buf * SC_NB * SC_STEP + 4 * jl;
        const LAS float* vb = stg + buf * SC_NB * SC_STEP + 320 + row;
        f32x4 nw = *(const LAS f32x4*)(sb), nkk = *(const LAS f32x4*)(sb + 64), nb = *(const LAS f32x4*)(sb + 128), nk = *(const LAS f32x4*)(sb + 192), nr = *(const LAS f32x4*)(sb + 256);
        float nv = vb[0], okeep = 0.f;
#pragma unroll
        for (int s = 0; s < NS; ++s) {
            const f32x4 cw = nw, ckk = nkk, cb = nb, ck = nk, cr = nr; const float cv = nv;
            if (s + 1 < NS) {
                nw = *(const LAS f32x4*)(sb + (s + 1) * SC_STEP); nkk = *(const LAS f32x4*)(sb + (s + 1) * SC_STEP + 64); nb = *(const LAS f32x4*)(sb + (s + 1) * SC_STEP + 128);
                nk = *(const LAS f32x4*)(sb + (s + 1) * SC_STEP + 192); nr = *(const LAS f32x4*)(sb + (s + 1) * SC_STEP + 256); nv = vb[(s + 1) * SC_STEP];
            }
            float sa = SMUL(P0.x, ckk.x); sa = SFMA(P0.y, ckk.y, sa); sa = SFMA(P1.x, ckk.z, sa); sa = SFMA(P1.y, ckk.w, sa);
            sa = row16_sum1(sa);
            const float nsa = -sa;
            P0.x = SFMA(P0.x, cw.x, SFMA(nsa, cb.x, SMUL(cv, ck.x))); P0.y = SFMA(P0.y, cw.y, SFMA(nsa, cb.y, SMUL(cv, ck.y)));
            P1.x = SFMA(P1.x, cw.z, SFMA(nsa, cb.z, SMUL(cv, ck.z))); P1.y = SFMA(P1.y, cw.w, SFMA(nsa, cb.w, SMUL(cv, ck.w)));
            float o = SMUL(P0.x, cr.x); o = SFMA(P0.y, cr.y, o); o = SFMA(P1.x, cr.z, o); o = SFMA(P1.y, cr.w, o);
            o = row16_sum1(o);
            okeep = jl == s ? o : okeep;
        }
        if (jl < NS) oraw[(size_t)(t0 + jl) * 1024 + hf * 32 + rl] = okeep;
    };
    __syncthreads();
    gload(sr[0], 0); gload(sr[1], NS);
    lstore(sr[0], 0);
    __syncthreads();
    for (int t0 = 0; t0 < T; t0 += 2 * NS) {
        gload(sr[0], t0 + 2 * NS);
        batch(t0, 0);
        lstore(sr[1], 1);
        __syncthreads();
        if (t0 + NS < T) {
            gload(sr[1], t0 + 3 * NS);
            batch(t0 + NS, 1);
            lstore(sr[0], 0);
            __syncthreads();
        }
    }
    *(f32x4*)(Sout + row * 64 + 4 * jl) = (f32x4){P0.x, P0.y, P1.x, P1.y};
    __syncthreads();
}

#define PMUL(a, b) ((a) * (b))
#define DSTEP(x, ctrl) x += DPPF(x, ctrl); asm("" : "+v"(x));
template <int NS>
__device__ __forceinline__ void scan_full(const float* __restrict__ prep  , int T, float* __restrict__ Sout, float* __restrict__ oraw  , LAS float* lds) {
    int tid_ = threadIdx.x; asm volatile("" : "+v"(tid_));
    const int tid = tid_, lane = tid & 63, w = tid >> 6, rg = lane >> 4, jl = lane & 15;
    const int ra = w * 8 + rg * 2;
    constexpr size_t SS = (size_t)16 * 384;
    LAS float* stg = lds;
    float a0 = 0.f, a1 = 0.f, a2 = 0.f, a3 = 0.f, b0 = 0.f, b1 = 0.f, b2 = 0.f, b3 = 0.f;
    constexpr int NF4 = NS * 96, NLD = (NF4 + 511) / 512;
    f32x4 sr[2][NLD];
    auto gload = [&](f32x4 (&r)[NLD], int t0) {
#pragma unroll
        for (int i = 0; i < NLD; ++i) { const int e = tid + 512 * i; if (e < NF4) { const int st = e / 96, o4 = e % 96; int t = t0 + st; t = t < T ? t : T - 1; r[i] = *(const f32x4*)(prep + (size_t)t * SS + o4 * 4); } }
    };
    auto lstore = [&](const f32x4 (&r)[NLD], int buf) {
#pragma unroll
        for (int i = 0; i < NLD; ++i) { const int e = tid + 512 * i; if (e < NF4) { const int st = e / 96, o4 = e % 96; *(LAS f32x4*)(stg + (buf * SC_NB + st) * SC_STEP + o4 * 4) = r[i]; } }
    };
    auto batch = [&](int t0, int buf) {
        const LAS float* sb = stg + buf * SC_NB * SC_STEP + 4 * jl;
        const LAS float* vb = stg + buf * SC_NB * SC_STEP + 320 + ra;
        f32x4 nw = *(const LAS f32x4*)(sb), nkk = *(const LAS f32x4*)(sb + 64), nb = *(const LAS f32x4*)(sb + 128), nk = *(const LAS f32x4*)(sb + 192), nr = *(const LAS f32x4*)(sb + 256);
        f32x2l nv = *(const LAS f32x2l*)(vb), okeep = {0.f, 0.f};
#pragma unroll
        for (int s = 0; s < NS; ++s) {
            const f32x4 cw = nw, ckk = nkk, cb = nb, ck = nk, cr = nr; const f32x2l cv = nv;
            if (s + 1 < NS) {
                nw = *(const LAS f32x4*)(sb + (s + 1) * SC_STEP); nkk = *(const LAS f32x4*)(sb + (s + 1) * SC_STEP + 64); nb = *(const LAS f32x4*)(sb + (s + 1) * SC_STEP + 128);
                nk = *(const LAS f32x4*)(sb + (s + 1) * SC_STEP + 192); nr = *(const LAS f32x4*)(sb + (s + 1) * SC_STEP + 256); nv = *(const LAS f32x2l*)(vb + (s + 1) * SC_STEP);
            }
            float sa = PMUL(a0, ckk.x), sbv = PMUL(b0, ckk.x);
            sa = fmaf(a1, ckk.y, sa); sbv = fmaf(b1, ckk.y, sbv); sa = fmaf(a2, ckk.z, sa); sbv = fmaf(b2, ckk.z, sbv); sa = fmaf(a3, ckk.w, sa); sbv = fmaf(b3, ckk.w, sbv);
            DSTEP(sa, 0xB1) DSTEP(sbv, 0xB1) DSTEP(sa, 0x4E) DSTEP(sbv, 0x4E) DSTEP(sa, 0x141) DSTEP(sbv, 0x141) DSTEP(sa, 0x140) DSTEP(sbv, 0x140)
            const float na = -sa, nbv = -sbv;
            a0 = fmaf(a0, cw.x, fmaf(na, cb.x, PMUL(cv.x, ck.x))); b0 = fmaf(b0, cw.x, fmaf(nbv, cb.x, PMUL(cv.y, ck.x)));
            a1 = fmaf(a1, cw.y, fmaf(na, cb.y, PMUL(cv.x, ck.y))); b1 = fmaf(b1, cw.y, fmaf(nbv, cb.y, PMUL(cv.y, ck.y)));
            a2 = fmaf(a2, cw.z, fmaf(na, cb.z, PMUL(cv.x, ck.z))); b2 = fmaf(b2, cw.z, fmaf(nbv, cb.z, PMUL(cv.y, ck.z)));
            a3 = fmaf(a3, cw.w, fmaf(na, cb.w, PMUL(cv.x, ck.w))); b3 = fmaf(b3, cw.w, fmaf(nbv, cb.w, PMUL(cv.y, ck.w)));
            float oa = PMUL(a0, cr.x), obv = PMUL(b0, cr.x);
            oa = fmaf(a1, cr.y, oa); obv = fmaf(b1, cr.y, obv); oa = fmaf(a2, cr.z, oa); obv = fmaf(b2, cr.z, obv); oa = fmaf(a3, cr.w, oa); obv = fmaf(b3, cr.w, obv);
            DSTEP(oa, 0xB1) DSTEP(obv, 0xB1) DSTEP(oa, 0x4E) DSTEP(obv, 0x4E) DSTEP(oa, 0x141) DSTEP(obv, 0x141) DSTEP(oa, 0x140) DSTEP(obv, 0x140)
            okeep.x = jl == s ? oa : okeep.x; okeep.y = jl == s ? obv : okeep.y;
        }
        if (jl < NS) *(f32x2l*)(oraw + (size_t)(t0 + jl) * 1024 + ra) = okeep;
    };
    __syncthreads();
    gload(sr[0], 0); gload(sr[1], NS);
    lstore(sr[0], 0);
    __syncthreads();
    for (int t0 = 0; t0 < T; t0 += 2 * NS) {
        gload(sr[0], t0 + 2 * NS);
        batch(t0, 0);
        lstore(sr[1], 1);
        __syncthreads();
        if (t0 + NS < T) {
            gload(sr[1], t0 + 3 * NS);
            batch(t0 + NS, 1);
            lstore(sr[0], 0);
            __syncthreads();
        }
    }
    *(f32x4*)(Sout + ra * 64 + 4 * jl) = (f32x4){a0, a1, a2, a3}; *(f32x4*)(Sout + (ra + 1) * 64 + 4 * jl) = (f32x4){b0, b1, b2, b3};
    __syncthreads();
}


constexpr float NEGF = -1e30f;
template <bool SAMPLE>
__device__ __forceinline__ void attn_item(const Args& a, int b, int g, int tile, LAS unsigned char* lds) {
    constexpr int TT = SAMPLE ? 4 : 8, NR = TT * 4, RPW = NR / 8, NCMP = SAMPLE ? NCMP_S : NCMP_P, NCB = SAMPLE ? NCB_S : NCB_P, NCT = NCB / 64, PBLD = NCB, NSEL = SAMPLE ? NSEL_S : NSEL_P;
    const int tid = threadIdx.x, lane = tid & 63, w = __builtin_amdgcn_readfirstlane(tid >> 6);
    LAS float* qs = (LAS float*)lds;
    LAS float* Ks = qs + 64 * 64;
    LAS float* Vs = Ks + 64 * 65;
    LAS float* Pb = Vs + 64 * 64;
    LAS float* imp = Pb + 8192;
    LAS int* selb = (LAS int*)(imp + 16 * 132);
    LAS int* ulist = selb + 16 * 132;
    const bf16* QG = (const bf16*)(a.ws + WS_QG);
    const bf16* UA = (const bf16*)(a.ws + WS_UA);
    const int* pt = (const int*)a.in[7];
    const int hr = w & 3, h = g * 4 + hr;
    const float slope = exp2f(-0.5f * (float)(h + 1));
    const int t0 = SAMPLE ? PAST : tile * TT;
    const int grow0 = SAMPLE ? MP + b * 4 : b * SEQ + t0;
    __syncthreads();
    {
        const int r = tid >> 3, c8 = tid & 7;
        if (r < NR) { float q[8]; unpack8(*(const u32x4*)(QG + (size_t)(grow0 + (r >> 2)) * 2048 + (g * 4 + (r & 3)) * 64 + c8 * 8), q);
#pragma unroll
            for (int i = 0; i < 8; ++i) qs[r * 64 + c8 * 8 + i] = q[i] * ATTN_SCALE; }
    }
    float accf[RPW], m_[RPW], l_[RPW], o_[RPW];
    f32x4 fk0, fk1, fv0, fv1;
    auto fetch = [&](auto kptr  , auto vptr, bool wantK, bool wantV) {
        const int key = tid >> 3, c8 = tid & 7;
        if (wantK) { const float* p = kptr(key); fk0 = (f32x4){0.f, 0.f, 0.f, 0.f}; fk1 = fk0; if (p) { fk0 = *(const f32x4*)(p + c8 * 8); fk1 = *(const f32x4*)(p + c8 * 8 + 4); } }
        if (wantV) { const float* p = vptr(key); fv0 = (f32x4){0.f, 0.f, 0.f, 0.f}; fv1 = fv0; if (p) { fv0 = *(const f32x4*)(p + c8 * 8); fv1 = *(const f32x4*)(p + c8 * 8 + 4); } }
    };
    auto commit = [&](bool wantK, bool wantV) {
        const int key = tid >> 3, c8 = tid & 7;
        if (wantK) { LAS float* d = Ks + key * 65 + c8 * 8; d[0] = fk0.x; d[1] = fk0.y; d[2] = fk0.z; d[3] = fk0.w; d[4] = fk1.x; d[5] = fk1.y; d[6] = fk1.z; d[7] = fk1.w; }
        if (wantV) { *(LAS f32x4*)(Vs + key * 64 + c8 * 8) = fv0; *(LAS f32x4*)(Vs + key * 64 + c8 * 8 + 4) = fv1; }
    };
    auto score_rows = [&](float (&sc)[RPW]) {
        float kreg[64];
#pragma unroll
        for (int d = 0; d < 64; ++d) kreg[d] = Ks[lane * 65 + d];
#pragma unroll
        for (int k = 0; k < RPW; ++k) { const LAS float* q = qs + (w + 8 * k) * 64; float s = 0.f;
#pragma unroll
            for (int d = 0; d < 64; d += 4) { const f32x4 q4 = *(const LAS f32x4*)(q + d); s += q4.x * kreg[d] + q4.y * kreg[d + 1] + q4.z * kreg[d + 2] + q4.w * kreg[d + 3]; }
            sc[k] = s; }
    };
    auto pv_rows = [&](const LAS float* pbase, int pld) {
#pragma unroll 4
        for (int key = 0; key < 64; key += 4) {
            const float v0 = Vs[(key + 0) * 64 + lane], v1 = Vs[(key + 1) * 64 + lane], v2 = Vs[(key + 2) * 64 + lane], v3 = Vs[(key + 3) * 64 + lane];
#pragma unroll
            for (int k = 0; k < RPW; ++k) { const f32x4 p4 = *(const LAS f32x4*)(pbase + (w + 8 * k) * pld + key); o_[k] += p4.x * v0 + p4.y * v1 + p4.z * v2 + p4.w * v3; }
        }
    };
#pragma unroll
    for (int k = 0; k < RPW; ++k) { accf[k] = 0.f; m_[k] = NEGF; l_[k] = 0.f; o_[k] = 0.f; }
    const float* KC = (const float*)(a.ws + (SAMPLE ? WS_KCS : WS_KCP)) + (size_t)b * NCB * 256 + g * 64;
    const float* VC = (const float*)(a.ws + (SAMPLE ? WS_VCS : WS_VCP)) + (size_t)b * NCB * 256 + g * 64;
    auto nullp = [&](int) -> const float* { return nullptr; };
    fetch([&](int key) -> const float* { const int n = key; return n < NCMP ? KC + (size_t)n * 256 : nullptr; }, nullp, true, false);
    for (int kt = 0; kt < NCT; ++kt) {
        __syncthreads();
        commit(true, false);
        __syncthreads();
        if (kt + 1 < NCT) fetch([&](int key) -> const float* { const int n = (kt + 1) * 64 + key; return n < NCMP ? KC + (size_t)n * 256 : nullptr; }, nullp, true, false);
        else fetch(nullp, [&](int key) -> const float* { const int n = key; return n < NCMP ? VC + (size_t)n * 256 : nullptr; }, false, true);
        float sc[RPW]; score_rows(sc);
        const int n = kt * 64 + lane;
#pragma unroll
        for (int k = 0; k < RPW; ++k) { const int t = t0 + (w >> 2) + 2 * k; const int dist = t - (16 * n + 31); const bool valid = n < NCMP && dist >= 0;
            const float s = valid ? sc[k] - slope * (float)dist : NEGF; Pb[(w + 8 * k) * PBLD + n] = s; m_[k] = fmaxf(m_[k], s); }
    }
#pragma unroll
    for (int k = 0; k < RPW; ++k) {
        const float m = wave_max(m_[k]); float ls = 0.f; LAS float* pr = Pb + (w + 8 * k) * PBLD;
        float pv[NCT];
#pragma unroll
        for (int i = 0; i < NCT; ++i) { const float s = pr[i * 64 + lane]; pv[i] = s > -1e29f ? __expf(s - m) : 0.f; ls += pv[i]; }
        ls = wave_sum(ls); const float inv = 1.0f / fmaxf(ls, 1e-30f);
#pragma unroll
        for (int i = 0; i < NCT; ++i) pr[i * 64 + lane] = pv[i] * inv;
    }
    for (int kt = 0; kt < NCT; ++kt) {
        __syncthreads();
        commit(false, true);
        __syncthreads();
        if (kt + 1 < NCT) fetch(nullp, [&](int key) -> const float* { const int n = (kt + 1) * 64 + key; return n < NCMP ? VC + (size_t)n * 256 : nullptr; }, false, true);
        pv_rows(Pb + kt * 64, PBLD);
    }
#pragma unroll
    for (int k = 0; k < RPW; ++k) { const int grow = grow0 + (w >> 2) + 2 * k; accf[k] = sigmoidf_(bf2f(UA[(size_t)grow * UA_LD + ACOLS + 0 * 16 + h])) * o_[k]; }
    for (int idx = tid; idx < TT * NSEL; idx += 512) {
        const int tok = idx / NSEL, j = idx % NSEL; float v = 0.f;
#pragma unroll
        for (int r4 = 0; r4 < 4; ++r4) { const LAS float* pr = Pb + (tok * 4 + r4) * PBLD;
#pragma unroll
            for (int mm = 0; mm < 3; ++mm) { const int n = 4 * j + mm; if (n < NCMP) v += pr[n]; }
            { const int n = 4 * j + 3; if (n < NCMP) v += 0.5f * pr[n]; }
            { const int n = 4 * j - 1; if (n >= 0 && n < NCMP) v += 0.5f * pr[n]; } }
        imp[tok * 132 + j] = v;
    }
    __syncthreads();
    for (int idx = tid; idx < TT * NSEL; idx += 512) {
        const int tok = idx / NSEL, j = idx % NSEL, tb = (t0 + tok) >> 6;
        auto score = [&](int jj) -> float { const int back = tb - jj; const bool forced = jj == 0 || (back >= 0 && back < 2); return forced ? 1e4f : (back >= 0 ? imp[tok * 132 + jj] : -1.0f); };
        const float sj = score(j); int rank = 0;
        for (int jj = 0; jj < NSEL; ++jj) { const float s2 = score(jj); rank += (s2 > sj || (s2 == sj && jj < j)) ? 1 : 0; }
        selb[tok * 132 + j] = (rank < 16 && sj >= 0.f) ? 1 : 0;
    }
    __syncthreads();
    if (tid == 0) { int nu = 0; for (int j = 0; j < NSEL; ++j) { int any = 0; for (int tok = 0; tok < TT; ++tok) any |= selb[tok * 132 + j]; if (any) ulist[nu++] = j; } ulist[132] = nu; }
    __syncthreads();
    const int nu = ulist[132];
    LAS float* ps = Pb;
    auto online = [&](int k, float s, bool valid) {
        const float sv = valid ? s : NEGF; const float mn = fmaxf(m_[k], wave_max(sv)); const float p = valid ? __expf(sv - mn) : 0.f; const float corr = __expf(m_[k] - mn);
        l_[k] = l_[k] * corr + wave_sum(p); o_[k] *= corr; m_[k] = mn; ps[(w + 8 * k) * 64 + lane] = p;
    };
#pragma unroll
    for (int k = 0; k < RPW; ++k) { m_[k] = NEGF; l_[k] = 0.f; o_[k] = 0.f; }
    auto selp = [&](int j, int key) -> const float* {
        if (!SAMPLE) return a.out + O_PSEL + ((size_t)b * SEQ + j * 64 + key) * 512 + g * 64;
        if (j < 128) return a.in[3] + ((size_t)pt[b * NPAGES + (j >> 1)] * PAGE + (j & 1) * 64 + key) * 512 + g * 64;
        return key < 4 ? a.out + O_SSEL + ((size_t)b * 4 + key) * 512 + g * 64 : nullptr; };
    { const int j0 = ulist[0]; fetch([&](int key) -> const float* { return selp(j0, key); }, [&](int key) -> const float* { const float* p = selp(j0, key); return p ? p + 256 : nullptr; }, true, true); }
    for (int ui = 0; ui < nu; ++ui) {
        const int j = ulist[ui];
        __syncthreads();
        commit(true, true);
        __syncthreads();
        if (ui + 1 < nu) { const int jn = ulist[ui + 1]; fetch([&](int key) -> const float* { return selp(jn, key); }, [&](int key) -> const float* { const float* p = selp(jn, key); return p ? p + 256 : nullptr; }, true, true); }
        float sc[RPW]; score_rows(sc);
        const int kpos = j * 64 + lane;
#pragma unroll
        for (int k = 0; k < RPW; ++k) { const int tok = (w >> 2) + 2 * k, t = t0 + tok; const bool valid = selb[tok * 132 + j] != 0 && kpos <= t; online(k, sc[k] - slope * (float)(t - kpos), valid); }
        asm volatile("s_waitcnt lgkmcnt(0)" ::: "memory");
        pv_rows(ps, 64);
    }
#pragma unroll
    for (int k = 0; k < RPW; ++k) { const int grow = grow0 + (w >> 2) + 2 * k; accf[k] += sigmoidf_(bf2f(UA[(size_t)grow * UA_LD + ACOLS + 1 * 16 + h])) * o_[k] / fmaxf(l_[k], 1e-30f); }
#pragma unroll
    for (int k = 0; k < RPW; ++k) { m_[k] = NEGF; l_[k] = 0.f; o_[k] = 0.f; }
    const int kstart = SAMPLE ? PAST - WINDOW : (t0 - WINDOW > 0 ? t0 - WINDOW : 0), kend = t0 + TT - 1;
    auto winp = [&](int kb, int key) -> const float* { const int kpos = kb + key; if (kpos > kend) return nullptr;
        if (!SAMPLE) return (const float*)(a.ws + WS_KVW) + ((size_t)b * SEQ + kpos) * 512 + g * 64;
        const int i = kpos - (PAST - WINDOW); return i < 512 ? a.in[4] + ((size_t)b * 512 + i) * 512 + g * 64 : a.out + O_SWIN + ((size_t)b * 512 + 508 + (i - 512)) * 512 + g * 64; };
    fetch([&](int key) -> const float* { return winp(kstart, key); }, [&](int key) -> const float* { const float* p = winp(kstart, key); return p ? p + 256 : nullptr; }, true, true);
    for (int kb = kstart; kb <= kend; kb += 64) {
        __syncthreads();
        commit(true, true);
        __syncthreads();
        if (kb + 64 <= kend) { const int kn = kb + 64; fetch([&](int key) -> const float* { return winp(kn, key); }, [&](int key) -> const float* { const float* p = winp(kn, key); return p ? p + 256 : nullptr; }, true, true); }
        float sc[RPW]; score_rows(sc);
        const int kpos = kb + lane;
#pragma unroll
        for (int k = 0; k < RPW; ++k) { const int t = t0 + (w >> 2) + 2 * k; const int dist = t - kpos; const bool valid = kpos <= kend && dist >= 0 && dist <= WINDOW; online(k, sc[k] - slope * (float)dist, valid); }
        asm volatile("s_waitcnt lgkmcnt(0)" ::: "memory");
        pv_rows(ps, 64);
    }
    bf16* OB = (bf16*)(a.ws + WS_OAB) + (size_t)MPAD * 1024;
#pragma unroll
    for (int k = 0; k < RPW; ++k) { const int grow = grow0 + (w >> 2) + 2 * k;
        const float o = accf[k] + sigmoidf_(bf2f(UA[(size_t)grow * UA_LD + ACOLS + 2 * 16 + h])) * o_[k] / fmaxf(l_[k], 1e-30f);
        const float gb = bf2f(QG[(size_t)grow * 2048 + 1024 + h * 64 + lane]);
        OB[(size_t)grow * 1024 + h * 64 + lane] = f2bf(o * gb / (1.0f + __expf(-gb))); }
    __syncthreads();
}


typedef short s16x4 __attribute__((ext_vector_type(4)));
constexpr int KSTR = 144, VSTR = 192;
constexpr int AL_KB = 0, AL_VB = 2 * 64 * KSTR, AL_KC = AL_VB + 2 * 64 * VSTR, AL_VC = AL_KC + 128 * KSTR, AL_IMP = AL_VC + 128 * VSTR, AL_SELM = AL_IMP + 4 * 64 * 33 * 4, AL_END = AL_SELM + 512;
static_assert(AL_END < LDS_BYTES - 64, "attention LDS map");

template <int K> __device__ __forceinline__ float fmamk_lit(float a, float c) { float d; asm("v_fmamk_f32 %0, %1, %2, %3" : "=v"(d) : "v"(a), "n"(__builtin_bit_cast(int, (float)K)), "v"(c)); return d; }
#define SINIT1(S, I, OFF) S[I] = fmamk_lit<((I) & 3) + 8 * ((I) >> 2) + (OFF)>(sl, cb);
#define SINIT16(S, OFF) SINIT1(S, 0, OFF) SINIT1(S, 1, OFF) SINIT1(S, 2, OFF) SINIT1(S, 3, OFF) SINIT1(S, 4, OFF) SINIT1(S, 5, OFF) SINIT1(S, 6, OFF) SINIT1(S, 7, OFF) \
                        SINIT1(S, 8, OFF) SINIT1(S, 9, OFF) SINIT1(S, 10, OFF) SINIT1(S, 11, OFF) SINIT1(S, 12, OFF) SINIT1(S, 13, OFF) SINIT1(S, 14, OFF) SINIT1(S, 15, OFF)
__device__ __forceinline__ float max3f(float a, float b, float c) { float d; asm("v_max3_f32 %0, %1, %2, %3" : "=v"(d) : "v"(a), "v"(b), "v"(c)); return d; }
__device__ __forceinline__ bf16x8v pack8(const f32x16& p, int s) {
    u32x4 w; w.x = pk2bf(p[8 * s + 0], p[8 * s + 1]); w.y = pk2bf(p[8 * s + 2], p[8 * s + 3]); w.z = pk2bf(p[8 * s + 4], p[8 * s + 5]); w.w = pk2bf(p[8 * s + 6], p[8 * s + 7]);
    return __builtin_bit_cast(bf16x8v, w);
}
__device__ __forceinline__ bf16x8v pack8sum(const f32x16& p, int s, float& acc) {
    const bf16n2 one = __builtin_bit_cast(bf16n2, 0x3f803f80u);
    const f32n2 v0 = {p[8 * s + 0], p[8 * s + 1]}, v1 = {p[8 * s + 2], p[8 * s + 3]}, v2 = {p[8 * s + 4], p[8 * s + 5]}, v3 = {p[8 * s + 6], p[8 * s + 7]};
    const bf16n2 h0 = __builtin_convertvector(v0, bf16n2), h1 = __builtin_convertvector(v1, bf16n2), h2 = __builtin_convertvector(v2, bf16n2), h3 = __builtin_convertvector(v3, bf16n2);
    acc = __builtin_amdgcn_fdot2_f32_bf16(h0, one, acc, false); acc = __builtin_amdgcn_fdot2_f32_bf16(h1, one, acc, false);
    acc = __builtin_amdgcn_fdot2_f32_bf16(h2, one, acc, false); acc = __builtin_amdgcn_fdot2_f32_bf16(h3, one, acc, false);
    u32x4 w; w.x = __builtin_bit_cast(unsigned, h0); w.y = __builtin_bit_cast(unsigned, h1); w.z = __builtin_bit_cast(unsigned, h2); w.w = __builtin_bit_cast(unsigned, h3);
    return __builtin_bit_cast(bf16x8v, w);
}
__device__ __forceinline__ bf16x8v vfrag(const LAS unsigned char* vb, int krow, int d0, int lane) {
    const int hh = lane >> 5, q = (lane & 15) >> 2, p = lane & 3, db = d0 + ((lane >> 4) & 1) * 16 + 4 * p;
    const LAS unsigned char* ad = vb + (krow + 4 * hh + q) * VSTR + db * 2;
    const s16x4 lo = __builtin_amdgcn_ds_read_tr16_b64_v4i16((LAS s16x4*)ad);
    const s16x4 hi = __builtin_amdgcn_ds_read_tr16_b64_v4i16((LAS s16x4*)(ad + 8 * VSTR));
    return __builtin_shufflevector(lo, hi, 0, 1, 2, 3, 4, 5, 6, 7);
}

__device__ __forceinline__ void attn_mfma_item(const Args& a, int b, int g, int qt, LAS unsigned char* lds, int nxt  , LAS int* qnext, unsigned& tacc) {
    int tid_ = threadIdx.x; asm volatile("" : "+v"(tid_));
    const int tid = tid_, lane = tid & 63, w = __builtin_amdgcn_readfirstlane(tid >> 6);
    const int r = lane & 31, hh = lane >> 5, hr = w & 3, th = w >> 2, h = g * 4 + hr;
    const int tl = th * 32 + r, t = qt * 64 + tl, grow = b * SEQ + t;
    const float slope8 = 8.0f * exp2f(-0.5f * (float)(h + 1));
    constexpr float C1 = 0.125f * 1.4426950408889634f, NEGA = -1e30f, THR = 8.0f;
    const float sl = slope8 * C1;
    const bf16* QG = (const bf16*)(a.ws + WS_QG);
    const bf16* UA = (const bf16*)(a.ws + WS_UA);
    LAS unsigned char* KB = lds + AL_KB; LAS unsigned char* VB = lds + AL_VB; LAS unsigned char* KC = lds + AL_KC; LAS unsigned char* VC = lds + AL_VC;
    LAS float* IMP = (LAS float*)(lds + AL_IMP); LAS unsigned* SELM = (LAS unsigned*)(lds + AL_SELM);
    __syncthreads();
    bf16x8v qf[4];
#pragma unroll
    for (int s = 0; s < 4; ++s) qf[s] = *(const bf16x8v*)(QG + (size_t)grow * 2048 + h * 64 + 16 * s + 8 * hh);
    unsigned short glog[3];
#pragma unroll
    for (int x = 0; x < 3; ++x) glog[x] = UA[(size_t)grow * UA_LD + ACOLS + x * 16 + h];
    const int nkt = ((4 * qt + 2) >> 5) + 1;
    {
        const int n = tid >> 2, c16 = (tid & 3) * 16;
        const bf16* kc = (const bf16*)(a.ws + WS_KCP) + ((size_t)(b * 4 + g) * 128 + n) * 64 + c16;
        const bf16* vc = (const bf16*)(a.ws + WS_VCP) + ((size_t)(b * 4 + g) * 128 + n) * 64 + c16;
        u32x4 k0 = {0u, 0u, 0u, 0u}, k1 = k0, v0 = k0, v1 = k0;
        if (n < NCMP_P && n < 32 * nkt) { k0 = *(const u32x4*)kc; k1 = *(const u32x4*)(kc + 8); v0 = *(const u32x4*)vc; v1 = *(const u32x4*)(vc + 8); }
        *(LAS u32x4*)(KC + n * KSTR + c16 * 2) = k0; *(LAS u32x4*)(KC + n * KSTR + c16 * 2 + 16) = k1;
        *(LAS u32x4*)(VC + n * VSTR + c16 * 2) = v0; *(LAS u32x4*)(VC + n * VSTR + c16 * 2 + 16) = v1;
        if (tid < 64) SELM[tid] = 0u;
        if (tid == 64) SELM[64] = 0u;
    }
    __syncthreads();
    f32x16 fin[2];
    {
        f32x16 sc[4];
        const float cb = slope8 * (float)(31 - t + 64 * hh);
#pragma unroll
        for (int kt = 0; kt < 4; ++kt)
#pragma unroll
            for (int i = 0; i < 16; ++i) sc[kt][i] = slope8 * (float)(16 * (32 * kt + (i & 3) + 8 * (i >> 2))) + cb;
#pragma unroll
        for (int kt = 0; kt < 4; ++kt) if (kt < nkt) {
            bf16x8v kf[4];
#pragma unroll
            for (int s = 0; s < 4; ++s) kf[s] = *(const LAS bf16x8v*)(KC + (32 * kt + r) * KSTR + (16 * s + 8 * hh) * 2);
#pragma unroll
            for (int s = 0; s < 4; ++s) sc[kt] = __builtin_amdgcn_mfma_f32_32x32x16_bf16(kf[s], qf[s], sc[kt], 0, 0, 0);
        }
        float m = NEGA;
        const int nlim = (t - 31) >> 4;
#pragma unroll
        for (int kt = 0; kt < 4; ++kt) if (kt < nkt)
#pragma unroll
            for (int i = 0; i < 16; i += 2) { const int n = 32 * kt + (i & 3) + 8 * (i >> 2) + 4 * hh; const float v = (t >= 31 && n <= nlim) ? sc[kt][i] : NEGA, v2 = (t >= 31 && n + 1 <= nlim) ? sc[kt][i + 1] : NEGA;
                sc[kt][i] = v; sc[kt][i + 1] = v2; m = max3f(m, v, v2); }
        m = xhalf_max(m); m = fmaxf(m, -1e20f);
        const float nm = -m * C1; float l = 0.f;
#pragma unroll
        for (int kt = 0; kt < 4; ++kt) if (kt < nkt)
#pragma unroll
            for (int i = 0; i < 16; ++i) { const float p = __builtin_amdgcn_exp2f(fmaf(sc[kt][i], C1, nm)); sc[kt][i] = p; l += p; }
        l = xhalf_sum(l);
        const float inv = 1.0f / fmaxf(l, 1e-30f);
#pragma unroll
        for (int kt = 0; kt < 4; ++kt) if (kt < nkt)
#pragma unroll
            for (int i = 0; i < 16; ++i) sc[kt][i] *= inv;
        if (qt >= 16) {
            float av[16], cv[16];
#pragma unroll
            for (int kt = 0; kt < 4; ++kt)
#pragma unroll
                for (int q4 = 0; q4 < 4; ++q4) { const bool on = kt < nkt; av[kt * 4 + q4] = on ? sc[kt][4 * q4] + sc[kt][4 * q4 + 1] + sc[kt][4 * q4 + 2] + 0.5f * sc[kt][4 * q4 + 3] : 0.f; cv[kt * 4 + q4] = on ? 0.5f * sc[kt][4 * q4 + 3] : 0.f; }
            float cp[16];
#pragma unroll
            for (int x = 0; x < 16; ++x) cp[x] = xhalf_other(cv[x], hh != 0);
#pragma unroll
            for (int x = 0; x < 16; ++x) { const float prev = x > 0 ? cp[x - 1] : 0.f; IMP[(hr * 64 + tl) * 33 + 2 * x + hh] = av[x] + (hh ? cp[x] : prev); }
        }
        f32x16 oc[2];
#pragma unroll
        for (int i = 0; i < 16; ++i) { oc[0][i] = 0.f; oc[1][i] = 0.f; }
#pragma unroll
        for (int kt = 0; kt < 4; ++kt) if (kt < nkt)
#pragma unroll
            for (int s = 0; s < 2; ++s) { const bf16x8v pf = pack8(sc[kt], s);
#pragma unroll
                for (int dt = 0; dt < 2; ++dt) oc[dt] = __builtin_amdgcn_mfma_f32_32x32x16_bf16(vfrag(VC, 32 * kt + 16 * s, 32 * dt, lane), pf, oc[dt], 0, 0, 0); }
        const float g0 = sigmoidf_(bf2f(glog[0]));
#pragma unroll
        for (int i = 0; i < 16; ++i) { fin[0][i] = g0 * oc[0][i]; fin[1][i] = g0 * oc[1][i]; }
    }
    unsigned selmask, uni;
    if (qt < 16) { selmask = (2u << qt) - 1u; uni = selmask; }
    else {
        __syncthreads();
        LAS float* IMPT = (LAS float*)KC;
        const int tok = tid >> 3, jq = tid & 7;
#pragma unroll
        for (int jj = 0; jj < 4; ++jj) { const int j = jq * 4 + jj, back = qt - j;
            const float v = (IMP[(0 * 64 + tok) * 33 + j] + IMP[(1 * 64 + tok) * 33 + j]) + (IMP[(2 * 64 + tok) * 33 + j] + IMP[(3 * 64 + tok) * 33 + j]);
            IMPT[tok * 36 + j] = (j == 0 || (back >= 0 && back < 2)) ? 1e4f : (back >= 0 ? v : -1.0f); }
        __syncthreads();
        float sc[32];
#pragma unroll
        for (int x = 0; x < 8; ++x) { const f32x4 v = *(const LAS f32x4*)(IMPT + tok * 36 + 4 * x); sc[4 * x] = v.x; sc[4 * x + 1] = v.y; sc[4 * x + 2] = v.z; sc[4 * x + 3] = v.w; }
        const f32x4 mine = *(const LAS f32x4*)(IMPT + tok * 36 + 4 * jq);
        unsigned bits = 0u;
#pragma unroll
        for (int jj = 0; jj < 4; ++jj) {
            const int jme = jq * 4 + jj; const float sj = mine[jj]; int rank = 0;
#pragma unroll
            for (int j = 0; j < 32; ++j) rank += (sc[j] > sj || (sc[j] == sj && j < jme)) ? 1 : 0;
            if (rank < 16 && sj >= 0.f) bits |= 1u << jme;
        }
#define DPPU(x, ctrl) ((unsigned)__builtin_amdgcn_update_dpp(0, (int)(x), (ctrl), 0xf, 0xf, false))
        bits |= DPPU(bits, 0xB1); bits |= DPPU(bits, 0x4E); bits |= DPPU(bits, 0x141);
        if (jq == 0) SELM[tok] = bits;
        unsigned wu = bits | DPPU(bits, 0x140);
        { const auto r1 = __builtin_amdgcn_permlane16_swap(wu, wu, false, false); wu = r1[0] | r1[1]; const auto r2 = __builtin_amdgcn_permlane32_swap(wu, wu, false, false); wu = r2[0] | r2[1]; }
#undef DPPU
        if (lane == 0) atomicOr((unsigned*)(SELM + 64), wu);
        __syncthreads();
        selmask = SELM[tl]; uni = SELM[64];
    }
    const bf16* KVSB = (const bf16*)(a.ws + WS_KVSB) + (size_t)b * SEQ * 512 + g * 64;
    const bf16* KVWB = (const bf16*)(a.ws + WS_KVWB) + (size_t)b * SEQ * 512 + g * 64;
    const int skey = tid >> 3, sc8 = tid & 7;
    u32x4 rk, rv;
    if (tid == 0) *qnext = nxt;
    unsigned tword = 0u;
#pragma unroll 1
    for (int br = 1; br <= 2; ++br) {
        if (br == 2) {
            const int na = *qnext;
            if (na < BATCH * 4 * 32 && tid < 384) {
                const int nb_ = (na & 31) >> 2, ng = na & 3, nqt = 31 - (na >> 5);
                const bf16* tp = tid < 256 ? QG + (size_t)(nb_ * SEQ + nqt * 64 + (tid >> 2)) * 2048 + (ng * 4 + (tid & 3)) * 64
                                           : (const bf16*)(a.ws + WS_KVSB) + (size_t)(nb_ * SEQ + ((tid - 256) >> 1)) * 512 + ng * 64 + ((tid - 256) & 1) * 256;
                tword = *(const unsigned*)tp;
            }
        }
        const bf16* src = br == 1 ? KVSB : KVWB;
        unsigned tmask = br == 1 ? uni : (qt >= 8 ? (0x1ffu << (qt - 8)) : ((2u << qt) - 1u));
        f32x16 o[2];
#pragma unroll
        for (int i = 0; i < 16; ++i) { o[0][i] = 0.f; o[1][i] = 0.f; }
        float m = 0.f, l = 0.f;
        int j = __builtin_ctz(tmask); tmask &= tmask - 1u;
        const int jfirst = j;
        if (br == 1) { const bf16* p = src + (size_t)(j * 64 + skey) * 512 + sc8 * 8; rk = *(const u32x4*)p; rv = *(const u32x4*)(p + 256); }
        __syncthreads();
        *(LAS u32x4*)(KB + skey * KSTR + sc8 * 16) = rk; *(LAS u32x4*)(VB + skey * VSTR + sc8 * 16) = rv;
        __syncthreads();
        int buf = 0;
        for (;;) {
            const int jn = tmask ? __builtin_ctz(tmask) : -1; tmask &= tmask - 1u;
            if (jn >= 0) { const bf16* p = src + (size_t)(jn * 64 + skey) * 512 + sc8 * 8; rk = *(const u32x4*)p; rv = *(const u32x4*)(p + 256); }
            else if (br == 1) { const bf16* p = KVWB + (size_t)((qt >= 8 ? qt - 8 : 0) * 64 + skey) * 512 + sc8 * 8; rk = *(const u32x4*)p; rv = *(const u32x4*)(p + 256); }
            {
                const LAS unsigned char* kb = KB + buf * 64 * KSTR; const LAS unsigned char* vb = VB + buf * 64 * VSTR;
                f32x16 s0, s1;
                const bool diag = j == qt, ledge = br == 2 && j == qt - 8, unsel = br == 1 && ((selmask >> j) & 1u) == 0u;
                const float cb = unsel ? NEGA : fmaf(sl, (float)(j * 64 - t + 4 * hh), -m);
                bf16x8v kf0[4], kf1[4];
#pragma unroll
                for (int s = 0; s < 4; ++s) { kf0[s] = *(const LAS bf16x8v*)(kb + r * KSTR + (16 * s + 8 * hh) * 2); kf1[s] = *(const LAS bf16x8v*)(kb + (32 + r) * KSTR + (16 * s + 8 * hh) * 2); }
                asm volatile("" ::: "memory");
                SINIT16(s0, 0) SINIT16(s1, 32)
#pragma unroll
                for (int s = 0; s < 4; ++s) { s0 = __builtin_amdgcn_mfma_f32_32x32x16_bf16(kf0[s], qf[s], s0, 0, 0, 0); s1 = __builtin_amdgcn_mfma_f32_32x32x16_bf16(kf1[s], qf[s], s1, 0, 0, 0); }
                bf16x8v vf[2][2][2];
#pragma unroll
                for (int kh = 0; kh < 2; ++kh)
#pragma unroll
                    for (int s = 0; s < 2; ++s)
#pragma unroll
                        for (int dt = 0; dt < 2; ++dt) vf[kh][s][dt] = vfrag(vb, 32 * kh + 16 * s, 32 * dt, lane);
                asm volatile("" ::: "memory");
                if (diag || ledge) {
                    const int dbase = 64 * (qt - j) + tl - 4 * hh;
                    const unsigned dmax = br == 2 ? 512u : 0x7fffffffu;
#pragma unroll
                    for (int i = 0; i < 16; ++i) { const int kc = (i & 3) + 8 * (i >> 2);
                        s0[i] = (unsigned)(dbase - kc) <= dmax ? s0[i] : NEGA; s1[i] = (unsigned)(dbase - kc - 32) <= dmax ? s1[i] : NEGA; }
                }
                float mr = NEGA;
#pragma unroll
                for (int i = 0; i < 16; ++i) mr = max3f(mr, s0[i], s1[i]);
                const float gr = xhalf_max(mr);
                const bool mv = j == jfirst || gr > THR;
                if (__builtin_amdgcn_ballot_w64(mv) != 0ull) {
                    const float dm = mv ? gr : 0.f;
                    const float corr = __builtin_amdgcn_exp2f(fminf(-dm, 0.f));
                    m += dm; l *= corr;
#pragma unroll
                    for (int i = 0; i < 16; ++i) { s0[i] -= dm; s1[i] -= dm; o[0][i] *= corr; o[1][i] *= corr; }
                }
#pragma unroll
                for (int i = 0; i < 16; ++i) { s0[i] = __builtin_amdgcn_exp2f(s0[i]); s1[i] = __builtin_amdgcn_exp2f(s1[i]); }
#pragma unroll
                for (int s = 0; s < 2; ++s) {
                    const bf16x8v p0 = pack8sum(s0, s, l), p1 = pack8sum(s1, s, l);
#pragma unroll
                    for (int dt = 0; dt < 2; ++dt) { o[dt] = __builtin_amdgcn_mfma_f32_32x32x16_bf16(vf[0][s][dt], p0, o[dt], 0, 0, 0);
                        o[dt] = __builtin_amdgcn_mfma_f32_32x32x16_bf16(vf[1][s][dt], p1, o[dt], 0, 0, 0); }
                }
            }
            if (jn < 0) break;
            buf ^= 1;
            *(LAS u32x4*)(KB + buf * 64 * KSTR + skey * KSTR + sc8 * 16) = rk; *(LAS u32x4*)(VB + buf * 64 * VSTR + skey * VSTR + sc8 * 16) = rv;
            __syncthreads();
            j = jn;
        }
        l = xhalf_sum(l);
        const float gs = sigmoidf_(bf2f(br == 1 ? glog[1] : glog[2])) / fmaxf(l, 1e-30f);
#pragma unroll
        for (int i = 0; i < 16; ++i) { fin[0][i] += gs * o[0][i]; fin[1][i] += gs * o[1][i]; }
    }
    tacc ^= tword;
    {
        bf16* OB = (bf16*)(a.ws + WS_OAB) + (size_t)MPAD * 1024 + (size_t)grow * 1024 + h * 64;
        const bf16* GB = QG + (size_t)grow * 2048 + 1024 + h * 64;
#pragma unroll
        for (int dt = 0; dt < 2; ++dt)
#pragma unroll
            for (int q4 = 0; q4 < 4; ++q4) {
                const int d = 32 * dt + 8 * q4 + 4 * hh;
                const u32x2 gw = *(const u32x2*)(GB + d);
                const float g0 = __uint_as_float(gw.x << 16), g1 = __uint_as_float(gw.x & 0xffff0000u), g2 = __uint_as_float(gw.y << 16), g3 = __uint_as_float(gw.y & 0xffff0000u);
                const float y0 = fin[dt][4 * q4 + 0] * g0 / (1.0f + __expf(-g0)), y1 = fin[dt][4 * q4 + 1] * g1 / (1.0f + __expf(-g1));
                const float y2 = fin[dt][4 * q4 + 2] * g2 / (1.0f + __expf(-g2)), y3 = fin[dt][4 * q4 + 3] * g3 / (1.0f + __expf(-g3));
                u32x2 ww; ww.x = pg8::cvt_pk_bf16(y0, y1); ww.y = pg8::cvt_pk_bf16(y2, y3);
                *(u32x2*)(OB + d) = ww;
            }
    }
}


constexpr int SM_WSZ = 32 * KSTR + 32 * VSTR;
constexpr int SM_ML = 8 * SM_WSZ;
constexpr int SM_O = SM_ML + 1024;
constexpr int SM_IA = SM_O + 32768;
constexpr int SM_IC = SM_IA + 8448;
constexpr int SM_IMP = SM_IC + 8448;
constexpr int SM_SEL = SM_IMP + 2112;
constexpr int SM_UL = SM_SEL + 2112;
constexpr int SM_FIN = SM_UL + 544;
constexpr int SM_END = SM_FIN + 4096;
static_assert(SM_END <= LDS_BYTES - 64, "sample attention LDS map");

__device__ __forceinline__ void attn_sample_mfma(const Args& a, int b, int g, LAS unsigned char* lds) {
    int tid_ = threadIdx.x; asm volatile("" : "+v"(tid_));
    const int tid = tid_, lane = tid & 63, w = __builtin_amdgcn_readfirstlane(tid >> 6);
    const int r = lane & 31, hh = lane >> 5, c = r & 15, tok = c >> 2, hr = c & 3, h = g * 4 + hr;
    const int t = PAST + tok, grow = MP + b * 4 + tok;
    const bool real = r < 16;
    const float slope8 = 8.0f * exp2f(-0.5f * (float)(h + 1));
    constexpr float C1 = 0.125f * 1.4426950408889634f, NEGA = -1e30f;
    const bf16* QG = (const bf16*)(a.ws + WS_QG);
    const bf16* UA = (const bf16*)(a.ws + WS_UA);
    const int* pt = (const int*)a.in[7];
    LAS unsigned char* KB = lds + w * SM_WSZ; LAS unsigned char* VB = KB + 32 * KSTR;
    LAS float* ML = (LAS float*)(lds + SM_ML); LAS float* OB = (LAS float*)(lds + SM_O);
    LAS float* IA = (LAS float*)(lds + SM_IA); LAS float* IC = (LAS float*)(lds + SM_IC);
    LAS float* imp = (LAS float*)(lds + SM_IMP); LAS int* selb = (LAS int*)(lds + SM_SEL); LAS int* ulist = (LAS int*)(lds + SM_UL);
    LAS float* FIN = (LAS float*)(lds + SM_FIN);
    __syncthreads();
    bf16x8v qf[4];
#pragma unroll
    for (int s = 0; s < 4; ++s) qf[s] = *(const bf16x8v*)(QG + (size_t)grow * 2048 + h * 64 + 16 * s + 8 * hh);
    for (int i = tid; i < 16 * 64; i += 512) FIN[i] = 0.f;
    if (tid < 16) IC[tid * 132] = 0.f;
    f32x4 fk[8], fv[8];
    auto fetch = [&](const float* kp, const float* vp) {
        const int hf = lane & 1;
#pragma unroll
        for (int x = 0; x < 8; ++x) { fk[x] = (f32x4){0.f, 0.f, 0.f, 0.f}; fv[x] = fk[x]; }
        if (kp) {
#pragma unroll
            for (int x = 0; x < 8; ++x) fk[x] = *(const f32x4*)(kp + hf * 32 + 4 * x); }
        if (vp) {
#pragma unroll
            for (int x = 0; x < 8; ++x) fv[x] = *(const f32x4*)(vp + hf * 32 + 4 * x); }
    };
    auto commit = [&](bool wantK, bool wantV) {
        const int key = lane >> 1, hf = lane & 1;
        if (wantK) {
#pragma unroll
            for (int x = 0; x < 4; ++x) *(LAS u32x4*)(KB + key * KSTR + hf * 64 + x * 16) = (u32x4){pk2bf(fk[2 * x].x, fk[2 * x].y), pk2bf(fk[2 * x].z, fk[2 * x].w), pk2bf(fk[2 * x + 1].x, fk[2 * x + 1].y), pk2bf(fk[2 * x + 1].z, fk[2 * x + 1].w)}; }
        if (wantV) {
#pragma unroll
            for (int x = 0; x < 4; ++x) *(LAS u32x4*)(VB + key * VSTR + hf * 64 + x * 16) = (u32x4){pk2bf(fv[2 * x].x, fv[2 * x].y), pk2bf(fv[2 * x].z, fv[2 * x].w), pk2bf(fv[2 * x + 1].x, fv[2 * x + 1].y), pk2bf(fv[2 * x + 1].z, fv[2 * x + 1].w)}; }
    };
    auto scores = [&](f32x16& st, float cbase, float mul) {
#pragma unroll
        for (int i = 0; i < 16; ++i) st[i] = slope8 * (cbase + mul * (float)((i & 3) + 8 * (i >> 2) + 4 * hh));
#pragma unroll
        for (int s = 0; s < 4; ++s) { const bf16x8v kf = *(const LAS bf16x8v*)(KB + r * KSTR + (16 * s + 8 * hh) * 2); st = __builtin_amdgcn_mfma_f32_32x32x16_bf16(kf, qf[s], st, 0, 0, 0); }
    };
    auto pv = [&](const f32x16& p, f32x16 (&o)[2]) {
#pragma unroll
        for (int s = 0; s < 2; ++s) { const bf16x8v pf = pack8(p, s);
#pragma unroll
            for (int dt = 0; dt < 2; ++dt) o[dt] = __builtin_amdgcn_mfma_f32_32x32x16_bf16(vfrag(VB, 16 * s, 32 * dt, lane), pf, o[dt], 0, 0, 0); }
    };
    auto merge = [&](float m, float l, const f32x16 (&o)[2], int br, bool norm) {
        if (real && hh == 0) { ML[(w * 16 + c) * 2] = m; ML[(w * 16 + c) * 2 + 1] = l; }
        if (real) {
#pragma unroll
            for (int dt = 0; dt < 2; ++dt)
#pragma unroll
                for (int i = 0; i < 16; ++i) OB[(w * 16 + c) * 64 + 32 * dt + (i & 3) + 8 * (i >> 2) + 4 * hh] = o[dt][i];
        }
        __syncthreads();
        {
            const int cc = tid >> 5, d = (tid & 31) * 2;
            float M = NEGA;
#pragma unroll
            for (int ww = 0; ww < 8; ++ww) M = fmaxf(M, ML[(ww * 16 + cc) * 2]);
            float n0 = 0.f, n1 = 0.f, den = 0.f;
#pragma unroll
            for (int ww = 0; ww < 8; ++ww) { const float sc = norm ? __builtin_amdgcn_exp2f((ML[(ww * 16 + cc) * 2] - M) * C1) : 1.0f;
                n0 += sc * OB[(ww * 16 + cc) * 64 + d]; n1 += sc * OB[(ww * 16 + cc) * 64 + d + 1]; den += sc * ML[(ww * 16 + cc) * 2 + 1]; }
            const int tk = cc >> 2, hx = g * 4 + (cc & 3);
            const float gate = sigmoidf_(bf2f(UA[(size_t)(MP + b * 4 + tk) * UA_LD + ACOLS + br * 16 + hx])) / (norm ? fmaxf(den, 1e-30f) : 1.0f);
            FIN[cc * 64 + d] += gate * n0; FIN[cc * 64 + d + 1] += gate * n1;
        }
        __syncthreads();
    };
    f32x16 st0, st1;
    const float* KC = (const float*)(a.ws + WS_KCS) + (size_t)b * NCB_S * 256 + g * 64;
    const float* VC = (const float*)(a.ws + WS_VCS) + (size_t)b * NCB_S * 256 + g * 64;
    {
        const int key = lane >> 1;
        const int n0a = 32 * w, n0b = 32 * (w + 8);
        fetch(n0a + key < NCMP_S ? KC + (size_t)(n0a + key) * 256 : nullptr, nullptr); commit(true, false);
        fetch(n0b + key < NCMP_S ? KC + (size_t)(n0b + key) * 256 : nullptr, nullptr);
        scores(st0, (float)(16 * n0a + 31 - t), 16.0f);
        commit(true, false);
        fetch(nullptr, n0a + key < NCMP_S ? VC + (size_t)(n0a + key) * 256 : nullptr);
        scores(st1, (float)(16 * n0b + 31 - t), 16.0f);
        float m = NEGA;
#pragma unroll
        for (int i = 0; i < 16; ++i) { const int nn = (i & 3) + 8 * (i >> 2) + 4 * hh; if (n0a + nn >= NCMP_S) st0[i] = NEGA; if (n0b + nn >= NCMP_S) st1[i] = NEGA; m = fmaxf(m, fmaxf(st0[i], st1[i])); }
        m = xhalf_max(m);
        if (real && hh == 0) ML[(w * 16 + c) * 2] = m;
        __syncthreads();
        float M = NEGA;
#pragma unroll
        for (int ww = 0; ww < 8; ++ww) M = fmaxf(M, ML[(ww * 16 + c) * 2]);
        const float nm = -M * C1; float l = 0.f;
#pragma unroll
        for (int i = 0; i < 16; ++i) { st0[i] = __builtin_amdgcn_exp2f(fmaf(st0[i], C1, nm)); st1[i] = __builtin_amdgcn_exp2f(fmaf(st1[i], C1, nm)); l += st0[i] + st1[i]; }
        l = xhalf_sum(l);
        __syncthreads();
        if (real && hh == 0) ML[(w * 16 + c) * 2 + 1] = l;
        __syncthreads();
        float L = 0.f;
#pragma unroll
        for (int ww = 0; ww < 8; ++ww) L += ML[(ww * 16 + c) * 2 + 1];
        const float inv = 1.0f / fmaxf(L, 1e-30f);
#pragma unroll
        for (int i = 0; i < 16; ++i) { st0[i] *= inv; st1[i] *= inv; }
        if (real) {
#pragma unroll
            for (int q4 = 0; q4 < 4; ++q4) {
                const int Ja = 8 * w + 2 * q4 + hh, Jb = 8 * (w + 8) + 2 * q4 + hh;
                IA[c * 132 + Ja] = st0[4 * q4] + st0[4 * q4 + 1] + st0[4 * q4 + 2] + 0.5f * st0[4 * q4 + 3]; IC[c * 132 + Ja + 1] = 0.5f * st0[4 * q4 + 3];
                IA[c * 132 + Jb] = st1[4 * q4] + st1[4 * q4 + 1] + st1[4 * q4 + 2] + 0.5f * st1[4 * q4 + 3]; IC[c * 132 + Jb + 1] = 0.5f * st1[4 * q4 + 3];
            }
        }
        f32x16 oc[2];
#pragma unroll
        for (int i = 0; i < 16; ++i) { oc[0][i] = 0.f; oc[1][i] = 0.f; }
        commit(false, true);
        fetch(nullptr, n0b + key < NCMP_S ? VC + (size_t)(n0b + key) * 256 : nullptr);
        pv(st0, oc);
        commit(false, true);
        pv(st1, oc);
        merge(0.f, 0.f, oc, 0, false);
    }
    for (int idx = tid; idx < 4 * NSEL_S; idx += 512) {
        const int tk = idx / NSEL_S, j = idx % NSEL_S; float v = 0.f;
#pragma unroll
        for (int r4 = 0; r4 < 4; ++r4) { const int cc = tk * 4 + r4; v += (j < 128 ? IA[cc * 132 + j] : 0.f) + IC[cc * 132 + j]; }
        imp[tk * 132 + j] = v;
    }
    __syncthreads();
    for (int idx = tid; idx < 4 * NSEL_S; idx += 512) {
        const int tk = idx / NSEL_S, j = idx % NSEL_S, tb = (PAST + tk) >> 6;
        auto score = [&](int jj) -> float { const int back = tb - jj; const bool forced = jj == 0 || (back >= 0 && back < 2); return forced ? 1e4f : (back >= 0 ? imp[tk * 132 + jj] : -1.0f); };
        const float sj = score(j); int rank = 0;
        for (int jj = 0; jj < NSEL_S; ++jj) { const float s2 = score(jj); rank += (s2 > sj || (s2 == sj && jj < j)) ? 1 : 0; }
        selb[tk * 132 + j] = (rank < 16 && sj >= 0.f) ? 1 : 0;
    }
    __syncthreads();
    if (tid == 0) { int nu = 0; for (int j = 0; j < NSEL_S; ++j) { int any = 0; for (int tk = 0; tk < 4; ++tk) any |= selb[tk * 132 + j]; if (any) ulist[nu++] = j; } ulist[132] = nu; }
    __syncthreads();
    const int nu = ulist[132];
#pragma unroll 1
    for (int br = 1; br <= 2; ++br) {
        const int ntile = br == 1 ? 2 * nu : 17;
        f32x16 o[2];
#pragma unroll
        for (int i = 0; i < 16; ++i) { o[0][i] = 0.f; o[1][i] = 0.f; }
        float m = NEGA, l = 0.f;
        auto tile_ptr = [&](int ti, const float*& kp) -> int {
            const int key = lane >> 1;
            if (br == 1) { const int j = ulist[ti >> 1], kk = 32 * (ti & 1) + key;
                if (j < 128) kp = a.in[3] + ((size_t)pt[b * NPAGES + (j >> 1)] * PAGE + (j & 1) * 64 + kk) * 512 + g * 64;
                else kp = kk < 4 ? a.out + O_SSEL + ((size_t)b * 4 + kk) * 512 + g * 64 : nullptr;
                return 64 * j + 32 * (ti & 1); }
            const int i = 32 * ti + key;
            kp = i < 512 ? a.in[4] + ((size_t)b * 512 + i) * 512 + g * 64 : (i < 516 ? a.out + O_SWIN + ((size_t)b * 512 + 508 + (i - 512)) * 512 + g * 64 : nullptr);
            return PAST - WINDOW + 32 * ti;
        };
        int ti = w;
        const float* kp = nullptr; int kpos0 = 0;
        if (ti < ntile) { kpos0 = tile_ptr(ti, kp); fetch(kp, kp ? kp + 256 : nullptr); }
        while (ti < ntile) {
            commit(true, true);
            const int tin = ti + 8; const int kpos_c = kpos0; const int jcur = br == 1 ? ulist[ti >> 1] : 0;
            if (tin < ntile) { kpos0 = tile_ptr(tin, kp); fetch(kp, kp ? kp + 256 : nullptr); }
            f32x16 st;
            scores(st, (float)(kpos_c - t), 1.0f);
            const bool unsel = br == 1 && selb[tok * 132 + jcur] == 0;
            {
                const int dbase = unsel ? -100000 : t - kpos_c - 4 * hh;
                const unsigned dmax = br == 2 ? (unsigned)WINDOW : 0x7fffffffu;
#pragma unroll
                for (int i = 0; i < 16; ++i) st[i] = (unsigned)(dbase - ((i & 3) + 8 * (i >> 2))) <= dmax ? st[i] : NEGA;
            }
            float mr = NEGA;
#pragma unroll
            for (int i = 0; i < 16; ++i) mr = fmaxf(mr, st[i]);
            const float mx = fmaxf(m, xhalf_max(mr));
            const float nm = -fmaxf(mx, -1e20f) * C1, corr = __builtin_amdgcn_exp2f((m - mx) * C1);
            float ls = 0.f;
#pragma unroll
            for (int i = 0; i < 16; ++i) { st[i] = __builtin_amdgcn_exp2f(fmaf(st[i], C1, nm)); ls += st[i]; }
            l = l * corr + ls; m = mx;
#pragma unroll
            for (int i = 0; i < 16; ++i) { o[0][i] *= corr; o[1][i] *= corr; }
            pv(st, o);
            ti = tin;
        }
        l = xhalf_sum(l);
        merge(m, l, o, br, true);
    }
    {
        const int cc = tid >> 5, d = (tid & 31) * 2, tk = cc >> 2, hx = g * 4 + (cc & 3);
        const size_t row = (size_t)(MP + b * 4 + tk);
        const unsigned gw = *(const unsigned*)(QG + row * 2048 + 1024 + hx * 64 + d);
        const float g0 = __uint_as_float(gw << 16), g1 = __uint_as_float(gw & 0xffff0000u);
        const float y0 = FIN[cc * 64 + d] * g0 / (1.0f + __expf(-g0)), y1 = FIN[cc * 64 + d + 1] * g1 / (1.0f + __expf(-g1));
        *(unsigned*)((bf16*)(a.ws + WS_OAB) + (size_t)MPAD * 1024 + row * 1024 + hx * 64 + d) = pk2bf(y0, y1);
    }
    __syncthreads();
}

__device__ __forceinline__ void p4_post(const Args& a, int row_lo, int row_hi, int row_step) {
    const int tid = threadIdx.x, h = tid >> 5;
    const float* ORAW = (const float*)(a.ws + WS_ORAW); const float* PREP = (const float*)(a.ws + WS_PREP); const bf16* SG = (const bf16*)(a.ws + WS_SG); const float* BON = (const float*)(a.ws + WS_BONUS);
    bf16* OA = (bf16*)(a.ws + WS_OAB);
    const int c = (tid & 31) * 2, ch = h * 64 + c;
    const float gw0 = a.in[18][ch], gw1 = a.in[18][ch + 1], gb0 = a.in[19][ch], gb1 = a.in[19][ch + 1];
    for (int row0 = row_lo; row0 < row_hi; row0 += 8 * row_step) {
        float o0[8], o1[8], bon[8]; unsigned vw2[8], sgw[8];
#pragma unroll
        for (int u = 0; u < 8; ++u) { int row = row0 + u * row_step; row = row < row_hi ? row : row0;
            const f32n2 ov = *(const f32n2*)(ORAW + (size_t)row * 1024 + ch); o0[u] = ov.x; o1[u] = ov.y;
            bon[u] = BON[(size_t)row * 16 + h];
            vw2[u] = *(const unsigned*)((const bf16*)(a.ws + WS_VB) + (size_t)row * 1024 + ch);
            sgw[u] = *(const unsigned*)(SG + (size_t)row * 1024 + ch); }
#pragma unroll
        for (int u = 0; u < 8; ++u) { const int row = row0 + u * row_step;
            const float s = x16_sum(row16_allsum(o0[u] + o1[u]));
            const float mean = s * (1.0f / 64.0f), d0 = o0[u] - mean, d1 = o1[u] - mean;
            const float q = x16_sum(row16_allsum(d0 * d0 + d1 * d1));
            const float rstd = rsqrtf(q * (1.0f / 64.0f) + GN_EPS);
            const float y0 = (d0 * rstd * gw0 + gb0 + bon[u] * __uint_as_float(vw2[u] << 16)) * __uint_as_float(sgw[u] << 16), y1 = (d1 * rstd * gw1 + gb1 + bon[u] * __uint_as_float(vw2[u] & 0xffff0000u)) * __uint_as_float(sgw[u] & 0xffff0000u);
            if (row < row_hi) *(unsigned*)(OA + (size_t)row * 1024 + ch) = pk2bf(y0, y1); }
    }
}

struct Sched2 {
    int G, c;
    __device__ bool next(int i, pg8::Unit& u) const { const int p = (i >> 1) * G + c; if (p >= 65 * 8) return false; const int hf = i & 1; u.pm = (p >> 3) + hf * 65; u.pn = (p & 7) + hf * 8; return true; }
    __device__ __forceinline__ void a_ready(const pg8::Unit&) const {}
    __device__ __forceinline__ void done(const pg8::Unit&) const {}
};
struct EpiG2 {
    static constexpr bool PERM = true, AFTER_DRAIN = false;
    const bf16* GATES; bf16* MERGED;
    __device__ __forceinline__ void operator()(const pg8::f32x4 (&acc)[2][2][4][2], const pg8::Unit& u, int wr, int wc, int fr, int fq) const {
        const int hf = u.pm >= 65 ? 1 : 0, pm = u.pm - 65 * hf, pn = u.pn - 8 * hf;
        const int row0 = pm * 256 + wr * 64 + fr, cl0 = pn * 256 + wc * 32 + fq * 8;
#pragma unroll
        for (int ai = 0; ai < 2; ++ai)
#pragma unroll
            for (int m = 0; m < 4; ++m) {
                const int row = row0 + ai * 128 + m * 16;
#pragma unroll
                for (int bj = 0; bj < 2; ++bj) {
                    const int col = cl0 + bj * 128;
                    float gt[8], pv[8];
                    unpack8(*(const u32x4*)(GATES + (size_t)row * 4096 + hf * 2048 + col), gt);
                    const pg8::f32x4 v0 = acc[ai][bj][m][0], v1 = acc[ai][bj][m][1];
                    float r[8] = {gt[0] * v0[0], gt[1] * v0[1], gt[2] * v0[2], gt[3] * v0[3], gt[4] * v1[0], gt[5] * v1[1], gt[6] * v1[2], gt[7] * v1[3]};
                    bf16* d = MERGED + (size_t)row * 2048 + col;
                    if (hf) { unpack8(*(const u32x4*)d, pv);
#pragma unroll
                        for (int i = 0; i < 8; ++i) r[i] += pv[i]; }
                    u32x4 w; w.x = pg8::cvt_pk_bf16(r[0], r[1]); w.y = pg8::cvt_pk_bf16(r[2], r[3]); w.z = pg8::cvt_pk_bf16(r[4], r[5]); w.w = pg8::cvt_pk_bf16(r[6], r[7]);
                    *(u32x4*)d = w;
                }
            }
    }
};
struct EpiG3 {
    static constexpr bool PERM = true, AFTER_DRAIN = false;
    const float* xp; const float* xs; float* y; float* sumsq;
    __device__ __forceinline__ void operator()(const pg8::f32x4 (&acc)[2][2][4][2], const pg8::Unit& u, int wr, int wc, int fr, int fq) const {
        const int row0 = u.pm * 256 + wr * 64 + fr, cl0 = u.pn * 256 + wc * 32 + fq * 8;
#pragma unroll
        for (int ai = 0; ai < 2; ++ai)
#pragma unroll
            for (int m = 0; m < 4; ++m) {
                const int row = row0 + ai * 128 + m * 16;
                float ss = 0.f;
                if (row < MT) {
                    const float* xr = row < MP ? xp + (size_t)row * D : xs + (size_t)(row - MP) * D;
#pragma unroll
                    for (int bj = 0; bj < 2; ++bj) {
                        const int col = cl0 + bj * 128;
                        const pg8::f32x4 h0 = acc[ai][bj][m][0] + *(const pg8::f32x4*)(xr + col), h1 = acc[ai][bj][m][1] + *(const pg8::f32x4*)(xr + col + 4);
                        *(pg8::f32x4*)(y + (size_t)row * D + col) = h0; *(pg8::f32x4*)(y + (size_t)row * D + col + 4) = h1;
                        ss += h0[0] * h0[0] + h0[1] * h0[1] + h0[2] * h0[2] + h0[3] * h0[3] + h1[0] * h1[0] + h1[1] * h1[1] + h1[2] * h1[2] + h1[3] * h1[3];
                    }
                }
                ss = xhalf_sum(x16_sum(ss));
                if (fq == 0 && row < MT) sumsq[(size_t)row * 32 + u.pn * 4 + wc] = ss;
            }
    }
};

struct Sched2s {
    pg8::StaticOrder S;
    __device__ bool next(int i, pg8::Unit& u) const { if (!S.next(i, u)) return false; u.pm += 65 * (u.pn >> 3); return true; }
    __device__ __forceinline__ void a_ready(const pg8::Unit&) const {}
    __device__ __forceinline__ void done(const pg8::Unit&) const {}
};
struct EpiBf {
    static constexpr bool PERM = true, AFTER_DRAIN = false;
    bf16* O; int ld;
    __device__ __forceinline__ void operator()(const pg8::f32x4 (&acc)[2][2][4][2], const pg8::Unit& u, int wr, int wc, int fr, int fq) const {
        const int pm = u.pm >= 65 ? u.pm - 65 : u.pm;
        const int row0 = pm * 256 + wr * 64 + fr, cl0 = u.pn * 256 + wc * 32 + fq * 8;
#pragma unroll
        for (int ai = 0; ai < 2; ++ai)
#pragma unroll
            for (int m = 0; m < 4; ++m) {
                const int row = row0 + ai * 128 + m * 16;
#pragma unroll
                for (int bj = 0; bj < 2; ++bj) {
                    const pg8::f32x4 v0 = acc[ai][bj][m][0], v1 = acc[ai][bj][m][1];
                    u32x4 w; w.x = pg8::cvt_pk_bf16(v0[0], v0[1]); w.y = pg8::cvt_pk_bf16(v0[2], v0[3]); w.z = pg8::cvt_pk_bf16(v1[0], v1[1]); w.w = pg8::cvt_pk_bf16(v1[2], v1[3]);
                    *(u32x4*)(O + (size_t)row * ld + cl0 + bj * 128) = w;
                }
            }
    }
};
struct SchedOne {
    pg8::Unit u0;
    __device__ bool next(int i, pg8::Unit& u) const { if (i != 0) return false; u = u0; return true; }
    __device__ __forceinline__ void a_ready(const pg8::Unit&) const {}
    __device__ __forceinline__ void done(const pg8::Unit&) const {}
};
__device__ __forceinline__ void p5_merge(const Args& a, size_t i_lo, size_t i_hi, size_t i_step) {
    const bf16* G = (const bf16*)(a.ws + WS_GATES); const bf16* P = (const bf16*)(a.ws + WS_PAB); bf16* Mg = (bf16*)(a.ws + WS_MERGED);
    for (size_t i0 = i_lo + threadIdx.x; i0 < i_hi; i0 += 2 * i_step) {
        u32x4 rg[2][4];
#pragma unroll
        for (int u = 0; u < 2; ++u) { size_t i = i0 + u * i_step; i = i < i_hi ? i : i0; const size_t row = i >> 8; const int c = (int)(i & 255) * 8;
            rg[u][0] = *(const u32x4*)(G + row * 4096 + c); rg[u][1] = *(const u32x4*)(G + row * 4096 + 2048 + c); rg[u][2] = *(const u32x4*)(P + row * 4096 + c); rg[u][3] = *(const u32x4*)(P + row * 4096 + 2048 + c); }
#pragma unroll
        for (int u = 0; u < 2; ++u) { const size_t i = i0 + u * i_step; const size_t row = i >> 8; const int c = (int)(i & 255) * 8;
            float ga[8], gb[8], pa[8], pb[8];
            unpack8(rg[u][0], ga); unpack8(rg[u][1], gb); unpack8(rg[u][2], pa); unpack8(rg[u][3], pb);
#pragma unroll
            for (int e = 0; e < 8; ++e) {
                const float da = 1.0f + __expf(-fmaxf(ga[e], -40.0f)), db = 1.0f + __expf(-fmaxf(gb[e], -40.0f)), inv = 1.0f / (da * db);
                ga[e] = db * inv; gb[e] = da * inv; }
            u32x4 w; w.x = pk2bf(ga[0] * pa[0] + gb[0] * pb[0], ga[1] * pa[1] + gb[1] * pb[1]); w.y = pk2bf(ga[2] * pa[2] + gb[2] * pb[2], ga[3] * pa[3] + gb[3] * pb[3]);
            w.z = pk2bf(ga[4] * pa[4] + gb[4] * pb[4], ga[5] * pa[5] + gb[5] * pb[5]); w.w = pk2bf(ga[6] * pa[6] + gb[6] * pb[6], ga[7] * pa[7] + gb[7] * pb[7]);
            if (i < i_hi) *(u32x4*)(Mg + row * 2048 + c) = w; }
    }
}
__device__ __forceinline__ void p7_final(const Args& a) {
    const int tid = threadIdx.x, lane = tid & 63, wave = tid >> 6;
    const bf16* DL = (const bf16*)(a.ws + WS_DELTA); const float* gout = a.in[27];
    for (int row = blockIdx.x * 8 + wave; row < MT; row += gridDim.x * 8) {
        const float* x = row < MP ? a.in[0] + (size_t)row * D : a.in[1] + (size_t)(row - MP) * D;
        float h[32]; float ss = 0.f;
#pragma unroll
        for (int i = 0; i < 4; ++i) {
            const int c = i * 512 + lane * 8; float dl[8]; unpack8(*(const u32x4*)(DL + (size_t)row * D + c), dl);
            const f32x4 x0 = *(const f32x4*)(x + c), x1 = *(const f32x4*)(x + c + 4);
            h[8 * i + 0] = x0.x + dl[0]; h[8 * i + 1] = x0.y + dl[1]; h[8 * i + 2] = x0.z + dl[2]; h[8 * i + 3] = x0.w + dl[3];
            h[8 * i + 4] = x1.x + dl[4]; h[8 * i + 5] = x1.y + dl[5]; h[8 * i + 6] = x1.z + dl[6]; h[8 * i + 7] = x1.w + dl[7];
#pragma unroll
            for (int j = 0; j < 8; ++j) ss += h[8 * i + j] * h[8 * i + j];
        }
        ss = wave_sum(ss);
        const float rs = rsqrtf(ss * (1.0f / D) + RMS_EPS);
        float* y = a.out + (size_t)row * D;
#pragma unroll
        for (int i = 0; i < 4; ++i) {
            const int c = i * 512 + lane * 8; const f32x4 g0 = *(const f32x4*)(gout + c), g1 = *(const f32x4*)(gout + c + 4);
            *(f32x4*)(y + c) = (f32x4){h[8 * i + 0] * rs * g0.x, h[8 * i + 1] * rs * g0.y, h[8 * i + 2] * rs * g0.z, h[8 * i + 3] * rs * g0.w};
            *(f32x4*)(y + c + 4) = (f32x4){h[8 * i + 4] * rs * g1.x, h[8 * i + 5] * rs * g1.y, h[8 * i + 6] * rs * g1.z, h[8 * i + 7] * rs * g1.w};
        }
    }
}

__device__ __forceinline__ void p7_norm(const Args& a) {
    const int tid = threadIdx.x, lane = tid & 63, wave = tid >> 6;
    const float* sumsq = (const float*)(a.ws + WS_SUMSQ); const float* gout = a.in[27];
    for (int row = blockIdx.x * 8 + wave; row < MT; row += gridDim.x * 8) {
        float s = lane < 32 ? sumsq[(size_t)row * 32 + lane] : 0.f; s = wave_sum(s);
        const float rs = rsqrtf(s * (1.0f / D) + RMS_EPS);
        float* y = a.out + (size_t)row * D;
#pragma unroll
        for (int i = 0; i < 8; ++i) { f32x4 v = *(f32x4*)(y + i * 256 + lane * 4); const f32x4 gg = *(const f32x4*)(gout + i * 256 + lane * 4);
            v.x *= rs * gg.x; v.y *= rs * gg.y; v.z *= rs * gg.z; v.w *= rs * gg.w; *(f32x4*)(y + i * 256 + lane * 4) = v; }
    }
}

constexpr int N_PHASES = 12;
__global__ void __launch_bounds__(512, 2) fwd(Args a) {
    extern __shared__ __align__(16) unsigned char smem[];
    LAS unsigned char* lds = (LAS unsigned char*)smem;
    const int tid = threadIdx.x;
    volatile LAS unsigned* xbw = (volatile LAS unsigned*)(lds + LDS_BYTES - 16);
    LAS int* qitem = (LAS int*)(lds + LDS_BYTES - 32);
    if (tid < 4) xbw[tid] = 0u;
    __syncthreads();
    unsigned* ctl = (unsigned*)(a.ws + WS_CTL);
    const int lo = a.ph_lo, hi = a.ph_hi;
    XcdBarrier bar; bar.bar = ctl + CW_BAR; bar.x = 0; bar.st = xbw;
    if (hi - lo > 1) bar = xcd_barrier_post(ctl + CW_BAR, xbw);
#ifndef PH_MASK
#define PH_MASK 0xffff
#endif
#define IN(k) (((PH_MASK >> (k)) & 1) && lo <= (k) && (k) < hi)
#define SEAM(k) do { if (IN(k) && IN((k) + 1)) xcd_barrier(bar); } while (0)

    if (IN(0)) p0_prologue(a, lds);
    SEAM(0);
    if (IN(1)) {
        pg8::Gemm g{(const bf16*)(a.ws + WS_XN), (const bf16*)(a.ws + WS_WIN_T), MPAD, NIN, D};
        pg8::StaticOrder S; S.init(MPAD, NIN, (int)gridDim.x, (int)blockIdx.x);
        EpiG1 E{(bf16*)(a.ws + WS_UA), (bf16*)(a.ws + WS_QG), (float*)(a.ws + WS_KVW), (bf16*)(a.ws + WS_GATES), a.out, (bf16*)(a.ws + WS_KVSB), (bf16*)(a.ws + WS_KVWB)};
        pg8::gemm_phase<EpiG1, pg8::StaticOrder, false>(lds, g, S, E, nullptr);
    }
    SEAM(1);
    if (IN(2)) p2_pre(a);
    SEAM(2);
    if (IN(3)) {
        int cur_hp = -1;
        for (int it = blockIdx.x; it < 258 * 8; it += gridDim.x) { const int tt = it < 16 ? 256 + (it >> 3) : (it - 16) >> 3, hp = it & 7;
            if (hp != cur_hp) { __syncthreads(); prep_consts(a, hp, lds); cur_hp = hp; __syncthreads(); }
            prep_pair(a, tt, hp, lds); }
        __syncthreads();
        for (int it = blockIdx.x; it < BATCH * 32; it += gridDim.x) { const int b = it >> 5, n0 = (it & 31) * 4; const int cnt = (NCMP_P - n0) < 4 ? (NCMP_P - n0) : 4; compress_item<false>(a, b, n0, cnt, (LAS float*)lds); }
    }
    SEAM(3);
    if (IN(4)) {
        constexpr int N_CH = 2 * (BATCH * AH + DB * AH), N_PA = BATCH * 4 * 32, N_SA = DB * 4;
#ifndef P3_MASK
#define P3_MASK 7
#endif
        if ((P3_MASK & 1) && (a.p3mask & 1)) {
            if (gridDim.x >= 2 * BATCH * AH) {
                const int cp = (blockIdx.x >> 5) * 8 + (blockIdx.x & 7);
                if ((blockIdx.x & 24) == 0 && cp < BATCH * AH / 2) { const int ca = 2 * cp, cbn = 2 * cp + 1;
                    chain_seq(a.ws + WS_CHUNK + (size_t)ca * 128 * CK_BYTES, a.ws + WS_CHUNK + (size_t)cbn * 128 * CK_BYTES, SEQ / 16, a.out + O_PRWKV + (size_t)ca * 4096, a.out + O_PRWKV + (size_t)cbn * 4096,
                              (float*)(a.ws + WS_ORAW) + (size_t)(ca >> 4) * SEQ * 1024 + (ca & 15) * 64, (float*)(a.ws + WS_ORAW) + (size_t)(cbn >> 4) * SEQ * 1024 + (cbn & 15) * 64, lds); }
            } else {
                for (int cp = blockIdx.x; cp < BATCH * AH / 2; cp += gridDim.x) { const int ca = 2 * cp, cbn = 2 * cp + 1;
                    chain_seq(a.ws + WS_CHUNK + (size_t)ca * 128 * CK_BYTES, a.ws + WS_CHUNK + (size_t)cbn * 128 * CK_BYTES, SEQ / 16, a.out + O_PRWKV + (size_t)ca * 4096, a.out + O_PRWKV + (size_t)cbn * 4096,
                              (float*)(a.ws + WS_ORAW) + (size_t)(ca >> 4) * SEQ * 1024 + (ca & 15) * 64, (float*)(a.ws + WS_ORAW) + (size_t)(cbn >> 4) * SEQ * 1024 + (cbn & 15) * 64, lds); }
            }
            for (;;) {
                __syncthreads();
                if (tid == 0) *qitem = (int)atomicAdd(ctl + CW_QUEUE, 1u);
                __syncthreads();
                const int it = *qitem;
                if (it >= 2 * DB * AH) break;
                const int hf = it & 1, ci = it >> 1, b = ci >> 4, h = ci & 15, row0 = MP + b * 4;
                scan_half<4>((const float*)(a.ws + WS_PREP) + ((size_t)row0 * 16 + h) * 384, DS, a.in[5] + (size_t)ci * 4096, a.out + O_SRWKV + (size_t)ci * 4096, (float*)(a.ws + WS_ORAW) + (size_t)row0 * 1024 + h * 64, hf, (LAS float*)lds);
            }
        }
        if ((P3_MASK & 4) && (a.p3mask & 4)) for (;;) {
            __syncthreads();
            if (tid == 0) *qitem = (int)atomicAdd(ctl + CW_QUEUE + 128, 1u);
            __syncthreads();
            const int ai = *qitem;
            if (ai >= N_SA) break;
            attn_sample_mfma(a, ai >> 2, ai & 3, lds);
        }
        if ((P3_MASK & 2) && (a.p3mask & 2)) {
            __syncthreads();
            if (tid == 0) *qitem = (int)atomicAdd(ctl + CW_QUEUE + 64, 1u);
            __syncthreads();
            int ai = *qitem; unsigned tacc = 0u;
            LAS int* qnext = (LAS int*)(lds + LDS_BYTES - 48);
            while (ai < N_PA) {
                int nxt = 0;
                if (tid == 0) nxt = (int)atomicAdd(ctl + CW_QUEUE + 64, 1u);
                attn_mfma_item(a, (ai & 31) >> 2, ai & 3, 31 - (ai >> 5), lds, nxt, qnext, tacc);
                __syncthreads();
                ai = *qnext;
            }
            if (tacc == 0x9e3779b9u && c_never(tid)) ctl[CW_QUEUE + 320] = tacc;
        }
    }
    SEAM(4);
    const int nsp2 = gridDim.x >= 64 ? 16 : 0, nsp3 = gridDim.x >= 64 ? 8 : 0;
    if (IN(5)) p4_post(a, MP + (int)blockIdx.x, MT, (int)gridDim.x);
    SEAM(5);
    if (IN(6)) {
        if ((int)blockIdx.x < nsp2) {
            const int hf = blockIdx.x >> 3, pn = blockIdx.x & 7;
            pg8::Gemm g{(const bf16*)(a.ws + WS_OAB), (const bf16*)(a.ws + WS_WPAB_T), 2 * MPAD, 4096, 1024};
            SchedOne S{{64 + 65 * hf, pn + 8 * hf}};
            EpiBf E{(bf16*)(a.ws + WS_PAB), 4096};
            pg8::gemm_phase<EpiBf, SchedOne, false>(lds, g, S, E, nullptr);
        } else p4_post(a, (int)blockIdx.x - nsp2, MP, (int)gridDim.x - nsp2);
    }
    SEAM(6);
    if (IN(7)) {
        pg8::Gemm g{(const bf16*)(a.ws + WS_OAB), (const bf16*)(a.ws + WS_WPAB_T), 2 * MPAD, 4096, 1024};
        Sched2s S; S.S.init(nsp2 ? MP : MPAD, 4096, (int)gridDim.x, (int)blockIdx.x);
        EpiBf E{(bf16*)(a.ws + WS_PAB), 4096};
        pg8::gemm_phase<EpiBf, Sched2s, false>(lds, g, S, E, nullptr);
        if (nsp2) p5_merge(a, (size_t)MP * 256 + (size_t)blockIdx.x * 512, (size_t)MPAD * 256, (size_t)gridDim.x * 512);
    }
    SEAM(7);
    if (IN(8) && !nsp2) p5_merge(a, (size_t)MP * 256 + (size_t)blockIdx.x * 512, (size_t)MPAD * 256, (size_t)gridDim.x * 512);
    if (!nsp2) SEAM(8);
    if (IN(9)) {
        if ((int)blockIdx.x < nsp3) {
            pg8::Gemm g{(const bf16*)(a.ws + WS_MERGED), (const bf16*)(a.ws + WS_WO_T), MPAD, D, D};
            SchedOne S{{64, (int)blockIdx.x}};
            EpiBf E{(bf16*)(a.ws + WS_DELTA), D};
            pg8::gemm_phase<EpiBf, SchedOne, false>(lds, g, S, E, nullptr);
        } else p5_merge(a, (size_t)((int)blockIdx.x - nsp3) * 512, (size_t)MP * 256, (size_t)((int)gridDim.x - nsp3) * 512);
    }
    SEAM(9);
    if (IN(10)) {
        pg8::Gemm g{(const bf16*)(a.ws + WS_MERGED), (const bf16*)(a.ws + WS_WO_T), MPAD, D, D};
        pg8::StaticOrder S; S.init(nsp3 ? MP : MPAD, D, (int)gridDim.x, (int)blockIdx.x);
        EpiBf E{(bf16*)(a.ws + WS_DELTA), D};
        pg8::gemm_phase<EpiBf, pg8::StaticOrder, false>(lds, g, S, E, nullptr);
    }
    SEAM(10);
    if (IN(11)) p7_final(a);
#undef IN
#undef SEAM
}

#ifndef MK_ONE_LAUNCH
#define MK_ONE_LAUNCH 1
#endif
extern "C" void kernel_launch(void* const* d_in, const int* in_sizes, int n_in, void* d_out, int out_size, void* d_ws, size_t ws_size, hipStream_t stream) {
    static int grid = 0;
    if (grid == 0) {
        int dev = 0, cus = 0;
        if (n_in != 28 || (size_t)out_size != O_END || ws_size < WS_END) { fprintf(stderr, "kernel_launch: unexpected shapes (n_in %d out %d ws %zu, need %zu)\n", n_in, out_size, ws_size, (size_t)WS_END); grid = -1; return; }
        if (hipGetDevice(&dev) != hipSuccess || hipDeviceGetAttribute(&cus, hipDeviceAttributeMultiprocessorCount, dev) != hipSuccess) { grid = -1; return; }
        if (hipFuncSetAttribute((const void*)fwd, hipFuncAttributeMaxDynamicSharedMemorySize, LDS_BYTES) != hipSuccess) { fprintf(stderr, "kernel_launch: hipFuncSetAttribute failed\n"); grid = -1; return; }
        int per_cu = 0;
        if (hipOccupancyMaxActiveBlocksPerMultiprocessor(&per_cu, (const void*)fwd, 512, LDS_BYTES) != hipSuccess || per_cu < 1) fprintf(stderr, "kernel_launch: occupancy query says %d\n", per_cu);
        (void)hipGetLastError();
        grid = cus;
    }
    if (grid < 0) return;
    (void)hipMemsetAsync((char*)d_ws + WS_CTL, 0, CTL_BYTES, stream);
    Args a{};
    for (int i = 0; i < 28; ++i) a.in[i] = (const float*)d_in[i];
    a.out = (float*)d_out; a.ws = (unsigned char*)d_ws;
#if MK_ONE_LAUNCH
    a.ph_lo = 0; a.ph_hi = N_PHASES; a.p3mask = 7;
    hipLaunchKernelGGL(fwd, dim3(grid), dim3(512), LDS_BYTES, stream, a);
#ifdef PROBE_PHASE
    (void)hipMemsetAsync((char*)d_ws + WS_CTL, 0, CTL_BYTES, stream);
#ifdef PROBE_P3MASK
    a.p3mask = PROBE_P3MASK;
#endif
    a.ph_lo = PROBE_PHASE; a.ph_hi = PROBE_PHASE + 1;
    hipLaunchKernelGGL(fwd, dim3(grid), dim3(512), LDS_BYTES, stream, a);
#endif
#else
    a.p3mask = 7; for (int p = 0; p < N_PHASES; ++p) { a.ph_lo = p; a.ph_hi = p + 1; hipLaunchKernelGGL(fwd, dim3(grid), dim3(512), LDS_BYTES, stream, a); }
#endif
}
```

```cpp
#include <hip/hip_runtime.h>
#include <stdint.h>
#include <stdio.h>

#define LAS __attribute__((address_space(3)))
typedef unsigned short bf16;
typedef float f32x4 __attribute__((ext_vector_type(4)));
typedef unsigned u32x4 __attribute__((ext_vector_type(4)));
typedef unsigned u32x2 __attribute__((ext_vector_type(2)));

constexpr int D = 2048, BATCH = 8, SEQ = 2048, DB = 32, DS = 4, PAST = 8192, PAGE = 128, NPAGES = PAST / PAGE;
constexpr int MP = BATCH * SEQ, MS = DB * DS, MT = MP + MS, MPAD = 16640;
constexpr int AH = 16, AN = 64, AW = 1024, ACOLS = 4224;
constexpr int NIN = 12032, IN_COLS = 11952, UA_LD = 4352;
constexpr int WINDOW = 512;
constexpr float RMS_EPS = 1e-6f, GN_EPS = 64e-5f, ATTN_SCALE = 0.125f;
constexpr int NCMP_P = 127, NCMP_S = 511, NCB_P = 128, NCB_S = 512;
constexpr int NSEL_P = 32, NSEL_S = 129;
constexpr int LDS_BYTES = 147456;

constexpr size_t O_YP = 0, O_YS = O_YP + (size_t)MP * D, O_PCMP = O_YS + (size_t)MS * D, O_PSEL = O_PCMP + (size_t)MP * 512, O_PWIN = O_PSEL + (size_t)MP * 512,
                 O_PRWKV = O_PWIN + (size_t)BATCH * 512 * 512, O_PSHIFT = O_PRWKV + (size_t)BATCH * AH * 64 * 64, O_SCMP = O_PSHIFT + (size_t)BATCH * ACOLS,
                 O_SSEL = O_SCMP + (size_t)MS * 512, O_SWIN = O_SSEL + (size_t)MS * 512, O_SRWKV = O_SWIN + (size_t)DB * 512 * 512, O_SSHIFT = O_SRWKV + (size_t)DB * AH * 64 * 64,
                 O_END = O_SSHIFT + (size_t)DB * ACOLS;
static_assert(O_END == 64001024, "output size");

constexpr size_t al256(size_t x) { return (x + 255) & ~(size_t)255; }
constexpr size_t WS_CTL = 0, CTL_BYTES = 65536;
constexpr size_t WS_WIN_T = WS_CTL + CTL_BYTES;
constexpr size_t WS_WPAB_T = al256(WS_WIN_T + (size_t)NIN * D * 2);
constexpr size_t WS_WO_T = al256(WS_WPAB_T + (size_t)4096 * 1024 * 2);
constexpr size_t WS_XN = al256(WS_WO_T + (size_t)D * D * 2);
constexpr size_t WS_UA = al256(WS_XN + (size_t)MPAD * D * 2);
constexpr size_t WS_QG = al256(WS_UA + (size_t)MPAD * UA_LD * 2);
constexpr size_t WS_KVW = al256(WS_QG + (size_t)MPAD * 2048 * 2);
constexpr size_t WS_GATES = al256(WS_KVW + (size_t)MPAD * 512 * 4);
constexpr size_t WS_PREP = al256(WS_GATES + (size_t)MPAD * 4096 * 2);
constexpr size_t WS_SG = al256(WS_PREP + (size_t)MT * 16 * 384 * 4);
constexpr size_t WS_BONUS = al256(WS_SG + (size_t)MT * 1024 * 2);
constexpr size_t WS_ORAW = al256(WS_BONUS + (size_t)MT * 16 * 4);
constexpr size_t WS_OAB = al256(WS_ORAW + (size_t)MT * 1024 * 4);
constexpr size_t WS_MERGED = al256(WS_OAB + (size_t)2 * MPAD * 1024 * 2);
constexpr size_t WS_SUMSQ = al256(WS_MERGED + (size_t)MPAD * 2048 * 2);
constexpr size_t WS_KCP = al256(WS_SUMSQ + (size_t)MPAD * 32 * 4);
constexpr size_t WS_VCP = al256(WS_KCP + (size_t)BATCH * NCB_P * 256 * 4);
constexpr size_t WS_KCS = al256(WS_VCP + (size_t)BATCH * NCB_P * 256 * 4);
constexpr size_t WS_VCS = al256(WS_KCS + (size_t)DB * NCB_S * 256 * 4);
constexpr size_t WS_KVSB = al256(WS_VCS + (size_t)DB * NCB_S * 256 * 4);
constexpr size_t WS_KVWB = al256(WS_KVSB + (size_t)MPAD * 512 * 2);
constexpr size_t WS_WUPT = al256(WS_KVWB + (size_t)MPAD * 512 * 2);
constexpr size_t WS_PAB = al256(WS_WUPT + (size_t)2 * 1024 * 64 * 2);
constexpr size_t WS_DELTA = al256(WS_PAB + (size_t)MPAD * 4096 * 2);
constexpr size_t WS_CHUNK = al256(WS_DELTA + (size_t)MPAD * 2048 * 2);
constexpr size_t WS_VB = al256(WS_CHUNK + (size_t)BATCH * AH * 128 * 12288);
constexpr size_t WS_END = al256(WS_VB + (size_t)MT * 1024 * 2);
constexpr int CW_BAR = 0;
constexpr int CW_QUEUE = 4096;

struct Args {
    const float* in[28];
    float* out;
    unsigned char* ws;
    int ph_lo, ph_hi, p3mask, pad_;
};
static_assert(sizeof(Args) == 30 * 8 + 16, "Args has no holes");

__device__ __forceinline__ float bf2f(unsigned short b) { return __uint_as_float(((unsigned)b) << 16); }
typedef __bf16 bf16n2 __attribute__((ext_vector_type(2)));
typedef float f32n2 __attribute__((ext_vector_type(2)));
__device__ __forceinline__ unsigned short f2bf(float f) { const __bf16 h = (__bf16)f; return __builtin_bit_cast(unsigned short, h); }
__device__ __forceinline__ unsigned pk2bf(float lo, float hi) { const f32n2 v = {lo, hi}; const bf16n2 h = __builtin_convertvector(v, bf16n2); return __builtin_bit_cast(unsigned, h); }
__device__ __forceinline__ float sigmoidf_(float x) { return 1.0f / (1.0f + __expf(-x)); }
#define DPPF(x, ctrl) __int_as_float(__builtin_amdgcn_update_dpp(0, __float_as_int(x), (ctrl), 0xf, 0xf, false))
__device__ __forceinline__ float xhalf_sum(float x) { const auto r = __builtin_amdgcn_permlane32_swap(__float_as_uint(x), __float_as_uint(x), false, false); return __uint_as_float(r[0]) + __uint_as_float(r[1]); }
__device__ __forceinline__ float xhalf_max(float x) { const auto r = __builtin_amdgcn_permlane32_swap(__float_as_uint(x), __float_as_uint(x), false, false); return fmaxf(__uint_as_float(r[0]), __uint_as_float(r[1])); }
__device__ __forceinline__ float wave_sum(float v) {
    v += DPPF(v, 0xB1); v += DPPF(v, 0x4E); v += DPPF(v, 0x141); v += DPPF(v, 0x140);
    { const auto r = __builtin_amdgcn_permlane16_swap(__float_as_uint(v), __float_as_uint(v), false, false); v = __uint_as_float(r[0]) + __uint_as_float(r[1]); }
    return xhalf_sum(v);
}
__device__ __forceinline__ float wave_max(float v) {
    v = fmaxf(v, DPPF(v, 0xB1)); v = fmaxf(v, DPPF(v, 0x4E)); v = fmaxf(v, DPPF(v, 0x141)); v = fmaxf(v, DPPF(v, 0x140));
    { const auto r = __builtin_amdgcn_permlane16_swap(__float_as_uint(v), __float_as_uint(v), false, false); v = fmaxf(__uint_as_float(r[0]), __uint_as_float(r[1])); }
    return xhalf_max(v);
}
__device__ __forceinline__ float x16_sum(float v) { const auto r = __builtin_amdgcn_permlane16_swap(__float_as_uint(v), __float_as_uint(v), false, false); return __uint_as_float(r[0]) + __uint_as_float(r[1]); }
__device__ __forceinline__ float oct_sum(float v) { v += DPPF(v, 0xB1); v += DPPF(v, 0x4E); v += DPPF(v, 0x141); return v; }
__device__ __forceinline__ float row16_allsum(float v) { v += DPPF(v, 0xB1); v += DPPF(v, 0x4E); v += DPPF(v, 0x141); v += DPPF(v, 0x140); return v; }
__device__ __forceinline__ float xhalf_other(float x, bool hi) { const auto r = __builtin_amdgcn_permlane32_swap(__float_as_uint(x), __float_as_uint(x), false, false); return __uint_as_float(hi ? r[0] : r[1]); }

#define XB_TMO      128
#define XB_XCNT(j)  (256  + 64 * (j))
#define XB_XSUB(j)  (1280 + 64 * (j))
#define XB_XGEN(j)  (2304 + 64 * (j))
#define XB_TOP      3328
#define XB_TOPGEN   3392
#define XCD_BAR_WORDS 3456
#define XB_SPIN_CAP (1u << 18)
#define LAS __attribute__((address_space(3)))

__device__ __forceinline__ unsigned xb_ld(unsigned* p)              { return __hip_atomic_load(p, __ATOMIC_RELAXED, __HIP_MEMORY_SCOPE_AGENT); }
__device__ __forceinline__ unsigned xb_add(unsigned* p, unsigned v) { return __hip_atomic_fetch_add(p, v, __ATOMIC_RELAXED, __HIP_MEMORY_SCOPE_AGENT); }
__device__ __forceinline__ unsigned xb_xcc_id() { return (unsigned)__builtin_amdgcn_s_getreg((3 << 11) | 20) & 0xFu; }
#define XB_SPIN(cond, bar) do { unsigned _sp = 0; while (cond) { __builtin_amdgcn_s_sleep(1); \
    if ((++_sp & 255u) == 0u) { if (xb_ld(&(bar)[XB_TMO])) break; if (_sp > XB_SPIN_CAP) { atomicAdd(&(bar)[XB_TMO], 1u); break; } } } } while (0)

struct XcdBarrier {
    unsigned* bar; unsigned x;
    volatile LAS unsigned* st;
};

__device__ __forceinline__ XcdBarrier xcd_barrier_post(unsigned* bar, volatile LAS unsigned* st) {
    XcdBarrier b; b.bar = bar; b.x = xb_xcc_id(); b.st = st;
    if (threadIdx.x == 0) (void)xb_add(&bar[XB_XCNT(b.x)], 1u);
    return b;
}
__device__ __forceinline__ void xcd_barrier_complete(unsigned* bar, unsigned x, unsigned& nloc, unsigned& nx) {
    const unsigned G = gridDim.x * gridDim.y * gridDim.z;
    unsigned sum, cnt, mine, sp = 0u;
    for (;;) {
        sum = 0u; cnt = 0u; mine = 0u;
#pragma unroll
        for (unsigned j = 0; j < 16; ++j) { const unsigned c = xb_ld(&bar[XB_XCNT(j)]); sum += c; cnt += (c > 0u) ? 1u : 0u; mine = (j == x) ? c : mine; }
        if (sum == G) break;
        __builtin_amdgcn_s_sleep(1);
        if ((++sp & 255u) == 0u) { if (xb_ld(&bar[XB_TMO])) break; if (sp > XB_SPIN_CAP) { atomicAdd(&bar[XB_TMO], 1u); break; } }
    }
    nloc = mine > 0u ? mine : 1u; nx = cnt > 0u ? cnt : 1u;
}

__device__ __forceinline__ void xcd_barrier(const XcdBarrier& b) {
    asm volatile("s_waitcnt vmcnt(0)" ::: "memory");
    __syncthreads();
    if (threadIdx.x == 0) {
        unsigned* bar = b.bar;
        __builtin_amdgcn_s_waitcnt(0);
        unsigned nloc = b.st[0], nx = b.st[1];
        if (nloc == 0u) { xcd_barrier_complete(bar, b.x, nloc, nx); b.st[0] = nloc; b.st[1] = nx; }
        const unsigned old = xb_add(&bar[XB_XSUB(b.x)], 1u);
        const unsigned gen = old / nloc;
        if (old + 1u == (gen + 1u) * nloc) {
            __builtin_amdgcn_fence(__ATOMIC_RELEASE, "agent");
            asm volatile("s_waitcnt vmcnt(0)" ::: "memory");
            const unsigned og = xb_add(&bar[XB_TOP], 1u);
            const unsigned tg = og / nx;
            if (og + 1u == (tg + 1u) * nx) xb_add(&bar[XB_TOPGEN], 1u);
            else XB_SPIN(xb_ld(&bar[XB_TOPGEN]) == tg, bar);
            __builtin_amdgcn_fence(__ATOMIC_ACQUIRE, "agent");
            xb_add(&bar[XB_XGEN(b.x)], 1u);
            asm volatile("s_waitcnt vmcnt(0)" ::: "memory");
        } else {
            XB_SPIN(xb_ld(&bar[XB_XGEN(b.x)]) == gen, bar);
            __builtin_amdgcn_fence(__ATOMIC_ACQUIRE, "agent");
            asm volatile("s_waitcnt vmcnt(0)" ::: "memory");
        }
    }
    __syncthreads();
}

namespace pg8 {
#define PG8_LAS __attribute__((address_space(3)))
typedef unsigned short bf16_t;
typedef short bf16x8 __attribute__((ext_vector_type(8)));
typedef float f32x4 __attribute__((ext_vector_type(4)));
typedef unsigned u32x4 __attribute__((ext_vector_type(4)));
constexpr int BM = 256, BK = 64, HALF = 128, HTB = HALF * BK * 2  , STAGE_BYTES = 8 * HTB, NXCD = 8, WGM = 8;

__host__ __device__ __forceinline__ int lds_byte(int r, int c) { const int st = (r >> 4) * 2 + (c >> 5), rr = r & 15, cc = c & 31, ob = rr * 64 + cc * 2; return st * 1024 + (ob ^ (((ob >> 9) & 1) << 5)); }
__host__ __device__ __forceinline__ void stage_rc(int b, int& R, int& C) { const int st = b / 1024, sb = b % 1024, swz = sb ^ (((sb >> 9) & 1) << 5); R = (st >> 1) * 16 + swz / 64; C = (st & 1) * 32 + (swz % 64) / 2; }
__host__ __device__ __forceinline__ int perm32(int rho) { const int n = rho >> 4, i = rho & 15; return 8 * (i >> 2) + 4 * n + (i & 3); }

struct Unit { int pm, pn; };
struct Gemm { const bf16_t* A; const bf16_t* Bt; int M, N, K; };
struct StaticOrder {
    int nM, nN, nwg, G, c;
    __host__ __device__ void init(int M, int N, int G_, int c_) { nM = M / BM; nN = N / BM; nwg = nM * nN; G = G_; c = c_; }
    __host__ __device__ bool next(int i, Unit& u) const {
        const long L = (long)i * G + c; if (L >= nwg) return false;
        int wgid = (int)L; { const int q = nwg / NXCD, r = nwg % NXCD, xcd = wgid % NXCD, off = wgid / NXCD; wgid = (xcd < r ? xcd * (q + 1) : r * (q + 1) + (xcd - r) * q) + off; }
        const int nig = WGM * nN, gid = wgid / nig, fm = gid * WGM, gsz = (nM - fm) < WGM ? (nM - fm) : WGM;
        u.pm = fm + ((wgid % nig) % gsz); u.pn = (wgid % nig) / gsz; return true;
    }
    __device__ __forceinline__ void a_ready(const Unit&) const {}
    __device__ __forceinline__ void done(const Unit&) const {}
};
__device__ __forceinline__ unsigned cvt_pk_bf16(float lo, float hi) { unsigned r; asm volatile("v_cvt_pk_bf16_f32 %0, %1, %2" : "=v"(r) : "v"(lo), "v"(hi)); return r; }
template <class Epi, class Sched, bool STAMP = false>
__device__ __forceinline__ void gemm_phase(PG8_LAS unsigned char* lds, const Gemm g, const Sched& S, const Epi& E, unsigned long long* stamps) {
    const int tid = threadIdx.x, wid = __builtin_amdgcn_readfirstlane(tid >> 6), lane = tid & 63, wr = wid >> 2, wc = wid & 3, fr = lane & 15, fq = lane >> 4;
    const int K = g.K, nt = K / BK;
    int ts_lo = 0, ts_hi = 0, nts = 0; const unsigned long long rt_entry = STAMP ? (unsigned long long)wall_clock64() : 0ull;
#define PG8_STAMP() do { if (STAMP && wid == 0 && nts < 64) { const unsigned long long _c = (unsigned long long)clock64(); \
        ts_lo = (lane == nts) ? (int)(unsigned)_c : ts_lo; ts_hi = (lane == nts) ? (int)(unsigned)(_c >> 32) : ts_hi; ++nts; } } while (0)
    PG8_STAMP();
    unsigned voffA[2], voffB[2];
#pragma unroll
    for (int i = 0; i < 2; ++i) { int R, C; stage_rc(tid * 16 + i * 8192, R, C); const int Rb = Epi::PERM ? ((R & ~31) + perm32(R & 31)) : R;
        voffA[i] = (unsigned)(R * K + C) * 2u; voffB[i] = (unsigned)(Rb * K + C) * 2u; }
    const size_t kstep = (size_t)(BK * 2);
    const size_t hstep = (size_t)HALF * K * 2;
    const size_t tstep = 2 * hstep;
    const unsigned ldsw = (unsigned)wid * 1024u;
    const int aoff = lds_byte(wr * 64 + fr, fq * 8), boff = lds_byte(wc * 32 + fr, fq * 8);
#define PG8_SA(b, h) (((b) * 2 + (h)) * HTB)
#define PG8_SB(b, h) ((4 + (b) * 2 + (h)) * HTB)
#define PG8_STAGE(bufoff, gbase, voff) do { _Pragma("unroll") for (int _i = 0; _i < 2; ++_i) \
        __builtin_amdgcn_global_load_lds((const unsigned*)((const char*)(gbase) + (voff)[_i]), (PG8_LAS unsigned*)(lds + (bufoff) + ldsw + _i * 8192), 16, 0, 0); } while (0)
#define PG8_LDA(dst, b, h) do { _Pragma("unroll") for (int m = 0; m < 4; ++m) _Pragma("unroll") for (int k = 0; k < 2; ++k) dst[m][k] = *(const PG8_LAS bf16x8*)(lds + PG8_SA(b, h) + aoff + m * 2048 + k * 1024); } while (0)
#define PG8_LDB(dst, b, h) do { _Pragma("unroll") for (int n = 0; n < 2; ++n) _Pragma("unroll") for (int k = 0; k < 2; ++k) dst[n][k] = *(const PG8_LAS bf16x8*)(lds + PG8_SB(b, h) + boff + n * 2048 + k * 1024); } while (0)
#define PG8_MMA(ai, bj, At, Bt) do { __builtin_amdgcn_s_setprio(1); _Pragma("unroll") for (int m = 0; m < 4; ++m) _Pragma("unroll") for (int n = 0; n < 2; ++n) _Pragma("unroll") for (int k = 0; k < 2; ++k) \
        acc[ai][bj][m][n] = __builtin_amdgcn_mfma_f32_16x16x32_bf16(Bt[n][k], At[m][k], acc[ai][bj][m][n], 0, 0, 0); __builtin_amdgcn_s_setprio(0); } while (0)
#define PG8_WAIT_V(n) asm volatile("s_waitcnt vmcnt(" #n ")" ::: "memory")
#define PG8_WAIT_L(n) asm volatile("s_waitcnt lgkmcnt(" #n ")" ::: "memory")
#define PG8_BAR __builtin_amdgcn_s_barrier()
#define PG8_SCHED __builtin_amdgcn_sched_barrier(0)
    Unit cur, nxt; int ui = 0;
    if (!S.next(0, cur)) return;
    f32x4 acc[2][2][4][2];
#pragma unroll
    for (int a = 0; a < 2; ++a)
#pragma unroll
        for (int b = 0; b < 2; ++b)
#pragma unroll
            for (int m = 0; m < 4; ++m)
#pragma unroll
                for (int n = 0; n < 2; ++n) acc[a][b][m][n] = (f32x4){0.f, 0.f, 0.f, 0.f};
    bf16x8 At[4][2], B0[2][2], B1[2][2];
    const char* cA = (const char*)g.A + (size_t)cur.pm * tstep; const char* cB = (const char*)g.Bt + (size_t)cur.pn * tstep;
    S.a_ready(cur);
    PG8_STAGE(PG8_SB(0, 0), cB, voffB); PG8_STAGE(PG8_SA(0, 0), cA, voffA); PG8_STAGE(PG8_SB(0, 1), cB + hstep, voffB); PG8_STAGE(PG8_SA(0, 1), cA + hstep, voffA);
    if (wr == 1) PG8_BAR;
    PG8_WAIT_V(4); PG8_BAR;
    PG8_STAGE(PG8_SB(1, 0), cB + kstep, voffB); PG8_STAGE(PG8_SA(1, 0), cA + kstep, voffA); PG8_STAGE(PG8_SB(1, 1), cB + hstep + kstep, voffB);
    PG8_WAIT_V(6); PG8_BAR;
    PG8_STAMP();
    for (;;) {
        const bool has_next = S.next(ui + 1, nxt);
        const char* nA = has_next ? (const char*)g.A + (size_t)nxt.pm * tstep : cA; const char* nB = has_next ? (const char*)g.Bt + (size_t)nxt.pn * tstep : cB;
        for (int t = 0; t < nt; t += 2) {
            const bool last = (t == nt - 2);
            const char* a1 = cA + (size_t)(t + 1) * kstep;
            const char* a2 = last ? nA : cA + (size_t)(t + 2) * kstep; const char* b2 = last ? nB : cB + (size_t)(t + 2) * kstep;
            const char* a3 = a2 + kstep; const char* b3 = b2 + kstep;
            if (last && has_next) S.a_ready(nxt);
            PG8_LDB(B0, 0, 0); PG8_SCHED; PG8_LDA(At, 0, 0); PG8_STAGE(PG8_SA(1, 1), a1 + hstep, voffA);
            PG8_WAIT_L(8); PG8_BAR; PG8_WAIT_L(0); PG8_MMA(0, 0, At, B0); PG8_BAR; PG8_SCHED;
            PG8_LDB(B1, 0, 1); PG8_STAGE(PG8_SB(0, 0), b2, voffB);
            PG8_BAR; PG8_WAIT_L(0); PG8_MMA(0, 1, At, B1); PG8_BAR;
            PG8_LDA(At, 0, 1); PG8_STAGE(PG8_SA(0, 0), a2, voffA);
            PG8_BAR; PG8_WAIT_L(0); PG8_MMA(1, 0, At, B0); PG8_BAR; PG8_SCHED;
            PG8_STAGE(PG8_SB(0, 1), b2 + hstep, voffB);
            PG8_WAIT_V(6); PG8_BAR; PG8_MMA(1, 1, At, B1); PG8_BAR;
            PG8_LDB(B0, 1, 0); PG8_SCHED; PG8_LDA(At, 1, 0); PG8_STAGE(PG8_SA(0, 1), a2 + hstep, voffA);
            PG8_WAIT_L(8); PG8_BAR; PG8_WAIT_L(0); PG8_MMA(0, 0, At, B0); PG8_BAR; PG8_SCHED;
            PG8_LDB(B1, 1, 1); PG8_STAGE(PG8_SB(1, 0), b3, voffB);
            PG8_BAR; PG8_WAIT_L(0); PG8_MMA(0, 1, At, B1); PG8_BAR;
            PG8_LDA(At, 1, 1); PG8_STAGE(PG8_SA(1, 0), a3, voffA);
            PG8_BAR; PG8_WAIT_L(0); PG8_MMA(1, 0, At, B0); PG8_BAR; PG8_SCHED;
            PG8_STAGE(PG8_SB(1, 1), b3 + hstep, voffB);
            PG8_WAIT_V(6); PG8_BAR; PG8_MMA(1, 1, At, B1); PG8_BAR;
        }
        PG8_STAMP();
        if constexpr (!Epi::AFTER_DRAIN) { E(acc, cur, wr, wc, fr, fq); S.done(cur); }
        PG8_STAMP();
        if (!has_next) break;
#pragma unroll
        for (int a = 0; a < 2; ++a)
#pragma unroll
            for (int b = 0; b < 2; ++b)
#pragma unroll
                for (int m = 0; m < 4; ++m)
#pragma unroll
                    for (int n = 0; n < 2; ++n) acc[a][b][m][n] = (f32x4){0.f, 0.f, 0.f, 0.f};
        cur = nxt; cA = nA; cB = nB; ++ui;
    }
    PG8_WAIT_V(0);
    if (wr == 0) PG8_BAR;
    PG8_BAR;
    if constexpr (Epi::AFTER_DRAIN) { E.fused(acc, cur, wr, wc, fr, fq, lds, wid, lane); S.done(cur); }
    PG8_STAMP();
    if (STAMP && wid == 0) { stamps[lane] = lane < nts ? (((unsigned long long)(unsigned)ts_hi << 32) | (unsigned)ts_lo) : 0ull;
        if (lane == 62) stamps[62] = rt_entry; if (lane == 63) stamps[63] = (unsigned long long)wall_clock64(); }
#undef PG8_STAMP
#undef PG8_SA
#undef PG8_SB
#undef PG8_STAGE
#undef PG8_LDA
#undef PG8_LDB
#undef PG8_MMA
#undef PG8_WAIT_V
#undef PG8_WAIT_L
#undef PG8_BAR
#undef PG8_SCHED
}
}

__device__ __forceinline__ int win_src_col(int n) {
    if (n < 4224) return n;
    if (n < 4272) return 7808 + (n - 4224);
    if (n < 4352) return -1;
    if (n < 7936) return 4224 + (n - 4352);
    return 7856 + (n - 7936);
}
template <int MODE>
__device__ __forceinline__ void transpose_tiles(const float* __restrict__ src, int K, int ldsrc, bf16* __restrict__ dst, int N, LAS float* tile, int bid, int nb) {
    const int tid = threadIdx.x;
    const int tk = K / 64, tn = N / 64;
    const int total = tk * tn;
    constexpr int TPT = 4;
    for (int it0 = bid; it0 < total; it0 += TPT * nb) {
#pragma unroll
        for (int u = 0; u < TPT; ++u) {
            const int it = it0 + u * nb;
            if (it < total) {
                const int k0 = (it % tk) * 64, n0 = (it / tk) * 64;
                const int nl = tid & 63, kg = tid >> 6;
                const int n = n0 + nl; const int c = MODE == 0 ? win_src_col(n) : n;
#pragma unroll
                for (int kk = 0; kk < 8; ++kk) { const int k = kg * 8 + kk; tile[u * 64 * 65 + k * 65 + nl] = c >= 0 ? src[(size_t)(k0 + k) * ldsrc + c] : 0.f; }
            }
        }
        __syncthreads();
#pragma unroll
        for (int u = 0; u < TPT; ++u) {
            const int it = it0 + u * nb;
            if (it < total) {
                const int k0 = (it % tk) * 64, n0 = (it / tk) * 64;
                const int nn = tid >> 3, kc = tid & 7;
                float v[8];
#pragma unroll
                for (int i = 0; i < 8; ++i) v[i] = tile[u * 64 * 65 + (kc * 8 + i) * 65 + nn];
                u32x4 w; w.x = pk2bf(v[0], v[1]); w.y = pk2bf(v[2], v[3]); w.z = pk2bf(v[4], v[5]); w.w = pk2bf(v[6], v[7]);
                *(u32x4*)(dst + (size_t)(n0 + nn) * K + k0 + kc * 8) = w;
            }
        }
        __syncthreads();
    }
}

template <bool SAMPLE>
__device__ __forceinline__ void compress_item(const Args& a, int b, int n0, int cnt, LAS float* pooled  ) {
    const int col = threadIdx.x, kv = col >> 8, g = (col >> 6) & 3, e = col & 63;
    const int* pt = (const int*)a.in[7];
    LAS float* pwl = pooled + 32 * 512;
#pragma unroll
    for (int i = 0; i < 8; ++i) { const int idx = i * 512 + col; pwl[idx] = a.in[(idx >> 11) ? 21 : 20][idx & 2047]; }
    __syncthreads();
    const LAS float* pw = pwl + kv * 2048 + e;
    float prevP0 = 0.f;
    const int last = n0 + cnt;
#define CMP_LD(cc, x) { const int c_ = (cc); const float* rp; \
        if (SAMPLE) { const int r0 = 16 * c_; rp = a.in[2] + ((size_t)pt[b * NPAGES + (r0 >> 7)] * PAGE + (r0 & 127)) * 512 + col; } \
        else rp = a.out + O_PCMP + ((size_t)b * SEQ + 16 * c_) * 512 + col; \
        _Pragma("unroll") for (int s = 0; s < 16; ++s) x[s] = rp[(size_t)s * 512]; }
#define CMP_PROC(cc, x) { const int c_ = (cc); float P0 = 0.f, P1 = 0.f; \
        _Pragma("unroll") for (int s = 0; s < 16; ++s) { P0 += x[s] * pw[s * 64]; P1 += x[s] * pw[(16 + s) * 64]; } \
        if (c_ > n0) pooled[(c_ - 1 - n0) * 512 + col] = prevP0 + P1; \
        prevP0 = P0; }
    float xa[16], xb[16], xc[16];
    CMP_LD(n0, xa)
    CMP_LD(n0 + 1 < last ? n0 + 1 : last, xb)
    for (int c = n0; c <= last; c += 3) {
        CMP_LD(c + 2 < last ? c + 2 : last, xc)
        CMP_PROC(c, xa)
        CMP_LD(c + 3 < last ? c + 3 : last, xa)
        if (c + 1 <= last) CMP_PROC(c + 1, xb)
        CMP_LD(c + 4 < last ? c + 4 : last, xb)
        if (c + 2 <= last) CMP_PROC(c + 2, xc)
    }
#undef CMP_LD
#undef CMP_PROC
    __syncthreads();
    const float* wc = a.in[kv ? 23 : 22];
    float wcol[64];
#pragma unroll
    for (int d = 0; d < 64; ++d) wcol[d] = wc[d * 64 + e];
    float* dstb = (float*)(a.ws + (SAMPLE ? (kv ? WS_VCS : WS_KCS) : (kv ? WS_VCP : WS_KCP))) + (size_t)b * (SAMPLE ? NCB_S : NCB_P) * 256;
    for (int blk = 0; blk < cnt; ++blk) {
        const LAS float* pp = pooled + blk * 512 + (col & ~63);
        float acc = 0.f;
#pragma unroll
        for (int d = 0; d < 64; d += 4) { const f32x4 p4 = *(const LAS f32x4*)(pp + d); acc += p4.x * wcol[d] + p4.y * wcol[d + 1] + p4.z * wcol[d + 2] + p4.w * wcol[d + 3]; }
        if (SAMPLE) dstb[((size_t)(n0 + blk) * 4 + g) * 64 + e] = acc;
        else ((bf16*)(a.ws + (kv ? WS_VCP : WS_KCP)))[((size_t)(b * 4 + g) * 128 + (n0 + blk)) * 64 + e] = f2bf(acc);
    }
    __syncthreads();
}


__device__ __forceinline__ void compress_sample_item(const Args& a, int b, int n0, int cnt, LAS float* pooled  ) {
    int tid_ = threadIdx.x; asm volatile("" : "+v"(tid_));
    const int tid = tid_, cg = tid >> 7, c4 = (tid & 127) * 4, kv = c4 >> 8, e4 = c4 & 63;
    const int* pt = (const int*)a.in[7];
    LAS float* pwl = pooled + 32 * 512;
#pragma unroll
    for (int i = 0; i < 8; ++i) { const int idx = i * 512 + tid; pwl[idx] = a.in[(idx >> 11) ? 21 : 20][idx & 2047]; }
    const int last = n0 + cnt;
    int pgk[9];
#pragma unroll
    for (int k = 0; k < 9; ++k) { const int c_ = n0 + cg + 4 * k; pgk[k] = pt[b * NPAGES + ((c_ <= last ? c_ : last) >> 3)]; }
    __syncthreads();
    const LAS float* pw = pwl + kv * 2048 + e4;
    f32x4 xa[8], xb[8], p1k[9], P0, P1;
#define CS_LDH(k, h, X) { if ((k) < 9) { const int c_ = n0 + cg + 4 * (k); if (c_ <= last) { const float* rp = a.in[2] + ((size_t)pgk[(k) < 9 ? (k) : 8] * PAGE + ((16 * c_) & 127) + 8 * (h)) * 512 + c4; \
        _Pragma("unroll") for (int s = 0; s < 8; ++s) X[s] = *(const f32x4*)(rp + (size_t)s * 512); } } }
#define CS_PROCH(k, h, X) { const int c_ = n0 + cg + 4 * (k); if ((h) == 0) { P0 = (f32x4){0.f, 0.f, 0.f, 0.f}; P1 = P0; } \
        if (c_ <= last) { _Pragma("unroll") for (int s = 0; s < 8; ++s) { const f32x4 w0 = *(const LAS f32x4*)(pw + (8 * (h) + s) * 64), w1 = *(const LAS f32x4*)(pw + (16 + 8 * (h) + s) * 64); P0 += X[s] * w0; P1 += X[s] * w1; } } \
        if ((h) == 1) { if (c_ < last) *(LAS f32x4*)(pooled + (c_ - n0) * 512 + c4) = P0; p1k[k] = P1; } }
#define CS_STEP(k) CS_LDH(k, 1, xb) CS_PROCH(k, 0, xa) CS_LDH((k) + 1, 0, xa) CS_PROCH(k, 1, xb)
    CS_LDH(0, 0, xa)
    CS_STEP(0) CS_STEP(1) CS_STEP(2) CS_STEP(3) CS_STEP(4) CS_STEP(5) CS_STEP(6) CS_STEP(7) CS_STEP(8)
#undef CS_STEP
#undef CS_LDH
#undef CS_PROCH
    __syncthreads();
#pragma unroll
    for (int k = 0; k < 9; ++k) { const int c_ = n0 + cg + 4 * k; if (c_ > n0 && c_ <= last) { LAS f32x4* d = (LAS f32x4*)(pooled + (c_ - 1 - n0) * 512 + c4); *d = *d + p1k[k]; } }
    __syncthreads();
    {
        const int col = tid, kv2 = col >> 8, g = (col >> 6) & 3, e = col & 63;
        const float* wc = a.in[kv2 ? 23 : 22];
        float wcol[64];
#pragma unroll
        for (int d = 0; d < 64; ++d) wcol[d] = wc[d * 64 + e];
        float* dstb = (float*)(a.ws + (kv2 ? WS_VCS : WS_KCS)) + (size_t)b * NCB_S * 256;
        for (int blk = 0; blk < cnt; ++blk) {
            const LAS float* pp = pooled + blk * 512 + (col & ~63);
            float acc = 0.f;
#pragma unroll
            for (int d = 0; d < 64; d += 4) { const f32x4 p4 = *(const LAS f32x4*)(pp + d); acc += p4.x * wcol[d] + p4.y * wcol[d + 1] + p4.z * wcol[d + 2] + p4.w * wcol[d + 3]; }
            dstb[((size_t)(n0 + blk) * 4 + g) * 64 + e] = acc;
        }
    }
    __syncthreads();
}

__device__ __forceinline__ void p0_prologue(const Args& a, LAS unsigned char* lds) {
    const int tid = threadIdx.x, lane = tid & 63, wave = tid >> 6, bid = blockIdx.x, nb = gridDim.x;
    LAS float* tile = (LAS float*)lds;
    transpose_tiles<0>(a.in[9], D, IN_COLS, (bf16*)(a.ws + WS_WIN_T), NIN, tile, bid, nb);
    transpose_tiles<1>(a.in[24], 1024, D, (bf16*)(a.ws + WS_WPAB_T), D, tile, bid, nb);
    transpose_tiles<1>(a.in[25], 1024, D, (bf16*)(a.ws + WS_WPAB_T) + (size_t)D * 1024, D, tile, bid, nb);
    transpose_tiles<1>(a.in[26], D, D, (bf16*)(a.ws + WS_WO_T), D, tile, bid, nb);
    {
        bf16* XN = (bf16*)(a.ws + WS_XN);
        const float* gin = a.in[8];
        for (int r = bid * 8 + wave; r < MPAD; r += nb * 8) {
            bf16* dst = XN + (size_t)r * D;
            if (r >= MT) {
#pragma unroll
                for (int i = 0; i < 4; ++i) *(u32x4*)(dst + i * 512 + lane * 8) = (u32x4){0u, 0u, 0u, 0u};
            } else {
                const float* x = r < MP ? a.in[0] + (size_t)r * D : a.in[1] + (size_t)(r - MP) * D;
                f32x4 v[8]; float ss = 0.f;
#pragma unroll
                for (int i = 0; i < 8; ++i) { v[i] = *(const f32x4*)(x + i * 256 + lane * 4); ss += v[i].x * v[i].x + v[i].y * v[i].y + v[i].z * v[i].z + v[i].w * v[i].w; }
                ss = wave_sum(ss);
                const float rs = rsqrtf(ss * (1.0f / D) + RMS_EPS);
#pragma unroll
                for (int i = 0; i < 8; ++i) { const f32x4 gg = *(const f32x4*)(gin + i * 256 + lane * 4);
                    u32x2 w; w.x = pk2bf(v[i].x * rs * gg.x, v[i].y * rs * gg.y); w.y = pk2bf(v[i].z * rs * gg.z, v[i].w * rs * gg.w);
                    *(u32x2*)(dst + i * 256 + lane * 4) = w; }
            }
        }
    }
    {
        const f32x4* src = (const f32x4*)a.in[4]; f32x4* dst = (f32x4*)(a.out + O_SWIN);
        const size_t n4 = (size_t)DB * 508 * 128;
        const size_t step = (size_t)nb * 512;
        for (size_t i0 = (size_t)bid * 512 + tid; i0 < n4; i0 += 8 * step) {
            f32x4 v[8];
#pragma unroll
            for (int u = 0; u < 8; ++u) { const size_t i = i0 + u * step; if (i < n4) { const size_t bb = i / (508 * 128), rem = i % (508 * 128); v[u] = src[bb * 512 * 128 + 4 * 128 + rem]; } }
#pragma unroll
            for (int u = 0; u < 8; ++u) { const size_t i = i0 + u * step; if (i < n4) { const size_t bb = i / (508 * 128), rem = i % (508 * 128); dst[bb * 512 * 128 + rem] = v[u]; } }
        }
        bf16* OAB = (bf16*)(a.ws + WS_OAB);
        for (int i = bid * 512 + tid; i < 2 * 128 * 128; i += nb * 512) { const int hf = i / (128 * 128), rem = i % (128 * 128); *(u32x4*)(OAB + ((size_t)hf * MPAD + MT) * 1024 + (size_t)rem * 8) = (u32x4){0u, 0u, 0u, 0u}; }
    }
    {
        bf16* WUPT = (bf16*)(a.ws + WS_WUPT);
        for (int i = bid * 512 + tid; i < 2 * 1024 * 8; i += nb * 512) { const int mat = i >> 13, c = (i >> 3) & 1023, m8 = (i & 7) * 8; const float* src = a.in[mat ? 14 : 12] + (size_t)m8 * AW + c;
            u32x4 w; w.x = pk2bf(src[0], src[AW]); w.y = pk2bf(src[2 * AW], src[3 * AW]); w.z = pk2bf(src[4 * AW], src[5 * AW]); w.w = pk2bf(src[6 * AW], src[7 * AW]);
            *(u32x4*)(WUPT + ((size_t)mat * 1024 + c) * 64 + m8) = w; }
    }
    __syncthreads();
    for (int it = bid; it < DB * 16; it += nb) { const int b = it >> 4, n0 = (it & 15) * 32; const int cnt = (NCMP_S - n0) < 32 ? (NCMP_S - n0) : 32; compress_sample_item(a, b, n0, cnt, tile); }
}

struct EpiG1 {
    static constexpr bool PERM = true, AFTER_DRAIN = false;
    bf16* UA; bf16* QG; float* KVW; bf16* GATES; float* out; bf16* KVSB; bf16* KVWB;
    __device__ __forceinline__ void operator()(const pg8::f32x4 (&acc)[2][2][4][2], const pg8::Unit& u, int wr, int wc, int fr, int fq) const {
        const int pn = u.pn;
        const int row0 = u.pm * 256 + wr * 64 + fr, cl0 = wc * 32 + fq * 8;
        if (pn <= 16) {
#pragma unroll
            for (int ai = 0; ai < 2; ++ai)
#pragma unroll
                for (int m = 0; m < 4; ++m) {
                    const int row = row0 + ai * 128 + m * 16;
                    const bool lastp = row < MP && (row & (SEQ - 1)) == SEQ - 1, lasts = row >= MP && row < MT && ((row - MP) & 3) == 3;
#pragma unroll
                    for (int bj = 0; bj < 2; ++bj) {
                        const int col = pn * 256 + bj * 128 + cl0;
                        const pg8::f32x4 v0 = acc[ai][bj][m][0], v1 = acc[ai][bj][m][1];
                        u32x4 w; w.x = pg8::cvt_pk_bf16(v0[0], v0[1]); w.y = pg8::cvt_pk_bf16(v0[2], v0[3]); w.z = pg8::cvt_pk_bf16(v1[0], v1[1]); w.w = pg8::cvt_pk_bf16(v1[2], v1[3]);
                        *(u32x4*)(UA + (size_t)row * UA_LD + col) = w;
                        if ((lastp || lasts) && col < ACOLS) {
                            float* d = lastp ? out + O_PSHIFT + (size_t)(row >> 11) * ACOLS + col : out + O_SSHIFT + (size_t)((row - MP) >> 2) * ACOLS + col;
                            *(pg8::f32x4*)d = v0; *(pg8::f32x4*)(d + 4) = v1;
                        }
                    }
                }
        } else if (pn <= 24) {
#pragma unroll
            for (int ai = 0; ai < 2; ++ai)
#pragma unroll
                for (int m = 0; m < 4; ++m) {
                    const int row = row0 + ai * 128 + m * 16;
#pragma unroll
                    for (int bj = 0; bj < 2; ++bj) {
                        const int col = (pn - 17) * 256 + bj * 128 + cl0;
                        const pg8::f32x4 v0 = acc[ai][bj][m][0], v1 = acc[ai][bj][m][1];
                        u32x4 w; w.x = pg8::cvt_pk_bf16(v0[0], v0[1]); w.y = pg8::cvt_pk_bf16(v0[2], v0[3]); w.z = pg8::cvt_pk_bf16(v1[0], v1[1]); w.w = pg8::cvt_pk_bf16(v1[2], v1[3]);
                        *(u32x4*)(QG + (size_t)row * 2048 + col) = w;
                    }
                }
        } else if (pn <= 30) {
#pragma unroll
            for (int ai = 0; ai < 2; ++ai)
#pragma unroll
                for (int m = 0; m < 4; ++m) {
                    const int row = row0 + ai * 128 + m * 16;
#pragma unroll
                    for (int bj = 0; bj < 2; ++bj) {
                        const int cb = (pn - 25) * 256 + bj * 128 + cl0, which = cb >> 9, cc = cb & 511;
                        const pg8::f32x4 v0 = acc[ai][bj][m][0], v1 = acc[ai][bj][m][1];
                        float* d = nullptr;
                        if (which >= 1) {
                            const float ks = cc < 256 ? 0.125f * 1.4426950408889634f : 1.0f;
                            u32x4 w; w.x = pg8::cvt_pk_bf16(v0[0] * ks, v0[1] * ks); w.y = pg8::cvt_pk_bf16(v0[2] * ks, v0[3] * ks); w.z = pg8::cvt_pk_bf16(v1[0] * ks, v1[1] * ks); w.w = pg8::cvt_pk_bf16(v1[2] * ks, v1[3] * ks);
                            *(u32x4*)((which == 1 ? KVSB : KVWB) + (size_t)row * 512 + cc) = w; }
                        if (which == 2) {
                            if (row < MP) { const int t = row & (SEQ - 1); if (t >= SEQ - 512) d = out + O_PWIN + ((size_t)(row >> 11) * 512 + (t - (SEQ - 512))) * 512 + cc; }
                            else if (row < MT) { const int si = row - MP; d = out + O_SWIN + ((size_t)(si >> 2) * 512 + 508 + (si & 3)) * 512 + cc; }
                        } else {
                            if (row < MP) d = out + (which ? O_PSEL : O_PCMP) + (size_t)row * 512 + cc;
                            else if (row < MT) d = out + (which ? O_SSEL : O_SCMP) + (size_t)(row - MP) * 512 + cc;
                        }
                        if (d) { *(pg8::f32x4*)d = v0; *(pg8::f32x4*)(d + 4) = v1; }
                    }
                }
        } else {
#pragma unroll
            for (int ai = 0; ai < 2; ++ai)
#pragma unroll
                for (int m = 0; m < 4; ++m) {
                    const int row = row0 + ai * 128 + m * 16;
#pragma unroll
                    for (int bj = 0; bj < 2; ++bj) {
                        const int col = (pn - 31) * 256 + bj * 128 + cl0;
                        const pg8::f32x4 v0 = acc[ai][bj][m][0], v1 = acc[ai][bj][m][1];
                        u32x4 w; w.x = pg8::cvt_pk_bf16(v0[0], v0[1]); w.y = pg8::cvt_pk_bf16(v0[2], v0[3]); w.z = pg8::cvt_pk_bf16(v1[0], v1[1]); w.w = pg8::cvt_pk_bf16(v1[2], v1[3]);
                        *(u32x4*)(GATES + (size_t)row * 4096 + col) = w;
                    }
                }
        }
    }
};

typedef short bf16x8v __attribute__((ext_vector_type(8)));
typedef float f32x16 __attribute__((ext_vector_type(16)));

__device__ __forceinline__ void unpack8(const u32x4 w, float (&f)[8]) {
    f[0] = __uint_as_float(w.x << 16); f[1] = __uint_as_float(w.x & 0xffff0000u); f[2] = __uint_as_float(w.y << 16); f[3] = __uint_as_float(w.y & 0xffff0000u);
    f[4] = __uint_as_float(w.z << 16); f[5] = __uint_as_float(w.z & 0xffff0000u); f[6] = __uint_as_float(w.w << 16); f[7] = __uint_as_float(w.w & 0xffff0000u);
}
constexpr int CK_PT = 0;
constexpr int CK_VT = 4096;
constexpr int CK_KB = 6144;
constexpr int CK_AO = 10240;
constexpr int CK_WM = 11264;
constexpr int CK_GC = 11776;
constexpr int CK_BYTES = 12288;
typedef float f32x4v __attribute__((ext_vector_type(4)));
#define DPPO(x, ctrl, oldv) __int_as_float(__builtin_amdgcn_update_dpp(__float_as_int(oldv), __float_as_int(x), (ctrl), 0xf, 0xf, false))

__device__ __forceinline__ void chunk_core(float (&w)[16], float (&kk)[16], float (&bb)[16], float (&kx)[16], float (&rx)[16], const float (&vs)[16], unsigned char* __restrict__ rec  ,
                                           LAS unsigned char* wl  , int lane) {
    const int s = lane & 15, q = lane >> 4;
    u32x4 fat[2], fbt[2], fkt[2], frt[2];
    unsigned short hkb[16], hbb[16], hat[16];
    float gg[16], ig[16];
#pragma unroll
    for (int e = 0; e < 16; ++e) {
        float g = w[e];
        g *= DPPO(g, 0x111, 1.0f); g *= DPPO(g, 0x112, 1.0f); g *= DPPO(g, 0x114, 1.0f); g *= DPPO(g, 0x118, 1.0f);
        gg[e] = g;
    }
#pragma unroll
    for (int e = 0; e < 16; e += 4) {
        const float p01 = gg[e] * gg[e + 1], p23 = gg[e + 2] * gg[e + 3], inv = 1.0f / (p01 * p23), i01 = p23 * inv, i23 = p01 * inv;
        ig[e] = gg[e + 1] * i01; ig[e + 1] = gg[e] * i01; ig[e + 2] = gg[e + 3] * i23; ig[e + 3] = gg[e + 2] * i23;
    }
#pragma unroll
    for (int e = 0; e < 16; ++e) {
        const float g = gg[e];
        const float gp = DPPO(g, 0x111, 1.0f);
        const float g16 = __shfl(g, (lane & 48) | 15);
        const float at = kk[e] * gp, bt = bb[e] * ig[e], kt = kx[e] * ig[e], rt = rx[e] * g, rr = g16 * ig[e];
        hat[e] = f2bf(at); hkb[e] = f2bf(kx[e] * rr); hbb[e] = f2bf(bb[e] * rr);
        w[e] = at; kk[e] = bt; bb[e] = kt; kx[e] = rt;
        if (s == 15) { const int j = 32 * (e >> 3) + 8 * q + (e & 7); ((float*)(rec + CK_GC))[j] = g; }
    }
#pragma unroll
    for (int u = 0; u < 2; ++u) {
        fat[u] = (u32x4){pk2bf(w[8 * u], w[8 * u + 1]), pk2bf(w[8 * u + 2], w[8 * u + 3]), pk2bf(w[8 * u + 4], w[8 * u + 5]), pk2bf(w[8 * u + 6], w[8 * u + 7])};
        fbt[u] = (u32x4){pk2bf(kk[8 * u], kk[8 * u + 1]), pk2bf(kk[8 * u + 2], kk[8 * u + 3]), pk2bf(kk[8 * u + 4], kk[8 * u + 5]), pk2bf(kk[8 * u + 6], kk[8 * u + 7])};
        fkt[u] = (u32x4){pk2bf(bb[8 * u], bb[8 * u + 1]), pk2bf(bb[8 * u + 2], bb[8 * u + 3]), pk2bf(bb[8 * u + 4], bb[8 * u + 5]), pk2bf(bb[8 * u + 6], bb[8 * u + 7])};
        frt[u] = (u32x4){pk2bf(kx[8 * u], kx[8 * u + 1]), pk2bf(kx[8 * u + 2], kx[8 * u + 3]), pk2bf(kx[8 * u + 4], kx[8 * u + 5]), pk2bf(kx[8 * u + 6], kx[8 * u + 7])};
        *(u32x4*)(rec + CK_PT + s * 128 + (32 * u + 8 * q) * 2) = frt[u];
    }
    {
        bf16* KB = (bf16*)(rec + CK_KB);
#pragma unroll
        for (int e = 0; e < 16; ++e) { const int j = 32 * (e >> 3) + 8 * q + (e & 7); KB[j * 32 + s] = hkb[e]; KB[j * 32 + 16 + s] = hbb[e]; }
        bf16* VT = (bf16*)(rec + CK_VT);
#pragma unroll
        for (int e = 0; e < 16; ++e) VT[(32 * (e >> 3) + 8 * q + (e & 7)) * 16 + s] = f2bf(vs[e]);
    }
    typedef float f32x4c __attribute__((ext_vector_type(4)));
    f32x4c aba = {0.f, 0.f, 0.f, 0.f}, aka = aba, abr = aba, akr = aba;
#pragma unroll
    for (int u = 0; u < 2; ++u) {
        const bf16x8v Bt_ = __builtin_bit_cast(bf16x8v, fbt[u]), Kt_ = __builtin_bit_cast(bf16x8v, fkt[u]), At_ = __builtin_bit_cast(bf16x8v, fat[u]), Rt_ = __builtin_bit_cast(bf16x8v, frt[u]);
        aba = __builtin_amdgcn_mfma_f32_16x16x32_bf16(Bt_, At_, aba, 0, 0, 0); aka = __builtin_amdgcn_mfma_f32_16x16x32_bf16(Kt_, At_, aka, 0, 0, 0);
        abr = __builtin_amdgcn_mfma_f32_16x16x32_bf16(Bt_, Rt_, abr, 0, 0, 0); akr = __builtin_amdgcn_mfma_f32_16x16x32_bf16(Kt_, Rt_, akr, 0, 0, 0);
    }
    LAS float* Aba = (LAS float*)wl;
    LAS float* Aka = Aba + 256;
    LAS float* Tm = Aka + 256;
    LAS bf16* AtT = (LAS bf16*)(Tm + 256);
    {
        const int t = s;
        u32x2 wkr, wbr;
        float vkr[4], vbr[4];
#pragma unroll
        for (int e = 0; e < 4; ++e) { const int sr = 4 * q + e; Aba[sr * 16 + t] = sr < t ? aba[e] : 0.f; Aka[sr * 16 + t] = sr < t ? aka[e] : 0.f; vkr[e] = sr <= t ? akr[e] : 0.f; vbr[e] = sr <= t ? abr[e] : 0.f; }
        wkr = (u32x2){pk2bf(vkr[0], vkr[1]), pk2bf(vkr[2], vkr[3])}; wbr = (u32x2){pk2bf(vbr[0], vbr[1]), pk2bf(vbr[2], vbr[3])};
        *(u32x2*)(rec + CK_AO + t * 64 + (4 * q) * 2) = wkr; *(u32x2*)(rec + CK_AO + t * 64 + (16 + 4 * q) * 2) = wbr;
#pragma unroll
        for (int e = 0; e < 16; ++e) { const int j = 32 * (e >> 3) + 8 * q + (e & 7); AtT[j * 16 + s] = hat[e]; }
    }
    asm volatile("s_waitcnt lgkmcnt(0)" ::: "memory");
    float Tc[16];
#pragma unroll
    for (int t = 0; t < 16; ++t) {
        float c = s == t ? 1.0f : 0.f;
#pragma unroll
        for (int m = 0; m < t; ++m) c -= Tc[m] * Aba[m * 16 + t];
        Tc[t] = c;
    }
    if (q == 0) {
#pragma unroll
        for (int t = 0; t < 16; ++t) Tm[s * 16 + t] = Tc[t];
    }
    asm volatile("s_waitcnt lgkmcnt(0)" ::: "memory");
    {
        float wm[4] = {0.f, 0.f, 0.f, 0.f};
#pragma unroll
        for (int m = 0; m < 16; ++m) { const float am = Aka[s * 16 + m];
#pragma unroll
            for (int e = 0; e < 4; ++e) wm[e] += am * Tm[m * 16 + 4 * q + e]; }
        bf16* WM = (bf16*)(rec + CK_WM);
#pragma unroll
        for (int e = 0; e < 4; ++e) WM[(4 * q + e) * 16 + s] = f2bf(wm[e]);
    }
    {
        u32x4 ta = {0u, 0u, 0u, 0u};
        if (q < 2) { float tv[8];
#pragma unroll
            for (int e = 0; e < 8; ++e) tv[e] = Tm[(8 * q + e) * 16 + s];
            ta = (u32x4){pk2bf(tv[0], tv[1]), pk2bf(tv[2], tv[3]), pk2bf(tv[4], tv[5]), pk2bf(tv[6], tv[7])}; }
        bf16* PT = (bf16*)(rec + CK_PT);
#pragma unroll
        for (int nt = 0; nt < 4; ++nt) {
            u32x4 tb = {0u, 0u, 0u, 0u};
            if (q < 2) tb = *(const LAS u32x4*)(AtT + (16 * nt + s) * 16 + 8 * q);
            f32x4c pa = {0.f, 0.f, 0.f, 0.f};
            pa = __builtin_amdgcn_mfma_f32_16x16x32_bf16(__builtin_bit_cast(bf16x8v, ta), __builtin_bit_cast(bf16x8v, tb), pa, 0, 0, 0);
#pragma unroll
            for (int e = 0; e < 4; ++e) PT[(16 + 4 * q + e) * 64 + 16 * nt + s] = f2bf(pa[e]);
        }
    }
}

__device__ __forceinline__ bool c_never(int tid) { int x = tid; asm volatile("" : "+v"(x)); return x < 0; }
constexpr int SQ_SSTR = 144, SQ_ASTR = 80;
__device__ __forceinline__ void chain_seq(const unsigned char* __restrict__ recsA, const unsigned char* __restrict__ recsB  , int nchunks,
                                          float* __restrict__ SoutA, float* __restrict__ SoutB, float* __restrict__ orawA, float* __restrict__ orawB  , LAS unsigned char* lds) {
    int tid_ = threadIdx.x; asm volatile("" : "+v"(tid_));
    const int tid = tid_, lane = tid & 63, w = tid >> 6, r = lane & 31, hh = lane >> 5;
    const int it = (w >> 1) & 1, jt = w & 1, cb = w >> 2;
    const unsigned char* recs = cb ? recsB : recsA; float* Sout = cb ? SoutB : SoutA; float* oraw = cb ? orawB : orawA;
    const bool act = true, xw = jt == 0;
    LAS unsigned char* Sb = lds + cb * (64 * SQ_SSTR + 2 * 64 * SQ_ASTR);
    LAS unsigned char* Av0 = Sb + 64 * SQ_SSTR;
    f32x16 S;
#pragma unroll
    for (int i = 0; i < 16; ++i) S[i] = 0.f;
    __syncthreads();
    bf16x8v pf[4], wmf, aof[2], kbf[2], vtf; float gc = 0.f; u32x4 vcp = {0u, 0u, 0u, 0u};
    bf16x8v n_pf[4], n_wmf, n_aof[2], n_kbf[2], n_vtf; float n_gc = 0.f; u32x4 n_vcp = {0u, 0u, 0u, 0u};
    const u32x4 z4 = {0u, 0u, 0u, 0u};
#define SQ_LOAD(rec, PF, WMF, AOF, KBF, VTF, GC, VCP) { \
        if (act) { _Pragma("unroll") for (int ks = 0; ks < 2; ++ks) KBF[ks] = *(const bf16x8v*)((rec) + CK_KB + (32 * jt + r) * 64 + (16 * ks + 8 * hh) * 2); \
            GC = ((const float*)((rec) + CK_GC))[32 * jt + r]; } \
        if (xw) { _Pragma("unroll") for (int ks = 0; ks < 4; ++ks) PF[ks] = *(const bf16x8v*)((rec) + CK_PT + r * 128 + (16 * ks + 8 * hh) * 2); \
            WMF = r >= 16 ? *(const bf16x8v*)((rec) + CK_WM + (r - 16) * 32 + 8 * hh * 2) : __builtin_bit_cast(bf16x8v, z4); \
            _Pragma("unroll") for (int ks = 0; ks < 2; ++ks) AOF[ks] = r < 16 ? *(const bf16x8v*)((rec) + CK_AO + r * 64 + (16 * ks + 8 * hh) * 2) : __builtin_bit_cast(bf16x8v, z4); \
            VTF = *(const bf16x8v*)((rec) + CK_VT + (32 * it + r) * 32 + 8 * hh * 2); } \
        if ((tid & 255) < 128) VCP = *(const u32x4*)((rec) + CK_VT + ((tid & 255) >> 1) * 32 + (tid & 1) * 16); }
    SQ_LOAD(recs, n_pf, n_wmf, n_aof, n_kbf, n_vtf, n_gc, n_vcp)
    unsigned tacc = 0u, tprev = 0u;
    for (int c = 0; c < nchunks; ++c) {
#pragma unroll
        for (int ks = 0; ks < 4; ++ks) pf[ks] = n_pf[ks];
        wmf = n_wmf; aof[0] = n_aof[0]; aof[1] = n_aof[1]; kbf[0] = n_kbf[0]; kbf[1] = n_kbf[1]; vtf = n_vtf; gc = n_gc; vcp = n_vcp;
        { const unsigned char* recn = recs + (size_t)(c + 1 < nchunks ? c + 1 : c) * CK_BYTES; SQ_LOAD(recn, n_pf, n_wmf, n_aof, n_kbf, n_vtf, n_gc, n_vcp) }
        tacc ^= tprev;
        if ((tid & 255) < 96) tprev = *(const unsigned*)(recs + (size_t)(c + 3 < nchunks ? c + 3 : nchunks - 1) * CK_BYTES + (tid & 255) * 128);
        LAS unsigned char* Av = Av0 + (c & 1) * 64 * SQ_ASTR;
        if (act) {
#pragma unroll
            for (int i = 0; i < 16; ++i) { const int row = 32 * it + (i & 3) + 8 * (i >> 2) + 4 * hh; *(LAS bf16*)(Sb + row * SQ_SSTR + (32 * jt + r) * 2) = f2bf(S[i]); }
        }
        if ((tid & 255) < 128) *(LAS u32x4*)(Av + ((tid & 255) >> 1) * SQ_ASTR + (tid & 1) * 16) = vcp;
        __syncthreads();
        f32x16 X;
        if (xw) {
#pragma unroll
            for (int i = 0; i < 16; ++i) X[i] = 0.f;
#pragma unroll
            for (int ks = 0; ks < 4; ++ks) { const bf16x8v sf = *(const LAS bf16x8v*)(Sb + (32 * it + r) * SQ_SSTR + (16 * ks + 8 * hh) * 2); X = __builtin_amdgcn_mfma_f32_32x32x16_bf16(sf, pf[ks], X, 0, 0, 0); }
            X = __builtin_amdgcn_mfma_f32_32x32x16_bf16(vtf, wmf, X, 0, 0, 0);
            if (r >= 16) {
#pragma unroll
                for (int i = 0; i < 16; ++i) { const int row = 32 * it + (i & 3) + 8 * (i >> 2) + 4 * hh; *(LAS bf16*)(Av + row * SQ_ASTR + (16 + (r - 16)) * 2) = f2bf(-X[i]); }
            }
        }
        __syncthreads();
        if (act) {
            bf16x8v af[2];
#pragma unroll
            for (int ks = 0; ks < 2; ++ks) af[ks] = *(const LAS bf16x8v*)(Av + (32 * it + r) * SQ_ASTR + (16 * ks + 8 * hh) * 2);
            if (xw) {
#pragma unroll
                for (int ks = 0; ks < 2; ++ks) X = __builtin_amdgcn_mfma_f32_32x32x16_bf16(af[ks], aof[ks], X, 0, 0, 0);
                if (r < 16) { float* od = oraw + (size_t)(c * 16 + r) * 1024 + 32 * it + 4 * hh;
#pragma unroll
                    for (int g4 = 0; g4 < 4; ++g4) *(f32x4*)(od + 8 * g4) = (f32x4){X[4 * g4], X[4 * g4 + 1], X[4 * g4 + 2], X[4 * g4 + 3]}; }
            }
#pragma unroll
            for (int i = 0; i < 16; ++i) S[i] *= gc;
#pragma unroll
            for (int ks = 0; ks < 2; ++ks) S = __builtin_amdgcn_mfma_f32_32x32x16_bf16(af[ks], kbf[ks], S, 0, 0, 0);
        }
    }
    __syncthreads();
    if (act) {
#pragma unroll
        for (int i = 0; i < 16; ++i) { const int row = 32 * it + (i & 3) + 8 * (i >> 2) + 4 * hh; Sout[row * 64 + 32 * jt + r] = S[i]; }
    }
    if ((tacc ^ tprev) == 0x9e3779b9u && c_never(tid)) Sout[0] = 0.f;
    __syncthreads();
#undef SQ_LOAD
}


__device__ __forceinline__ void shifted8(const Args& a, const bf16* UA, int row, int col, float (&us)[8]) {
    float u[8], p[8];
    unpack8(*(const u32x4*)(UA + (size_t)row * UA_LD + col), u);
    bool first;
    if (row < MP) first = (row & (SEQ - 1)) == 0; else first = ((row - MP) & 3) == 0;
    if (!first) unpack8(*(const u32x4*)(UA + (size_t)(row - 1) * UA_LD + col), p);
    else if (row < MP) {
#pragma unroll
        for (int i = 0; i < 8; ++i) p[i] = 0.f;
    } else { const float* sp = a.in[6] + (size_t)((row - MP) >> 2) * ACOLS + col; const f32x4 s0 = *(const f32x4*)sp, s1 = *(const f32x4*)(sp + 4);
        p[0] = s0.x; p[1] = s0.y; p[2] = s0.z; p[3] = s0.w; p[4] = s1.x; p[5] = s1.y; p[6] = s1.z; p[7] = s1.w; }
    const float* mu = a.in[10] + col; const f32x4 m0 = *(const f32x4*)mu, m1 = *(const f32x4*)(mu + 4);
    const float mm[8] = {m0.x, m0.y, m0.z, m0.w, m1.x, m1.y, m1.z, m1.w};
#pragma unroll
    for (int i = 0; i < 8; ++i) us[i] = u[i] + mm[i] * (p[i] - u[i]);
}

__device__ __forceinline__ void mix8(const Args& a, const u32x4 ur, const u32x4 pr, int row, int col, const LAS float* mu  , float (&us)[8]) {
    float u[8], p[8];
    unpack8(ur, u);
    bool first;
    if (row < MP) first = (row & (SEQ - 1)) == 0; else first = ((row - MP) & 3) == 0;
    if (!first) unpack8(pr, p);
    else if (row < MP) {
#pragma unroll
        for (int i = 0; i < 8; ++i) p[i] = 0.f;
    } else { const float* sp = a.in[6] + (size_t)((row - MP) >> 2) * ACOLS + col; const f32x4 s0 = *(const f32x4*)sp, s1 = *(const f32x4*)(sp + 4);
        p[0] = s0.x; p[1] = s0.y; p[2] = s0.z; p[3] = s0.w; p[4] = s1.x; p[5] = s1.y; p[6] = s1.z; p[7] = s1.w; }
    const f32x4 m0 = *(const LAS f32x4*)mu, m1 = *(const LAS f32x4*)(mu + 4);
    const float mm[8] = {m0.x, m0.y, m0.z, m0.w, m1.x, m1.y, m1.z, m1.w};
#pragma unroll
    for (int i = 0; i < 8; ++i) us[i] = u[i] + mm[i] * (p[i] - u[i]);
}

constexpr size_t WS_AM = WS_KVW;
__device__ __forceinline__ void p2_pre(const Args& a) {
    const bf16* UA = (const bf16*)(a.ws + WS_UA); bf16* AM = (bf16*)(a.ws + WS_AM);
    for (int idx = blockIdx.x * 512 + threadIdx.x; idx < MT * 8; idx += gridDim.x * 512) {
        const int row = idx >> 3, cg = idx & 7, mat = cg >> 2;
        float us[8], us2[8];
        shifted8(a, UA, row, 4096 + cg * 16, us); shifted8(a, UA, row, 4096 + cg * 16 + 8, us2);
        float oa[8], ob[8];
#pragma unroll
        for (int i0 = 0; i0 < 8; i0 += 4) {
            float dA[4], dB[4];
#pragma unroll
            for (int i = 0; i < 4; ++i) { dA[i] = 1.0f + __expf(2.0f * fminf(us[i0 + i], 9.0f)); dB[i] = 1.0f + __expf(2.0f * fminf(us2[i0 + i], 9.0f)); }
            const float a01 = dA[0] * dA[1], a23 = dA[2] * dA[3], ia = 1.0f / (a01 * a23), b01 = dB[0] * dB[1], b23 = dB[2] * dB[3], ib = 1.0f / (b01 * b23);
            const float rA[4] = {dA[1] * a23 * ia, dA[0] * a23 * ia, dA[3] * a01 * ia, dA[2] * a01 * ia}, rB[4] = {dB[1] * b23 * ib, dB[0] * b23 * ib, dB[3] * b01 * ib, dB[2] * b01 * ib};
#pragma unroll
            for (int i = 0; i < 4; ++i) { oa[i0 + i] = mat ? us[i0 + i] : 1.0f - 2.0f * rA[i]; ob[i0 + i] = mat ? us2[i0 + i] : 1.0f - 2.0f * rB[i]; }
        }
        u32x4* d = (u32x4*)(AM + (size_t)row * 128 + cg * 16);
        d[0] = (u32x4){pk2bf(oa[0], oa[1]), pk2bf(oa[2], oa[3]), pk2bf(oa[4], oa[5]), pk2bf(oa[6], oa[7])};
        d[1] = (u32x4){pk2bf(ob[0], ob[1]), pk2bf(ob[2], ob[3]), pk2bf(ob[4], ob[5]), pk2bf(ob[6], ob[7])};
    }
}

constexpr int PREP_W2 = 0, PREP_WSTR = 144, PREP_WL = 2 * 2 * 64 * PREP_WSTR  , PREP_CT = PREP_WL + 8 * 5120;
__device__ __forceinline__ void prep_consts(const Args& a, int hp, LAS unsigned char* lds) {
    LAS float* CT = (LAS float*)(lds + PREP_CT);
    for (int idx = threadIdx.x; idx < 2 * 9 * 64; idx += 512) {
        const int grp = idx / 576, k = (idx % 576) >> 6, c = idx & 63, h = hp + 8 * grp;
        const float* src = k < 4 ? a.in[10] + k * 1024 : (k == 4 ? a.in[11] : k == 5 ? a.in[13] : k == 6 ? a.in[15] : k == 7 ? a.in[16] : a.in[17]);
        CT[idx] = src[h * 64 + c];
    }
    for (int idx = threadIdx.x; idx < 2 * 2 * 64 * 8; idx += 512) {
        const int grp = idx >> 10, mat = (idx >> 9) & 1, col = (idx >> 3) & 63, pc = idx & 7;
        const u32x4 wv = *(const u32x4*)((const bf16*)(a.ws + WS_WUPT) + ((size_t)mat * 1024 + (hp + 8 * grp) * 64 + col) * 64 + pc * 8);
        *(LAS u32x4*)(lds + PREP_W2 + ((grp * 2 + mat) * 64 + col) * PREP_WSTR + pc * 16) = wv;
    }
}
__device__ __forceinline__ void prep_pair(const Args& a, int tt, int hp, LAS unsigned char* lds) {
    int tid_ = threadIdx.x; asm volatile("" : "+v"(tid_));
    const int tid = tid_, lane = tid & 63, wave = tid >> 6;
    const bf16* UA = (const bf16*)(a.ws + WS_UA);
    LAS unsigned char* WL = lds + PREP_WL;
    const int R0 = tt * 64;
    const bool prompt_tile = tt < MP / 64;
    const int grp = wave >> 2, cw = wave & 3, s = lane & 15, q = lane >> 4, h = hp + 8 * grp;
    const int row = R0 + 16 * cw + s;
    bf16x8v amf[2][2];
#pragma unroll
    for (int mat = 0; mat < 2; ++mat)
#pragma unroll
        for (int ks = 0; ks < 2; ++ks) amf[mat][ks] = *(const bf16x8v*)((const bf16*)(a.ws + WS_AM) + (size_t)row * 128 + mat * 64 + ks * 32 + 8 * q);
    asm volatile("" ::: "memory");
    u32x4 raw[2][8];
    {
        const bool first = row < MP ? (row & (SEQ - 1)) == 0 : ((row - MP) & 3) == 0;
#pragma unroll
        for (int u = 0; u < 2; ++u) { const int ch = h * 64 + 32 * u + 8 * q; const bf16* pu = UA + (size_t)row * UA_LD + ch; const bf16* pp = first ? pu : pu - UA_LD;
#pragma unroll
            for (int v4 = 0; v4 < 4; ++v4) { raw[u][v4] = *(const u32x4*)(pu + v4 * 1024); raw[u][4 + v4] = *(const u32x4*)(pp + v4 * 1024); } }
    }
    asm volatile("" ::: "memory");
    typedef float f32x4c_ __attribute__((ext_vector_type(4)));
    f32x4c_ lo[2][4];
    {
        const int wrow = 8 * (s >> 2) + (s & 3);
#pragma unroll
        for (int mat = 0; mat < 2; ++mat)
#pragma unroll
            for (int n = 0; n < 4; ++n) {
                f32x4c_ c = {0.f, 0.f, 0.f, 0.f};
#pragma unroll
                for (int ks = 0; ks < 2; ++ks) {
                    const bf16x8v wf = *(const LAS bf16x8v*)(lds + PREP_W2 + ((grp * 2 + mat) * 64 + 32 * (n >> 1) + 4 * (n & 1) + wrow) * PREP_WSTR + (ks * 32 + 8 * q) * 2);
                    c = __builtin_amdgcn_mfma_f32_16x16x32_bf16(wf, amf[mat][ks], c, 0, 0, 0);
                }
                lo[mat][n] = c;
            }
    }
    {
        float dec[16], kk[16], bb[16], kp[16], rs[16], vs[16];
        float ssq = 0.f, bon = 0.f;
#pragma unroll
        for (int u = 0; u < 2; ++u) {
            const int j0 = 32 * u + 8 * q, ch = h * 64 + j0;
            float r8[8], k8[8], v8[8], g8[8];
            const LAS float* CT = (const LAS float*)(lds + PREP_CT) + grp * 576 + j0;
            mix8(a, raw[u][0], raw[u][4], row, ch, CT, r8); mix8(a, raw[u][1], raw[u][5], row, 1024 + ch, CT + 64, k8); mix8(a, raw[u][2], raw[u][6], row, 2048 + ch, CT + 128, v8); mix8(a, raw[u][3], raw[u][7], row, 3072 + ch, CT + 192, g8);
            float sg[8];
            float c_w0[8], c_a0[8], c_kk[8], c_ka[8], c_rk[8];
            { const f32x4 x0 = *(const LAS f32x4*)(CT + 256), x1 = *(const LAS f32x4*)(CT + 260), y0 = *(const LAS f32x4*)(CT + 320), y1 = *(const LAS f32x4*)(CT + 324),
                          z0 = *(const LAS f32x4*)(CT + 384), z1 = *(const LAS f32x4*)(CT + 388), u0 = *(const LAS f32x4*)(CT + 448), u1 = *(const LAS f32x4*)(CT + 452),
                          t0 = *(const LAS f32x4*)(CT + 512), t1 = *(const LAS f32x4*)(CT + 516);
#pragma unroll
              for (int i = 0; i < 4; ++i) { c_w0[i] = x0[i]; c_w0[4 + i] = x1[i]; c_a0[i] = y0[i]; c_a0[4 + i] = y1[i]; c_kk[i] = z0[i]; c_kk[4 + i] = z1[i]; c_ka[i] = u0[i]; c_ka[4 + i] = u1[i]; c_rk[i] = t0[i]; c_rk[4 + i] = t1[i]; } }
#pragma unroll
            for (int i = 0; i < 8; ++i) {
                const int e = 8 * u + i;
                const float lw = lo[0][2 * u + (i >> 2)][i & 3] + c_w0[i];
                const float la = lo[1][2 * u + (i >> 2)][i & 3] + c_a0[i];
                const float d1 = 1.0f + __expf(-fmaxf(lw, -25.0f)), d2 = 1.0f + __expf(-fmaxf(la, -25.0f)), d3 = 1.0f + __expf(-fmaxf(g8[i], -25.0f));
                const float d12 = d1 * d2, inv = 1.0f / (d12 * d3);
                const float s_lw = d2 * d3 * inv, av = d1 * d3 * inv, s_g = d12 * inv;
                dec[e] = __expf(-0.60653066f * s_lw);
                const float kkv = k8[i] * c_kk[i];
                kk[e] = kkv; ssq += kkv * kkv;
                kp[e] = k8[i] * (1.0f + (av - 1.0f) * c_ka[i]);
                bb[e] = av; rs[e] = r8[i]; vs[e] = v8[i];
                bon += r8[i] * kp[e] * c_rk[i];
                sg[i] = g8[i] * s_g;
            }
            if (row < MT) {
                u32x4 wv; wv.x = pk2bf(v8[0], v8[1]); wv.y = pk2bf(v8[2], v8[3]); wv.z = pk2bf(v8[4], v8[5]); wv.w = pk2bf(v8[6], v8[7]);
                *(u32x4*)((bf16*)(a.ws + WS_VB) + (size_t)row * 1024 + ch) = wv;
                u32x4 ws_; ws_.x = pk2bf(sg[0], sg[1]); ws_.y = pk2bf(sg[2], sg[3]); ws_.z = pk2bf(sg[4], sg[5]); ws_.w = pk2bf(sg[6], sg[7]);
                *(u32x4*)((bf16*)(a.ws + WS_SG) + (size_t)row * 1024 + ch) = ws_;
            }
        }
        ssq = xhalf_sum(x16_sum(ssq)); bon = xhalf_sum(x16_sum(bon));
        const float rn = rsqrtf(fmaxf(ssq, 1e-24f));
#pragma unroll
        for (int e = 0; e < 16; ++e) { kk[e] *= rn; bb[e] *= kk[e]; }
        if (row < MT && q == 0) ((float*)(a.ws + WS_BONUS))[(size_t)row * 16 + h] = bon;
        if (prompt_tile) {
            const int b = R0 / SEQ, c = (R0 % SEQ) / 16 + cw;
            chunk_core(dec, kk, bb, kp, rs, vs, a.ws + WS_CHUNK + ((size_t)(b * 16 + h) * 128 + c) * CK_BYTES, WL + wave * 5120, lane);
        } else if (row < MT) {
            float* P = (float*)(a.ws + WS_PREP) + ((size_t)row * 16 + h) * 384;
#pragma unroll
            for (int u = 0; u < 2; ++u) { const int j0 = 32 * u + 8 * q;
#pragma unroll
                for (int x4 = 0; x4 < 2; ++x4) { const int e = 8 * u + 4 * x4, j = j0 + 4 * x4;
                    *(f32x4*)(P + j) = (f32x4){dec[e], dec[e + 1], dec[e + 2], dec[e + 3]}; *(f32x4*)(P + 64 + j) = (f32x4){kk[e], kk[e + 1], kk[e + 2], kk[e + 3]};
                    *(f32x4*)(P + 128 + j) = (f32x4){bb[e], bb[e + 1], bb[e + 2], bb[e + 3]}; *(f32x4*)(P + 192 + j) = (f32x4){kp[e], kp[e + 1], kp[e + 2], kp[e + 3]};
                    *(f32x4*)(P + 256 + j) = (f32x4){rs[e], rs[e + 1], rs[e + 2], rs[e + 3]}; *(f32x4*)(P + 320 + j) = (f32x4){vs[e], vs[e + 1], vs[e + 2], vs[e + 3]}; } }
        }
    }
}

__device__ __forceinline__ float row16_sum(float x) {
    x += DPPF(x, 0xB1);
    x += DPPF(x, 0x4E);
    x += DPPF(x, 0x141);
    x += DPPF(x, 0x140);
    return x;
}
constexpr int SC_NB = 16, SC_STEP = 384;
typedef float f32x2l __attribute__((ext_vector_type(2)));
__device__ __forceinline__ f32x2l splat2(float x) { return (f32x2l){x, x}; }
__device__ __forceinline__ f32x2l pair_row16_sum(f32x2l v) {
    float x = v.x, y = v.y;
#define SC_STAGE(ctrl) x += DPPF(x, ctrl); asm volatile("" : "+v"(x)); y += DPPF(y, ctrl); asm volatile("" : "+v"(y));
    SC_STAGE(0xB1) SC_STAGE(0x4E) SC_STAGE(0x141) SC_STAGE(0x140)
#undef SC_STAGE
    return (f32x2l){x, y};
}
__device__ __forceinline__ float SFMA(float a, float b, float c) { float d; asm("v_fma_f32 %0, %1, %2, %3" : "=v"(d) : "v"(a), "v"(b), "v"(c)); return d; }
__device__ __forceinline__ float SMUL(float a, float b) { float d; asm("v_mul_f32 %0, %1, %2" : "=v"(d) : "v"(a), "v"(b)); return d; }
__device__ __forceinline__ float row16_sum1(float x) {
    x += DPPF(x, 0xB1); x += DPPF(x, 0x4E); x += DPPF(x, 0x141); x += DPPF(x, 0x140);
    return x;
}
template <int NS>
__device__ __forceinline__ void scan_half(const float* __restrict__ prep  , int T, const float* __restrict__ S0, float* __restrict__ Sout,
                                          float* __restrict__ oraw  , int hf, LAS float* lds) {
    int tid_ = threadIdx.x; asm volatile("" : "+v"(tid_));
    const int tid = tid_, lane = tid & 63, w = tid >> 6, rg = lane >> 4, jl = lane & 15;
    const int rl = w * 4 + rg, row = hf * 32 + rl;
    constexpr size_t SS = (size_t)16 * 384;
    LAS float* stg = lds;
    f32x2l P0 = {0.f, 0.f}, P1 = {0.f, 0.f};
    if (S0) { const f32x4 s4 = *(const f32x4*)(S0 + row * 64 + 4 * jl); P0 = (f32x2l){s4.x, s4.y}; P1 = (f32x2l){s4.z, s4.w}; }
    constexpr int NF4 = NS * 96, NLD = (NF4 + 511) / 512;
    f32x4 sr[2][NLD];
    auto gload = [&](f32x4 (&r)[NLD], int t0) {
#pragma unroll
        for (int i = 0; i < NLD; ++i) { const int e = tid + 512 * i; if (e < NF4) { const int st = e / 96, o4 = e % 96; int t = t0 + st; t = t < T ? t : T - 1; r[i] = *(const f32x4*)(prep + (size_t)t * SS + o4 * 4); } }
    };
    auto lstore = [&](const f32x4 (&r)[NLD], int buf) {
#pragma unroll
        for (int i = 0; i < NLD; ++i) { const int e = tid + 512 * i; if (e < NF4) { const int st = e / 96, o4 = e % 96; *(LAS f32x4*)(stg + (buf * SC_NB + st) * SC_STEP + o4 * 4) = r[i]; } }
    };
    auto batch = [&](int t0, int buf) {
        const LAS float* sb = stg + buf * SC_NB * SC_STEP + 4 * jl;
        const LAS float* vb = stg + buf * SC_NB * SC_STEP + 320 + row;
        f32x4 nw = *(const LAS f32x4*)(sb), nkk = *(const LAS f32x4*)(sb + 64), nb = *(const LAS f32x4*)(sb + 128), nk = *(const LAS f32x4*)(sb + 192), nr = *(const LAS f32x4*)(sb + 256);
        float nv = vb[0], okeep = 0.f;
#pragma unroll
        for (int s = 0; s < NS; ++s) {
            const f32x4 cw = nw, ckk = nkk, cb = nb, ck = nk, cr = nr; const float cv = nv;
            if (s + 1 < NS) {
                nw = *(const LAS f32x4*)(sb + (s + 1) * SC_STEP); nkk = *(const LAS f32x4*)(sb + (s + 1) * SC_STEP + 64); nb = *(const LAS f32x4*)(sb + (s + 1) * SC_STEP + 128);
                nk = *(const LAS f32x4*)(sb + (s + 1) * SC_STEP + 192); nr = *(const LAS f32x4*)(sb + (s + 1) * SC_STEP + 256); nv = vb[(s + 1) * SC_STEP];
            }
            float sa = SMUL(P0.x, ckk.x); sa = SFMA(P0.y, ckk.y, sa); sa = SFMA(P1.x, ckk.z, sa); sa = SFMA(P1.y, ckk.w, sa);
            sa = row16_sum1(sa);
            const float nsa = -sa;
            P0.x = SFMA(P0.x, cw.x, SFMA(nsa, cb.x, SMUL(cv, ck.x))); P0.y = SFMA(P0.y, cw.y, SFMA(nsa, cb.y, SMUL(cv, ck.y)));
            P1.x = SFMA(P1.x, cw.z, SFMA(nsa, cb.z, SMUL(cv, ck.z))); P1.y = SFMA(P1.y, cw.w, SFMA(nsa, cb.w, SMUL(cv, ck.w)));
            float o = SMUL(P0.x, cr.x); o = SFMA(P0.y, cr.y, o); o = SFMA(P1.x, cr.z, o); o = SFMA(P1.y, cr.w, o);
            o = row16_sum1(o);
            okeep = jl == s ? o : okeep;
        }
        if (jl < NS) oraw[(size_t)(t0 + jl) * 1024 + hf * 32 + rl] = okeep;
    };
    __syncthreads();
    gload(sr[0], 0); gload(sr[1], NS);
    lstore(sr[0], 0);
    __syncthreads();
    for (int t0 = 0; t0 < T; t0 += 2 * NS) {
        gload(sr[0], t0 + 2 * NS);
        batch(t0, 0);
        lstore(sr[1], 1);
        __syncthreads();
        if (t0 + NS < T) {
            gload(sr[1], t0 + 3 * NS);
            batch(t0 + NS, 1);
            lstore(sr[0], 0);
            __syncthreads();
        }
    }
    *(f32x4*)(Sout + row * 64 + 4 * jl) = (f32x4){P0.x, P0.y, P1.x, P1.y};
    __syncthreads();
}

#define PMUL(a, b) ((a) * (b))
#define DSTEP(x, ctrl) x += DPPF(x, ctrl); asm("" : "+v"(x));
template <int NS>
__device__ __forceinline__ void scan_full(const float* __restrict__ prep  , int T, float* __restrict__ Sout, float* __restrict__ oraw  , LAS float* lds) {
    int tid_ = threadIdx.x; asm volatile("" : "+v"(tid_));
    const int tid = tid_, lane = tid & 63, w = tid >> 6, rg = lane >> 4, jl = lane & 15;
    const int ra = w * 8 + rg * 2;
    constexpr size_t SS = (size_t)16 * 384;
    LAS float* stg = lds;
    float a0 = 0.f, a1 = 0.f, a2 = 0.f, a3 = 0.f, b0 = 0.f, b1 = 0.f, b2 = 0.f, b3 = 0.f;
    constexpr int NF4 = NS * 96, NLD = (NF4 + 511) / 512;
    f32x4 sr[2][NLD];
    auto gload = [&](f32x4 (&r)[NLD], int t0) {
#pragma unroll
        for (int i = 0; i < NLD; ++i) { const int e = tid + 512 * i; if (e < NF4) { const int st = e / 96, o4 = e % 96; int t = t0 + st; t = t < T ? t : T - 1; r[i] = *(const f32x4*)(prep + (size_t)t * SS + o4 * 4); } }
    };
    auto lstore = [&](const f32x4 (&r)[NLD], int buf) {
#pragma unroll
        for (int i = 0; i < NLD; ++i) { const int e = tid + 512 * i; if (e < NF4) { const int st = e / 96, o4 = e % 96; *(LAS f32x4*)(stg + (buf * SC_NB + st) * SC_STEP + o4 * 4) = r[i]; } }
    };
    auto batch = [&](int t0, int buf) {
        const LAS float* sb = stg + buf * SC_NB * SC_STEP + 4 * jl;
        const LAS float* vb = stg + buf * SC_NB * SC_STEP + 320 + ra;
        f32x4 nw = *(const LAS f32x4*)(sb), nkk = *(const LAS f32x4*)(sb + 64), nb = *(const LAS f32x4*)(sb + 128), nk = *(const LAS f32x4*)(sb + 192), nr = *(const LAS f32x4*)(sb + 256);
        f32x2l nv = *(const LAS f32x2l*)(vb), okeep = {0.f, 0.f};
#pragma unroll
        for (int s = 0; s < NS; ++s) {
            const f32x4 cw = nw, ckk = nkk, cb = nb, ck = nk, cr = nr; const f32x2l cv = nv;
            if (s + 1 < NS) {
                nw = *(const LAS f32x4*)(sb + (s + 1) * SC_STEP); nkk = *(const LAS f32x4*)(sb + (s + 1) * SC_STEP + 64); nb = *(const LAS f32x4*)(sb + (s + 1) * SC_STEP + 128);
                nk = *(const LAS f32x4*)(sb + (s + 1) * SC_STEP + 192); nr = *(const LAS f32x4*)(sb + (s + 1) * SC_STEP + 256); nv = *(const LAS f32x2l*)(vb + (s + 1) * SC_STEP);
            }
            float sa = PMUL(a0, ckk.x), sbv = PMUL(b0, ckk.x);
            sa = fmaf(a1, ckk.y, sa); sbv = fmaf(b1, ckk.y, sbv); sa = fmaf(a2, ckk.z, sa); sbv = fmaf(b2, ckk.z, sbv); sa = fmaf(a3, ckk.w, sa); sbv = fmaf(b3, ckk.w, sbv);
            DSTEP(sa, 0xB1) DSTEP(sbv, 0xB1) DSTEP(sa, 0x4E) DSTEP(sbv, 0x4E) DSTEP(sa, 0x141) DSTEP(sbv, 0x141) DSTEP(sa, 0x140) DSTEP(sbv, 0x140)
            const float na = -sa, nbv = -sbv;
            a0 = fmaf(a0, cw.x, fmaf(na, cb.x, PMUL(cv.x, ck.x))); b0 = fmaf(b0, cw.x, fmaf(nbv, cb.x, PMUL(cv.y, ck.x)));
            a1 = fmaf(a1, cw.y, fmaf(na, cb.y, PMUL(cv.x, ck.y))); b1 = fmaf(b1, cw.y, fmaf(nbv, cb.y, PMUL(cv.y, ck.y)));
            a2 = fmaf(a2, cw.z, fmaf(na, cb.z, PMUL(cv.x, ck.z))); b2 = fmaf(b2, cw.z, fmaf(nbv, cb.z, PMUL(cv.y, ck.z)));
            a3 = fmaf(a3, cw.w, fmaf(na, cb.w, PMUL(cv.x, ck.w))); b3 = fmaf(b3, cw.w, fmaf(nbv, cb.w, PMUL(cv.y, ck.w)));
            float oa = PMUL(a0, cr.x), obv = PMUL(b0, cr.x);
            oa = fmaf(a1, cr.y, oa); obv = fmaf(b1, cr.y, obv); oa = fmaf(a2, cr.z, oa); obv = fmaf(b2, cr.z, obv); oa = fmaf(a3, cr.w, oa); obv = fmaf(b3, cr.w, obv);
            DSTEP(oa, 0xB1) DSTEP(obv, 0xB1) DSTEP(oa, 0x4E) DSTEP(obv, 0x4E) DSTEP(oa, 0x141) DSTEP(obv, 0x141) DSTEP(oa, 0x140) DSTEP(obv, 0x140)
            okeep.x = jl == s ? oa : okeep.x; okeep.y = jl == s ? obv : okeep.y;
        }
        if (jl < NS) *(f32x2l*)(oraw + (size_t)(t0 + jl) * 1024 + ra) = okeep;
    };
    __syncthreads();
    gload(sr[0], 0); gload(sr[1], NS);
    lstore(sr[0], 0);
    __syncthreads();
    for (int t0 = 0; t0 < T; t0 += 2 * NS) {
        gload(sr[0], t0 + 2 * NS);
        batch(t0, 0);
        lstore(sr[1], 1);
        __syncthreads();
        if (t0 + NS < T) {
            gload(sr[1], t0 + 3 * NS);
            batch(t0 + NS, 1);
            lstore(sr[0], 0);
            __syncthreads();
        }
    }
    *(f32x4*)(Sout + ra * 64 + 4 * jl) = (f32x4){a0, a1, a2, a3}; *(f32x4*)(Sout + (ra + 1) * 64 + 4 * jl) = (f32x4){b0, b1, b2, b3};
    __syncthreads();
}


constexpr float NEGF = -1e30f;
template <bool SAMPLE>
__device__ __forceinline__ void attn_item(const Args& a, int b, int g, int tile, LAS unsigned char* lds) {
    constexpr int TT = SAMPLE ? 4 : 8, NR = TT * 4, RPW = NR / 8, NCMP = SAMPLE ? NCMP_S : NCMP_P, NCB = SAMPLE ? NCB_S : NCB_P, NCT = NCB / 64, PBLD = NCB, NSEL = SAMPLE ? NSEL_S : NSEL_P;
    const int tid = threadIdx.x, lane = tid & 63, w = __builtin_amdgcn_readfirstlane(tid >> 6);
    LAS float* qs = (LAS float*)lds;
    LAS float* Ks = qs + 64 * 64;
    LAS float* Vs = Ks + 64 * 65;
    LAS float* Pb = Vs + 64 * 64;
    LAS float* imp = Pb + 8192;
    LAS int* selb = (LAS int*)(imp + 16 * 132);
    LAS int* ulist = selb + 16 * 132;
    const bf16* QG = (const bf16*)(a.ws + WS_QG);
    const bf16* UA = (const bf16*)(a.ws + WS_UA);
    const int* pt = (const int*)a.in[7];
    const int hr = w & 3, h = g * 4 + hr;
    const float slope = exp2f(-0.5f * (float)(h + 1));
    const int t0 = SAMPLE ? PAST : tile * TT;
    const int grow0 = SAMPLE ? MP + b * 4 : b * SEQ + t0;
    __syncthreads();
    {
        const int r = tid >> 3, c8 = tid & 7;
        if (r < NR) { float q[8]; unpack8(*(const u32x4*)(QG + (size_t)(grow0 + (r >> 2)) * 2048 + (g * 4 + (r & 3)) * 64 + c8 * 8), q);
#pragma unroll
            for (int i = 0; i < 8; ++i) qs[r * 64 + c8 * 8 + i] = q[i] * ATTN_SCALE; }
    }
    float accf[RPW], m_[RPW], l_[RPW], o_[RPW];
    f32x4 fk0, fk1, fv0, fv1;
    auto fetch = [&](auto kptr  , auto vptr, bool wantK, bool wantV) {
        const int key = tid >> 3, c8 = tid & 7;
        if (wantK) { const float* p = kptr(key); fk0 = (f32x4){0.f, 0.f, 0.f, 0.f}; fk1 = fk0; if (p) { fk0 = *(const f32x4*)(p + c8 * 8); fk1 = *(const f32x4*)(p + c8 * 8 + 4); } }
        if (wantV) { const float* p = vptr(key); fv0 = (f32x4){0.f, 0.f, 0.f, 0.f}; fv1 = fv0; if (p) { fv0 = *(const f32x4*)(p + c8 * 8); fv1 = *(const f32x4*)(p + c8 * 8 + 4); } }
    };
    auto commit = [&](bool wantK, bool wantV) {
        const int key = tid >> 3, c8 = tid & 7;
        if (wantK) { LAS float* d = Ks + key * 65 + c8 * 8; d[0] = fk0.x; d[1] = fk0.y; d[2] = fk0.z; d[3] = fk0.w; d[4] = fk1.x; d[5] = fk1.y; d[6] = fk1.z; d[7] = fk1.w; }
        if (wantV) { *(LAS f32x4*)(Vs + key * 64 + c8 * 8) = fv0; *(LAS f32x4*)(Vs + key * 64 + c8 * 8 + 4) = fv1; }
    };
    auto score_rows = [&](float (&sc)[RPW]) {
        float kreg[64];
#pragma unroll
        for (int d = 0; d < 64; ++d) kreg[d] = Ks[lane * 65 + d];
#pragma unroll
        for (int k = 0; k < RPW; ++k) { const LAS float* q = qs + (w + 8 * k) * 64; float s = 0.f;
#pragma unroll
            for (int d = 0; d < 64; d += 4) { const f32x4 q4 = *(const LAS f32x4*)(q + d); s += q4.x * kreg[d] + q4.y * kreg[d + 1] + q4.z * kreg[d + 2] + q4.w * kreg[d + 3]; }
            sc[k] = s; }
    };
    auto pv_rows = [&](const LAS float* pbase, int pld) {
#pragma unroll 4
        for (int key = 0; key < 64; key += 4) {
            const float v0 = Vs[(key + 0) * 64 + lane], v1 = Vs[(key + 1) * 64 + lane], v2 = Vs[(key + 2) * 64 + lane], v3 = Vs[(key + 3) * 64 + lane];
#pragma unroll
            for (int k = 0; k < RPW; ++k) { const f32x4 p4 = *(const LAS f32x4*)(pbase + (w + 8 * k) * pld + key); o_[k] += p4.x * v0 + p4.y * v1 + p4.z * v2 + p4.w * v3; }
        }
    };
#pragma unroll
    for (int k = 0; k < RPW; ++k) { accf[k] = 0.f; m_[k] = NEGF; l_[k] = 0.f; o_[k] = 0.f; }
    const float* KC = (const float*)(a.ws + (SAMPLE ? WS_KCS : WS_KCP)) + (size_t)b * NCB * 256 + g * 64;
    const float* VC = (const float*)(a.ws + (SAMPLE ? WS_VCS : WS_VCP)) + (size_t)b * NCB * 256 + g * 64;
    auto nullp = [&](int) -> const float* { return nullptr; };
    fetch([&](int key) -> const float* { const int n = key; return n < NCMP ? KC + (size_t)n * 256 : nullptr; }, nullp, true, false);
    for (int kt = 0; kt < NCT; ++kt) {
        __syncthreads();
        commit(true, false);
        __syncthreads();
        if (kt + 1 < NCT) fetch([&](int key) -> const float* { const int n = (kt + 1) * 64 + key; return n < NCMP ? KC + (size_t)n * 256 : nullptr; }, nullp, true, false);
        else fetch(nullp, [&](int key) -> const float* { const int n = key; return n < NCMP ? VC + (size_t)n * 256 : nullptr; }, false, true);
        float sc[RPW]; score_rows(sc);
        const int n = kt * 64 + lane;
#pragma unroll
        for (int k = 0; k < RPW; ++k) { const int t = t0 + (w >> 2) + 2 * k; const int dist = t - (16 * n + 31); const bool valid = n < NCMP && dist >= 0;
            const float s = valid ? sc[k] - slope * (float)dist : NEGF; Pb[(w + 8 * k) * PBLD + n] = s; m_[k] = fmaxf(m_[k], s); }
    }
#pragma unroll
    for (int k = 0; k < RPW; ++k) {
        const float m = wave_max(m_[k]); float ls = 0.f; LAS float* pr = Pb + (w + 8 * k) * PBLD;
        float pv[NCT];
#pragma unroll
        for (int i = 0; i < NCT; ++i) { const float s = pr[i * 64 + lane]; pv[i] = s > -1e29f ? __expf(s - m) : 0.f; ls += pv[i]; }
        ls = wave_sum(ls); const float inv = 1.0f / fmaxf(ls, 1e-30f);
#pragma unroll
        for (int i = 0; i < NCT; ++i) pr[i * 64 + lane] = pv[i] * inv;
    }
    for (int kt = 0; kt < NCT; ++kt) {
        __syncthreads();
        commit(false, true);
        __syncthreads();
        if (kt + 1 < NCT) fetch(nullp, [&](int key) -> const float* { const int n = (kt + 1) * 64 + key; return n < NCMP ? VC + (size_t)n * 256 : nullptr; }, false, true);
        pv_rows(Pb + kt * 64, PBLD);
    }
#pragma unroll
    for (int k = 0; k < RPW; ++k) { const int grow = grow0 + (w >> 2) + 2 * k; accf[k] = sigmoidf_(bf2f(UA[(size_t)grow * UA_LD + ACOLS + 0 * 16 + h])) * o_[k]; }
    for (int idx = tid; idx < TT * NSEL; idx += 512) {
        const int tok = idx / NSEL, j = idx % NSEL; float v = 0.f;
#pragma unroll
        for (int r4 = 0; r4 < 4; ++r4) { const LAS float* pr = Pb + (tok * 4 + r4) * PBLD;
#pragma unroll
            for (int mm = 0; mm < 3; ++mm) { const int n = 4 * j + mm; if (n < NCMP) v += pr[n]; }
            { const int n = 4 * j + 3; if (n < NCMP) v += 0.5f * pr[n]; }
            { const int n = 4 * j - 1; if (n >= 0 && n < NCMP) v += 0.5f * pr[n]; } }
        imp[tok * 132 + j] = v;
    }
    __syncthreads();
    for (int idx = tid; idx < TT * NSEL; idx += 512) {
        const int tok = idx / NSEL, j = idx % NSEL, tb = (t0 + tok) >> 6;
        auto score = [&](int jj) -> float { const int back = tb - jj; const bool forced = jj == 0 || (back >= 0 && back < 2); return forced ? 1e4f : (back >= 0 ? imp[tok * 132 + jj] : -1.0f); };
        const float sj = score(j); int rank = 0;
        for (int jj = 0; jj < NSEL; ++jj) { const float s2 = score(jj); rank += (s2 > sj || (s2 == sj && jj < j)) ? 1 : 0; }
        selb[tok * 132 + j] = (rank < 16 && sj >= 0.f) ? 1 : 0;
    }
    __syncthreads();
    if (tid == 0) { int nu = 0; for (int j = 0; j < NSEL; ++j) { int any = 0; for (int tok = 0; tok < TT; ++tok) any |= selb[tok * 132 + j]; if (any) ulist[nu++] = j; } ulist[132] = nu; }
    __syncthreads();
    const int nu = ulist[132];
    LAS float* ps = Pb;
    auto online = [&](int k, float s, bool valid) {
        const float sv = valid ? s : NEGF; const float mn = fmaxf(m_[k], wave_max(sv)); const float p = valid ? __expf(sv - mn) : 0.f; const float corr = __expf(m_[k] - mn);
        l_[k] = l_[k] * corr + wave_sum(p); o_[k] *= corr; m_[k] = mn; ps[(w + 8 * k) * 64 + lane] = p;
    };
#pragma unroll
    for (int k = 0; k < RPW; ++k) { m_[k] = NEGF; l_[k] = 0.f; o_[k] = 0.f; }
    auto selp = [&](int j, int key) -> const float* {
        if (!SAMPLE) return a.out + O_PSEL + ((size_t)b * SEQ + j * 64 + key) * 512 + g * 64;
        if (j < 128) return a.in[3] + ((size_t)pt[b * NPAGES + (j >> 1)] * PAGE + (j & 1) * 64 + key) * 512 + g * 64;
        return key < 4 ? a.out + O_SSEL + ((size_t)b * 4 + key) * 512 + g * 64 : nullptr; };
    { const int j0 = ulist[0]; fetch([&](int key) -> const float* { return selp(j0, key); }, [&](int key) -> const float* { const float* p = selp(j0, key); return p ? p + 256 : nullptr; }, true, true); }
    for (int ui = 0; ui < nu; ++ui) {
        const int j = ulist[ui];
        __syncthreads();
        commit(true, true);
        __syncthreads();
        if (ui + 1 < nu) { const int jn = ulist[ui + 1]; fetch([&](int key) -> const float* { return selp(jn, key); }, [&](int key) -> const float* { const float* p = selp(jn, key); return p ? p + 256 : nullptr; }, true, true); }
        float sc[RPW]; score_rows(sc);
        const int kpos = j * 64 + lane;
#pragma unroll
        for (int k = 0; k < RPW; ++k) { const int tok = (w >> 2) + 2 * k, t = t0 + tok; const bool valid = selb[tok * 132 + j] != 0 && kpos <= t; online(k, sc[k] - slope * (float)(t - kpos), valid); }
        asm volatile("s_waitcnt lgkmcnt(0)" ::: "memory");
        pv_rows(ps, 64);
    }
#pragma unroll
    for (int k = 0; k < RPW; ++k) { const int grow = grow0 + (w >> 2) + 2 * k; accf[k] += sigmoidf_(bf2f(UA[(size_t)grow * UA_LD + ACOLS + 1 * 16 + h])) * o_[k] / fmaxf(l_[k], 1e-30f); }
#pragma unroll
    for (int k = 0; k < RPW; ++k) { m_[k] = NEGF; l_[k] = 0.f; o_[k] = 0.f; }
    const int kstart = SAMPLE ? PAST - WINDOW : (t0 - WINDOW > 0 ? t0 - WINDOW : 0), kend = t0 + TT - 1;
    auto winp = [&](int kb, int key) -> const float* { const int kpos = kb + key; if (kpos > kend) return nullptr;
        if (!SAMPLE) return (const float*)(a.ws + WS_KVW) + ((size_t)b * SEQ + kpos) * 512 + g * 64;
        const int i = kpos - (PAST - WINDOW); return i < 512 ? a.in[4] + ((size_t)b * 512 + i) * 512 + g * 64 : a.out + O_SWIN + ((size_t)b * 512 + 508 + (i - 512)) * 512 + g * 64; };
    fetch([&](int key) -> const float* { return winp(kstart, key); }, [&](int key) -> const float* { const float* p = winp(kstart, key); return p ? p + 256 : nullptr; }, true, true);
    for (int kb = kstart; kb <= kend; kb += 64) {
        __syncthreads();
        commit(true, true);
        __syncthreads();
        if (kb + 64 <= kend) { const int kn = kb + 64; fetch([&](int key) -> const float* { return winp(kn, key); }, [&](int key) -> const float* { const float* p = winp(kn, key); return p ? p + 256 : nullptr; }, true, true); }
        float sc[RPW]; score_rows(sc);
        const int kpos = kb + lane;
#pragma unroll
        for (int k = 0; k < RPW; ++k) { const int t = t0 + (w >> 2) + 2 * k; const int dist = t - kpos; const bool valid = kpos <= kend && dist >= 0 && dist <= WINDOW; online(k, sc[k] - slope * (float)dist, valid); }
        asm volatile("s_waitcnt lgkmcnt(0)" ::: "memory");
        pv_rows(ps, 64);
    }
    bf16* OB = (bf16*)(a.ws + WS_OAB) + (size_t)MPAD * 1024;
#pragma unroll
    for (int k = 0; k < RPW; ++k) { const int grow = grow0 + (w >> 2) + 2 * k;
        const float o = accf[k] + sigmoidf_(bf2f(UA[(size_t)grow * UA_LD + ACOLS + 2 * 16 + h])) * o_[k] / fmaxf(l_[k], 1e-30f);
        const float gb = bf2f(QG[(size_t)grow * 2048 + 1024 + h * 64 + lane]);
        OB[(size_t)grow * 1024 + h * 64 + lane] = f2bf(o * gb / (1.0f + __expf(-gb))); }
    __syncthreads();
}


typedef short s16x4 __attribute__((ext_vector_type(4)));
constexpr int KSTR = 144, VSTR = 192;
constexpr int AL_KB = 0, AL_VB = 2 * 64 * KSTR, AL_KC = AL_VB + 2 * 64 * VSTR, AL_VC = AL_KC + 128 * KSTR, AL_IMP = AL_VC + 128 * VSTR, AL_SELM = AL_IMP + 4 * 64 * 33 * 4, AL_END = AL_SELM + 512;
static_assert(AL_END < LDS_BYTES - 64, "attention LDS map");

template <int K> __device__ __forceinline__ float fmamk_lit(float a, float c) { float d; asm("v_fmamk_f32 %0, %1, %2, %3" : "=v"(d) : "v"(a), "n"(__builtin_bit_cast(int, (float)K)), "v"(c)); return d; }
#define SINIT1(S, I, OFF) S[I] = fmamk_lit<((I) & 3) + 8 * ((I) >> 2) + (OFF)>(sl, cb);
#define SINIT16(S, OFF) SINIT1(S, 0, OFF) SINIT1(S, 1, OFF) SINIT1(S, 2, OFF) SINIT1(S, 3, OFF) SINIT1(S, 4, OFF) SINIT1(S, 5, OFF) SINIT1(S, 6, OFF) SINIT1(S, 7, OFF) \
                        SINIT1(S, 8, OFF) SINIT1(S, 9, OFF) SINIT1(S, 10, OFF) SINIT1(S, 11, OFF) SINIT1(S, 12, OFF) SINIT1(S, 13, OFF) SINIT1(S, 14, OFF) SINIT1(S, 15, OFF)
__device__ __forceinline__ float max3f(float a, float b, float c) { float d; asm("v_max3_f32 %0, %1, %2, %3" : "=v"(d) : "v"(a), "v"(b), "v"(c)); return d; }
__device__ __forceinline__ bf16x8v pack8(const f32x16& p, int s) {
    u32x4 w; w.x = pk2bf(p[8 * s + 0], p[8 * s + 1]); w.y = pk2bf(p[8 * s + 2], p[8 * s + 3]); w.z = pk2bf(p[8 * s + 4], p[8 * s + 5]); w.w = pk2bf(p[8 * s + 6], p[8 * s + 7]);
    return __builtin_bit_cast(bf16x8v, w);
}
__device__ __forceinline__ bf16x8v pack8sum(const f32x16& p, int s, float& acc) {
    const bf16n2 one = __builtin_bit_cast(bf16n2, 0x3f803f80u);
    const f32n2 v0 = {p[8 * s + 0], p[8 * s + 1]}, v1 = {p[8 * s + 2], p[8 * s + 3]}, v2 = {p[8 * s + 4], p[8 * s + 5]}, v3 = {p[8 * s + 6], p[8 * s + 7]};
    const bf16n2 h0 = __builtin_convertvector(v0, bf16n2), h1 = __builtin_convertvector(v1, bf16n2), h2 = __builtin_convertvector(v2, bf16n2), h3 = __builtin_convertvector(v3, bf16n2);
    acc = __builtin_amdgcn_fdot2_f32_bf16(h0, one, acc, false); acc = __builtin_amdgcn_fdot2_f32_bf16(h1, one, acc, false);
    acc = __builtin_amdgcn_fdot2_f32_bf16(h2, one, acc, false); acc = __builtin_amdgcn_fdot2_f32_bf16(h3, one, acc, false);
    u32x4 w; w.x = __builtin_bit_cast(unsigned, h0); w.y = __builtin_bit_cast(unsigned, h1); w.z = __builtin_bit_cast(unsigned, h2); w.w = __builtin_bit_cast(unsigned, h3);
    return __builtin_bit_cast(bf16x8v, w);
}
__device__ __forceinline__ bf16x8v vfrag(const LAS unsigned char* vb, int krow, int d0, int lane) {
    const int hh = lane >> 5, q = (lane & 15) >> 2, p = lane & 3, db = d0 + ((lane >> 4) & 1) * 16 + 4 * p;
    const LAS unsigned char* ad = vb + (krow + 4 * hh + q) * VSTR + db * 2;
    const s16x4 lo = __builtin_amdgcn_ds_read_tr16_b64_v4i16((LAS s16x4*)ad);
    const s16x4 hi = __builtin_amdgcn_ds_read_tr16_b64_v4i16((LAS s16x4*)(ad + 8 * VSTR));
    return __builtin_shufflevector(lo, hi, 0, 1, 2, 3, 4, 5, 6, 7);
}

__device__ __forceinline__ void attn_mfma_item(const Args& a, int b, int g, int qt, LAS unsigned char* lds, int nxt  , LAS int* qnext, unsigned& tacc) {
    int tid_ = threadIdx.x; asm volatile("" : "+v"(tid_));
    const int tid = tid_, lane = tid & 63, w = __builtin_amdgcn_readfirstlane(tid >> 6);
    const int r = lane & 31, hh = lane >> 5, hr = w & 3, th = w >> 2, h = g * 4 + hr;
    const int tl = th * 32 + r, t = qt * 64 + tl, grow = b * SEQ + t;
    const float slope8 = 8.0f * exp2f(-0.5f * (float)(h + 1));
    constexpr float C1 = 0.125f * 1.4426950408889634f, NEGA = -1e30f, THR = 8.0f;
    const float sl = slope8 * C1;
    const bf16* QG = (const bf16*)(a.ws + WS_QG);
    const bf16* UA = (const bf16*)(a.ws + WS_UA);
    LAS unsigned char* KB = lds + AL_KB; LAS unsigned char* VB = lds + AL_VB; LAS unsigned char* KC = lds + AL_KC; LAS unsigned char* VC = lds + AL_VC;
    LAS float* IMP = (LAS float*)(lds + AL_IMP); LAS unsigned* SELM = (LAS unsigned*)(lds + AL_SELM);
    __syncthreads();
    bf16x8v qf[4];
#pragma unroll
    for (int s = 0; s < 4; ++s) qf[s] = *(const bf16x8v*)(QG + (size_t)grow * 2048 + h * 64 + 16 * s + 8 * hh);
    unsigned short glog[3];
#pragma unroll
    for (int x = 0; x < 3; ++x) glog[x] = UA[(size_t)grow * UA_LD + ACOLS + x * 16 + h];
    const int nkt = ((4 * qt + 2) >> 5) + 1;
    {
        const int n = tid >> 2, c16 = (tid & 3) * 16;
        const bf16* kc = (const bf16*)(a.ws + WS_KCP) + ((size_t)(b * 4 + g) * 128 + n) * 64 + c16;
        const bf16* vc = (const bf16*)(a.ws + WS_VCP) + ((size_t)(b * 4 + g) * 128 + n) * 64 + c16;
        u32x4 k0 = {0u, 0u, 0u, 0u}, k1 = k0, v0 = k0, v1 = k0;
        if (n < NCMP_P && n < 32 * nkt) { k0 = *(const u32x4*)kc; k1 = *(const u32x4*)(kc + 8); v0 = *(const u32x4*)vc; v1 = *(const u32x4*)(vc + 8); }
        *(LAS u32x4*)(KC + n * KSTR + c16 * 2) = k0; *(LAS u32x4*)(KC + n * KSTR + c16 * 2 + 16) = k1;
        *(LAS u32x4*)(VC + n * VSTR + c16 * 2) = v0; *(LAS u32x4*)(VC + n * VSTR + c16 * 2 + 16) = v1;
        if (tid < 64) SELM[tid] = 0u;
        if (tid == 64) SELM[64] = 0u;
    }
    __syncthreads();
    f32x16 fin[2];
    {
        f32x16 sc[4];
        const float cb = slope8 * (float)(31 - t + 64 * hh);
#pragma unroll
        for (int kt = 0; kt < 4; ++kt)
#pragma unroll
            for (int i = 0; i < 16; ++i) sc[kt][i] = slope8 * (float)(16 * (32 * kt + (i & 3) + 8 * (i >> 2))) + cb;
#pragma unroll
        for (int kt = 0; kt < 4; ++kt) if (kt < nkt) {
            bf16x8v kf[4];
#pragma unroll
            for (int s = 0; s < 4; ++s) kf[s] = *(const LAS bf16x8v*)(KC + (32 * kt + r) * KSTR + (16 * s + 8 * hh) * 2);
#pragma unroll
            for (int s = 0; s < 4; ++s) sc[kt] = __builtin_amdgcn_mfma_f32_32x32x16_bf16(kf[s], qf[s], sc[kt], 0, 0, 0);
        }
        float m = NEGA;
        const int nlim = (t - 31) >> 4;
#pragma unroll
        for (int kt = 0; kt < 4; ++kt) if (kt < nkt)
#pragma unroll
            for (int i = 0; i < 16; i += 2) { const int n = 32 * kt + (i & 3) + 8 * (i >> 2) + 4 * hh; const float v = (t >= 31 && n <= nlim) ? sc[kt][i] : NEGA, v2 = (t >= 31 && n + 1 <= nlim) ? sc[kt][i + 1] : NEGA;
                sc[kt][i] = v; sc[kt][i + 1] = v2; m = max3f(m, v, v2); }
        m = xhalf_max(m); m = fmaxf(m, -1e20f);
        const float nm = -m * C1; float l = 0.f;
#pragma unroll
        for (int kt = 0; kt < 4; ++kt) if (kt < nkt)
#pragma unroll
            for (int i = 0; i < 16; ++i) { const float p = __builtin_amdgcn_exp2f(fmaf(sc[kt][i], C1, nm)); sc[kt][i] = p; l += p; }
        l = xhalf_sum(l);
        const float inv = 1.0f / fmaxf(l, 1e-30f);
#pragma unroll
        for (int kt = 0; kt < 4; ++kt) if (kt < nkt)
#pragma unroll
            for (int i = 0; i < 16; ++i) sc[kt][i] *= inv;
        if (qt >= 16) {
            float av[16], cv[16];
#pragma unroll
            for (int kt = 0; kt < 4; ++kt)
#pragma unroll
                for (int q4 = 0; q4 < 4; ++q4) { const bool on = kt < nkt; av[kt * 4 + q4] = on ? sc[kt][4 * q4] + sc[kt][4 * q4 + 1] + sc[kt][4 * q4 + 2] + 0.5f * sc[kt][4 * q4 + 3] : 0.f; cv[kt * 4 + q4] = on ? 0.5f * sc[kt][4 * q4 + 3] : 0.f; }
            float cp[16];
#pragma unroll
            for (int x = 0; x < 16; ++x) cp[x] = xhalf_other(cv[x], hh != 0);
#pragma unroll
            for (int x = 0; x < 16; ++x) { const float prev = x > 0 ? cp[x - 1] : 0.f; IMP[(hr * 64 + tl) * 33 + 2 * x + hh] = av[x] + (hh ? cp[x] : prev); }
        }
        f32x16 oc[2];
#pragma unroll
        for (int i = 0; i < 16; ++i) { oc[0][i] = 0.f; oc[1][i] = 0.f; }
#pragma unroll
        for (int kt = 0; kt < 4; ++kt) if (kt < nkt)
#pragma unroll
            for (int s = 0; s < 2; ++s) { const bf16x8v pf = pack8(sc[kt], s);
#pragma unroll
                for (int dt = 0; dt < 2; ++dt) oc[dt] = __builtin_amdgcn_mfma_f32_32x32x16_bf16(vfrag(VC, 32 * kt + 16 * s, 32 * dt, lane), pf, oc[dt], 0, 0, 0); }
        const float g0 = sigmoidf_(bf2f(glog[0]));
#pragma unroll
        for (int i = 0; i < 16; ++i) { fin[0][i] = g0 * oc[0][i]; fin[1][i] = g0 * oc[1][i]; }
    }
    unsigned selmask, uni;
    if (qt < 16) { selmask = (2u << qt) - 1u; uni = selmask; }
    else {
        __syncthreads();
        LAS float* IMPT = (LAS float*)KC;
        const int tok = tid >> 3, jq = tid & 7;
#pragma unroll
        for (int jj = 0; jj < 4; ++jj) { const int j = jq * 4 + jj, back = qt - j;
            const float v = (IMP[(0 * 64 + tok) * 33 + j] + IMP[(1 * 64 + tok) * 33 + j]) + (IMP[(2 * 64 + tok) * 33 + j] + IMP[(3 * 64 + tok) * 33 + j]);
            IMPT[tok * 36 + j] = (j == 0 || (back >= 0 && back < 2)) ? 1e4f : (back >= 0 ? v : -1.0f); }
        __syncthreads();
        float sc[32];
#pragma unroll
        for (int x = 0; x < 8; ++x) { const f32x4 v = *(const LAS f32x4*)(IMPT + tok * 36 + 4 * x); sc[4 * x] = v.x; sc[4 * x + 1] = v.y; sc[4 * x + 2] = v.z; sc[4 * x + 3] = v.w; }
        const f32x4 mine = *(const LAS f32x4*)(IMPT + tok * 36 + 4 * jq);
        unsigned bits = 0u;
#pragma unroll
        for (int jj = 0; jj < 4; ++jj) {
            const int jme = jq * 4 + jj; const float sj = mine[jj]; int rank = 0;
#pragma unroll
            for (int j = 0; j < 32; ++j) rank += (sc[j] > sj || (sc[j] == sj && j < jme)) ? 1 : 0;
            if (rank < 16 && sj >= 0.f) bits |= 1u << jme;
        }
#define DPPU(x, ctrl) ((unsigned)__builtin_amdgcn_update_dpp(0, (int)(x), (ctrl), 0xf, 0xf, false))
        bits |= DPPU(bits, 0xB1); bits |= DPPU(bits, 0x4E); bits |= DPPU(bits, 0x141);
        if (jq == 0) SELM[tok] = bits;
        unsigned wu = bits | DPPU(bits, 0x140);
        { const auto r1 = __builtin_amdgcn_permlane16_swap(wu, wu, false, false); wu = r1[0] | r1[1]; const auto r2 = __builtin_amdgcn_permlane32_swap(wu, wu, false, false); wu = r2[0] | r2[1]; }
#undef DPPU
        if (lane == 0) atomicOr((unsigned*)(SELM + 64), wu);
        __syncthreads();
        selmask = SELM[tl]; uni = SELM[64];
    }
    const bf16* KVSB = (const bf16*)(a.ws + WS_KVSB) + (size_t)b * SEQ * 512 + g * 64;
    const bf16* KVWB = (const bf16*)(a.ws + WS_KVWB) + (size_t)b * SEQ * 512 + g * 64;
    const int skey = tid >> 3, sc8 = tid & 7;
    u32x4 rk, rv;
    if (tid == 0) *qnext = nxt;
    unsigned tword = 0u;
#pragma unroll 1
    for (int br = 1; br <= 2; ++br) {
        if (br == 2) {
            const int na = *qnext;
            if (na < BATCH * 4 * 32 && tid < 384) {
                const int nb_ = (na & 31) >> 2, ng = na & 3, nqt = 31 - (na >> 5);
                const bf16* tp = tid < 256 ? QG + (size_t)(nb_ * SEQ + nqt * 64 + (tid >> 2)) * 2048 + (ng * 4 + (tid & 3)) * 64
                                           : (const bf16*)(a.ws + WS_KVSB) + (size_t)(nb_ * SEQ + ((tid - 256) >> 1)) * 512 + ng * 64 + ((tid - 256) & 1) * 256;
                tword = *(const unsigned*)tp;
            }
        }
        const bf16* src = br == 1 ? KVSB : KVWB;
        unsigned tmask = br == 1 ? uni : (qt >= 8 ? (0x1ffu << (qt - 8)) : ((2u << qt) - 1u));
        f32x16 o[2];
#pragma unroll
        for (int i = 0; i < 16; ++i) { o[0][i] = 0.f; o[1][i] = 0.f; }
        float m = 0.f, l = 0.f;
        int j = __builtin_ctz(tmask); tmask &= tmask - 1u;
        const int jfirst = j;
        if (br == 1) { const bf16* p = src + (size_t)(j * 64 + skey) * 512 + sc8 * 8; rk = *(const u32x4*)p; rv = *(const u32x4*)(p + 256); }
        __syncthreads();
        *(LAS u32x4*)(KB + skey * KSTR + sc8 * 16) = rk; *(LAS u32x4*)(VB + skey * VSTR + sc8 * 16) = rv;
        __syncthreads();
        int buf = 0;
        for (;;) {
            const int jn = tmask ? __builtin_ctz(tmask) : -1; tmask &= tmask - 1u;
            if (jn >= 0) { const bf16* p = src + (size_t)(jn * 64 + skey) * 512 + sc8 * 8; rk = *(const u32x4*)p; rv = *(const u32x4*)(p + 256); }
            else if (br == 1) { const bf16* p = KVWB + (size_t)((qt >= 8 ? qt - 8 : 0) * 64 + skey) * 512 + sc8 * 8; rk = *(const u32x4*)p; rv = *(const u32x4*)(p + 256); }
            {
                const LAS unsigned char* kb = KB + buf * 64 * KSTR; const LAS unsigned char* vb = VB + buf * 64 * VSTR;
                f32x16 s0, s1;
                const bool diag = j == qt, ledge = br == 2 && j == qt - 8, unsel = br == 1 && ((selmask >> j) & 1u) == 0u;
                const float cb = unsel ? NEGA : fmaf(sl, (float)(j * 64 - t + 4 * hh), -m);
                bf16x8v kf0[4], kf1[4];
#pragma unroll
                for (int s = 0; s < 4; ++s) { kf0[s] = *(const LAS bf16x8v*)(kb + r * KSTR + (16 * s + 8 * hh) * 2); kf1[s] = *(const LAS bf16x8v*)(kb + (32 + r) * KSTR + (16 * s + 8 * hh) * 2); }
                asm volatile("" ::: "memory");
                SINIT16(s0, 0) SINIT16(s1, 32)
#pragma unroll
                for (int s = 0; s < 4; ++s) { s0 = __builtin_amdgcn_mfma_f32_32x32x16_bf16(kf0[s], qf[s], s0, 0, 0, 0); s1 = __builtin_amdgcn_mfma_f32_32x32x16_bf16(kf1[s], qf[s], s1, 0, 0, 0); }
                bf16x8v vf[2][2][2];
#pragma unroll
                for (int kh = 0; kh < 2; ++kh)
#pragma unroll
                    for (int s = 0; s < 2; ++s)
#pragma unroll
                        for (int dt = 0; dt < 2; ++dt) vf[kh][s][dt] = vfrag(vb, 32 * kh + 16 * s, 32 * dt, lane);
                asm volatile("" ::: "memory");
                if (diag || ledge) {
                    const int dbase = 64 * (qt - j) + tl - 4 * hh;
                    const unsigned dmax = br == 2 ? 512u : 0x7fffffffu;
#pragma unroll
                    for (int i = 0; i < 16; ++i) { const int kc = (i & 3) + 8 * (i >> 2);
                        s0[i] = (unsigned)(dbase - kc) <= dmax ? s0[i] : NEGA; s1[i] = (unsigned)(dbase - kc - 32) <= dmax ? s1[i] : NEGA; }
                }
                float mr = NEGA;
#pragma unroll
                for (int i = 0; i < 16; ++i) mr = max3f(mr, s0[i], s1[i]);
                const float gr = xhalf_max(mr);
                const bool mv = j == jfirst || gr > THR;
                if (__builtin_amdgcn_ballot_w64(mv) != 0ull) {
                    const float dm = mv ? gr : 0.f;
                    const float corr = __builtin_amdgcn_exp2f(fminf(-dm, 0.f));
                    m += dm; l *= corr;
#pragma unroll
                    for (int i = 0; i < 16; ++i) { s0[i] -= dm; s1[i] -= dm; o[0][i] *= corr; o[1][i] *= corr; }
                }
#pragma unroll
                for (int i = 0; i < 16; ++i) { s0[i] = __builtin_amdgcn_exp2f(s0[i]); s1[i] = __builtin_amdgcn_exp2f(s1[i]); }
#pragma unroll
                for (int s = 0; s < 2; ++s) {
                    const bf16x8v p0 = pack8sum(s0, s, l), p1 = pack8sum(s1, s, l);
#pragma unroll
                    for (int dt = 0; dt < 2; ++dt) { o[dt] = __builtin_amdgcn_mfma_f32_32x32x16_bf16(vf[0][s][dt], p0, o[dt], 0, 0, 0);
                        o[dt] = __builtin_amdgcn_mfma_f32_32x32x16_bf16(vf[1][s][dt], p1, o[dt], 0, 0, 0); }
                }
            }
            if (jn < 0) break;
            buf ^= 1;
            *(LAS u32x4*)(KB + buf * 64 * KSTR + skey * KSTR + sc8 * 16) = rk; *(LAS u32x4*)(VB + buf * 64 * VSTR + skey * VSTR + sc8 * 16) = rv;
            __syncthreads();
            j = jn;
        }
        l = xhalf_sum(l);
        const float gs = sigmoidf_(bf2f(br == 1 ? glog[1] : glog[2])) / fmaxf(l, 1e-30f);
#pragma unroll
        for (int i = 0; i < 16; ++i) { fin[0][i] += gs * o[0][i]; fin[1][i] += gs * o[1][i]; }
    }
    tacc ^= tword;
    {
        bf16* OB = (bf16*)(a.ws + WS_OAB) + (size_t)MPAD * 1024 + (size_t)grow * 1024 + h * 64;
        const bf16* GB = QG + (size_t)grow * 2048 + 1024 + h * 64;
#pragma unroll
        for (int dt = 0; dt < 2; ++dt)
#pragma unroll
            for (int q4 = 0; q4 < 4; ++q4) {
                const int d = 32 * dt + 8 * q4 + 4 * hh;
                const u32x2 gw = *(const u32x2*)(GB + d);
                const float g0 = __uint_as_float(gw.x << 16), g1 = __uint_as_float(gw.x & 0xffff0000u), g2 = __uint_as_float(gw.y << 16), g3 = __uint_as_float(gw.y & 0xffff0000u);
                const float y0 = fin[dt][4 * q4 + 0] * g0 / (1.0f + __expf(-g0)), y1 = fin[dt][4 * q4 + 1] * g1 / (1.0f + __expf(-g1));
                const float y2 = fin[dt][4 * q4 + 2] * g2 / (1.0f + __expf(-g2)), y3 = fin[dt][4 * q4 + 3] * g3 / (1.0f + __expf(-g3));
                u32x2 ww; ww.x = pg8::cvt_pk_bf16(y0, y1); ww.y = pg8::cvt_pk_bf16(y2, y3);
                *(u32x2*)(OB + d) = ww;
            }
    }
}


constexpr int SM_WSZ = 32 * KSTR + 32 * VSTR;
constexpr int SM_ML = 8 * SM_WSZ;
constexpr int SM_O = SM_ML + 1024;
constexpr int SM_IA = SM_O + 32768;
constexpr int SM_IC = SM_IA + 8448;
constexpr int SM_IMP = SM_IC + 8448;
constexpr int SM_SEL = SM_IMP + 2112;
constexpr int SM_UL = SM_SEL + 2112;
constexpr int SM_FIN = SM_UL + 544;
constexpr int SM_END = SM_FIN + 4096;
static_assert(SM_END <= LDS_BYTES - 64, "sample attention LDS map");

__device__ __forceinline__ void attn_sample_mfma(const Args& a, int b, int g, LAS unsigned char* lds) {
    int tid_ = threadIdx.x; asm volatile("" : "+v"(tid_));
    const int tid = tid_, lane = tid & 63, w = __builtin_amdgcn_readfirstlane(tid >> 6);
    const int r = lane & 31, hh = lane >> 5, c = r & 15, tok = c >> 2, hr = c & 3, h = g * 4 + hr;
    const int t = PAST + tok, grow = MP + b * 4 + tok;
    const bool real = r < 16;
    const float slope8 = 8.0f * exp2f(-0.5f * (float)(h + 1));
    constexpr float C1 = 0.125f * 1.4426950408889634f, NEGA = -1e30f;
    const bf16* QG = (const bf16*)(a.ws + WS_QG);
    const bf16* UA = (const bf16*)(a.ws + WS_UA);
    const int* pt = (const int*)a.in[7];
    LAS unsigned char* KB = lds + w * SM_WSZ; LAS unsigned char* VB = KB + 32 * KSTR;
    LAS float* ML = (LAS float*)(lds + SM_ML); LAS float* OB = (LAS float*)(lds + SM_O);
    LAS float* IA = (LAS float*)(lds + SM_IA); LAS float* IC = (LAS float*)(lds + SM_IC);
    LAS float* imp = (LAS float*)(lds + SM_IMP); LAS int* selb = (LAS int*)(lds + SM_SEL); LAS int* ulist = (LAS int*)(lds + SM_UL);
    LAS float* FIN = (LAS float*)(lds + SM_FIN);
    __syncthreads();
    bf16x8v qf[4];
#pragma unroll
    for (int s = 0; s < 4; ++s) qf[s] = *(const bf16x8v*)(QG + (size_t)grow * 2048 + h * 64 + 16 * s + 8 * hh);
    for (int i = tid; i < 16 * 64; i += 512) FIN[i] = 0.f;
    if (tid < 16) IC[tid * 132] = 0.f;
    f32x4 fk[8], fv[8];
    auto fetch = [&](const float* kp, const float* vp) {
        const int hf = lane & 1;
#pragma unroll
        for (int x = 0; x < 8; ++x) { fk[x] = (f32x4){0.f, 0.f, 0.f, 0.f}; fv[x] = fk[x]; }
        if (kp) {
#pragma unroll
            for (int x = 0; x < 8; ++x) fk[x] = *(const f32x4*)(kp + hf * 32 + 4 * x); }
        if (vp) {
#pragma unroll
            for (int x = 0; x < 8; ++x) fv[x] = *(const f32x4*)(vp + hf * 32 + 4 * x); }
    };
    auto commit = [&](bool wantK, bool wantV) {
        const int key = lane >> 1, hf = lane & 1;
        if (wantK) {
#pragma unroll
            for (int x = 0; x < 4; ++x) *(LAS u32x4*)(KB + key * KSTR + hf * 64 + x * 16) = (u32x4){pk2bf(fk[2 * x].x, fk[2 * x].y), pk2bf(fk[2 * x].z, fk[2 * x].w), pk2bf(fk[2 * x + 1].x, fk[2 * x + 1].y), pk2bf(fk[2 * x + 1].z, fk[2 * x + 1].w)}; }
        if (wantV) {
#pragma unroll
            for (int x = 0; x < 4; ++x) *(LAS u32x4*)(VB + key * VSTR + hf * 64 + x * 16) = (u32x4){pk2bf(fv[2 * x].x, fv[2 * x].y), pk2bf(fv[2 * x].z, fv[2 * x].w), pk2bf(fv[2 * x + 1].x, fv[2 * x + 1].y), pk2bf(fv[2 * x + 1].z, fv[2 * x + 1].w)}; }
    };
    auto scores = [&](f32x16& st, float cbase, float mul) {
#pragma unroll
        for (int i = 0; i < 16; ++i) st[i] = slope8 * (cbase + mul * (float)((i & 3) + 8 * (i >> 2) + 4 * hh));
#pragma unroll
        for (int s = 0; s < 4; ++s) { const bf16x8v kf = *(const LAS bf16x8v*)(KB + r * KSTR + (16 * s + 8 * hh) * 2); st = __builtin_amdgcn_mfma_f32_32x32x16_bf16(kf, qf[s], st, 0, 0, 0); }
    };
    auto pv = [&](const f32x16& p, f32x16 (&o)[2]) {
#pragma unroll
        for (int s = 0; s < 2; ++s) { const bf16x8v pf = pack8(p, s);
#pragma unroll
            for (int dt = 0; dt < 2; ++dt) o[dt] = __builtin_amdgcn_mfma_f32_32x32x16_bf16(vfrag(VB, 16 * s, 32 * dt, lane), pf, o[dt], 0, 0, 0); }
    };
    auto merge = [&](float m, float l, const f32x16 (&o)[2], int br, bool norm) {
        if (real && hh == 0) { ML[(w * 16 + c) * 2] = m; ML[(w * 16 + c) * 2 + 1] = l; }
        if (real) {
#pragma unroll
            for (int dt = 0; dt < 2; ++dt)
#pragma unroll
                for (int i = 0; i < 16; ++i) OB[(w * 16 + c) * 64 + 32 * dt + (i & 3) + 8 * (i >> 2) + 4 * hh] = o[dt][i];
        }
        __syncthreads();
        {
            const int cc = tid >> 5, d = (tid & 31) * 2;
            float M = NEGA;
#pragma unroll
            for (int ww = 0; ww < 8; ++ww) M = fmaxf(M, ML[(ww * 16 + cc) * 2]);
            float n0 = 0.f, n1 = 0.f, den = 0.f;
#pragma unroll
            for (int ww = 0; ww < 8; ++ww) { const float sc = norm ? __builtin_amdgcn_exp2f((ML[(ww * 16 + cc) * 2] - M) * C1) : 1.0f;
                n0 += sc * OB[(ww * 16 + cc) * 64 + d]; n1 += sc * OB[(ww * 16 + cc) * 64 + d + 1]; den += sc * ML[(ww * 16 + cc) * 2 + 1]; }
            const int tk = cc >> 2, hx = g * 4 + (cc & 3);
            const float gate = sigmoidf_(bf2f(UA[(size_t)(MP + b * 4 + tk) * UA_LD + ACOLS + br * 16 + hx])) / (norm ? fmaxf(den, 1e-30f) : 1.0f);
            FIN[cc * 64 + d] += gate * n0; FIN[cc * 64 + d + 1] += gate * n1;
        }
        __syncthreads();
    };
    f32x16 st0, st1;
    const float* KC = (const float*)(a.ws + WS_KCS) + (size_t)b * NCB_S * 256 + g * 64;
    const float* VC = (const float*)(a.ws + WS_VCS) + (size_t)b * NCB_S * 256 + g * 64;
    {
        const int key = lane >> 1;
        const int n0a = 32 * w, n0b = 32 * (w + 8);
        fetch(n0a + key < NCMP_S ? KC + (size_t)(n0a + key) * 256 : nullptr, nullptr); commit(true, false);
        fetch(n0b + key < NCMP_S ? KC + (size_t)(n0b + key) * 256 : nullptr, nullptr);
        scores(st0, (float)(16 * n0a + 31 - t), 16.0f);
        commit(true, false);
        fetch(nullptr, n0a + key < NCMP_S ? VC + (size_t)(n0a + key) * 256 : nullptr);
        scores(st1, (float)(16 * n0b + 31 - t), 16.0f);
        float m = NEGA;
#pragma unroll
        for (int i = 0; i < 16; ++i) { const int nn = (i & 3) + 8 * (i >> 2) + 4 * hh; if (n0a + nn >= NCMP_S) st0[i] = NEGA; if (n0b + nn >= NCMP_S) st1[i] = NEGA; m = fmaxf(m, fmaxf(st0[i], st1[i])); }
        m = xhalf_max(m);
        if (real && hh == 0) ML[(w * 16 + c) * 2] = m;
        __syncthreads();
        float M = NEGA;
#pragma unroll
        for (int ww = 0; ww < 8; ++ww) M = fmaxf(M, ML[(ww * 16 + c) * 2]);
        const float nm = -M * C1; float l = 0.f;
#pragma unroll
        for (int i = 0; i < 16; ++i) { st0[i] = __builtin_amdgcn_exp2f(fmaf(st0[i], C1, nm)); st1[i] = __builtin_amdgcn_exp2f(fmaf(st1[i], C1, nm)); l += st0[i] + st1[i]; }
        l = xhalf_sum(l);
        __syncthreads();
        if (real && hh == 0) ML[(w * 16 + c) * 2 + 1] = l;
        __syncthreads();
        float L = 0.f;
#pragma unroll
        for (int ww = 0; ww < 8; ++ww) L += ML[(ww * 16 + c) * 2 + 1];
        const float inv = 1.0f / fmaxf(L, 1e-30f);
#pragma unroll
        for (int i = 0; i < 16; ++i) { st0[i] *= inv; st1[i] *= inv; }
        if (real) {
#pragma unroll
            for (int q4 = 0; q4 < 4; ++q4) {
                const int Ja = 8 * w + 2 * q4 + hh, Jb = 8 * (w + 8) + 2 * q4 + hh;
                IA[c * 132 + Ja] = st0[4 * q4] + st0[4 * q4 + 1] + st0[4 * q4 + 2] + 0.5f * st0[4 * q4 + 3]; IC[c * 132 + Ja + 1] = 0.5f * st0[4 * q4 + 3];
                IA[c * 132 + Jb] = st1[4 * q4] + st1[4 * q4 + 1] + st1[4 * q4 + 2] + 0.5f * st1[4 * q4 + 3]; IC[c * 132 + Jb + 1] = 0.5f * st1[4 * q4 + 3];
            }
        }
        f32x16 oc[2];
#pragma unroll
        for (int i = 0; i < 16; ++i) { oc[0][i] = 0.f; oc[1][i] = 0.f; }
        commit(false, true);
        fetch(nullptr, n0b + key < NCMP_S ? VC + (size_t)(n0b + key) * 256 : nullptr);
        pv(st0, oc);
        commit(false, true);
        pv(st1, oc);
        merge(0.f, 0.f, oc, 0, false);
    }
    for (int idx = tid; idx < 4 * NSEL_S; idx += 512) {
        const int tk = idx / NSEL_S, j = idx % NSEL_S; float v = 0.f;
#pragma unroll
        for (int r4 = 0; r4 < 4; ++r4) { const int cc = tk * 4 + r4; v += (j < 128 ? IA[cc * 132 + j] : 0.f) + IC[cc * 132 + j]; }
        imp[tk * 132 + j] = v;
    }
    __syncthreads();
    for (int idx = tid; idx < 4 * NSEL_S; idx += 512) {
        const int tk = idx / NSEL_S, j = idx % NSEL_S, tb = (PAST + tk) >> 6;
        auto score = [&](int jj) -> float { const int back = tb - jj; const bool forced = jj == 0 || (back >= 0 && back < 2); return forced ? 1e4f : (back >= 0 ? imp[tk * 132 + jj] : -1.0f); };
        const float sj = score(j); int rank = 0;
        for (int jj = 0; jj < NSEL_S; ++jj) { const float s2 = score(jj); rank += (s2 > sj || (s2 == sj && jj < j)) ? 1 : 0; }
        selb[tk * 132 + j] = (rank < 16 && sj >= 0.f) ? 1 : 0;
    }
    __syncthreads();
    if (tid == 0) { int nu = 0; for (int j = 0; j < NSEL_S; ++j) { int any = 0; for (int tk = 0; tk < 4; ++tk) any |= selb[tk * 132 + j]; if (any) ulist[nu++] = j; } ulist[132] = nu; }
    __syncthreads();
    const int nu = ulist[132];
#pragma unroll 1
    for (int br = 1; br <= 2; ++br) {
        const int ntile = br == 1 ? 2 * nu : 17;
        f32x16 o[2];
#pragma unroll
        for (int i = 0; i < 16; ++i) { o[0][i] = 0.f; o[1][i] = 0.f; }
        float m = NEGA, l = 0.f;
        auto tile_ptr = [&](int ti, const float*& kp) -> int {
            const int key = lane >> 1;
            if (br == 1) { const int j = ulist[ti >> 1], kk = 32 * (ti & 1) + key;
                if (j < 128) kp = a.in[3] + ((size_t)pt[b * NPAGES + (j >> 1)] * PAGE + (j & 1) * 64 + kk) * 512 + g * 64;
                else kp = kk < 4 ? a.out + O_SSEL + ((size_t)b * 4 + kk) * 512 + g * 64 : nullptr;
                return 64 * j + 32 * (ti & 1); }
            const int i = 32 * ti + key;
            kp = i < 512 ? a.in[4] + ((size_t)b * 512 + i) * 512 + g * 64 : (i < 516 ? a.out + O_SWIN + ((size_t)b * 512 + 508 + (i - 512)) * 512 + g * 64 : nullptr);
            return PAST - WINDOW + 32 * ti;
        };
        int ti = w;
        const float* kp = nullptr; int kpos0 = 0;
        if (ti < ntile) { kpos0 = tile_ptr(ti, kp); fetch(kp, kp ? kp + 256 : nullptr); }
        while (ti < ntile) {
            commit(true, true);
            const int tin = ti + 8; const int kpos_c = kpos0; const int jcur = br == 1 ? ulist[ti >> 1] : 0;
            if (tin < ntile) { kpos0 = tile_ptr(tin, kp); fetch(kp, kp ? kp + 256 : nullptr); }
            f32x16 st;
            scores(st, (float)(kpos_c - t), 1.0f);
            const bool unsel = br == 1 && selb[tok * 132 + jcur] == 0;
            {
                const int dbase = unsel ? -100000 : t - kpos_c - 4 * hh;
                const unsigned dmax = br == 2 ? (unsigned)WINDOW : 0x7fffffffu;
#pragma unroll
                for (int i = 0; i < 16; ++i) st[i] = (unsigned)(dbase - ((i & 3) + 8 * (i >> 2))) <= dmax ? st[i] : NEGA;
            }
            float mr = NEGA;
#pragma unroll
            for (int i = 0; i < 16; ++i) mr = fmaxf(mr, st[i]);
            const float mx = fmaxf(m, xhalf_max(mr));
            const float nm = -fmaxf(mx, -1e20f) * C1, corr = __builtin_amdgcn_exp2f((m - mx) * C1);
            float ls = 0.f;
#pragma unroll
            for (int i = 0; i < 16; ++i) { st[i] = __builtin_amdgcn_exp2f(fmaf(st[i], C1, nm)); ls += st[i]; }
            l = l * corr + ls; m = mx;
#pragma unroll
            for (int i = 0; i < 16; ++i) { o[0][i] *= corr; o[1][i] *= corr; }
            pv(st, o);
            ti = tin;
        }
        l = xhalf_sum(l);
        merge(m, l, o, br, true);
    }
    {
        const int cc = tid >> 5, d = (tid & 31) * 2, tk = cc >> 2, hx = g * 4 + (cc & 3);
        const size_t row = (size_t)(MP + b * 4 + tk);
        const unsigned gw = *(const unsigned*)(QG + row * 2048 + 1024 + hx * 64 + d);
        const float g0 = __uint_as_float(gw << 16), g1 = __uint_as_float(gw & 0xffff0000u);
        const float y0 = FIN[cc * 64 + d] * g0 / (1.0f + __expf(-g0)), y1 = FIN[cc * 64 + d + 1] * g1 / (1.0f + __expf(-g1));
        *(unsigned*)((bf16*)(a.ws + WS_OAB) + (size_t)MPAD * 1024 + row * 1024 + hx * 64 + d) = pk2bf(y0, y1);
    }
    __syncthreads();
}

__device__ __forceinline__ void p4_post(const Args& a, int row_lo, int row_hi, int row_step) {
    const int tid = threadIdx.x, h = tid >> 5;
    const float* ORAW = (const float*)(a.ws + WS_ORAW); const float* PREP = (const float*)(a.ws + WS_PREP); const bf16* SG = (const bf16*)(a.ws + WS_SG); const float* BON = (const float*)(a.ws + WS_BONUS);
    bf16* OA = (bf16*)(a.ws + WS_OAB);
    const int c = (tid & 31) * 2, ch = h * 64 + c;
    const float gw0 = a.in[18][ch], gw1 = a.in[18][ch + 1], gb0 = a.in[19][ch], gb1 = a.in[19][ch + 1];
    for (int row0 = row_lo; row0 < row_hi; row0 += 8 * row_step) {
        float o0[8], o1[8], bon[8]; unsigned vw2[8], sgw[8];
#pragma unroll
        for (int u = 0; u < 8; ++u) { int row = row0 + u * row_step; row = row < row_hi ? row : row0;
            const f32n2 ov = *(const f32n2*)(ORAW + (size_t)row * 1024 + ch); o0[u] = ov.x; o1[u] = ov.y;
            bon[u] = BON[(size_t)row * 16 + h];
            vw2[u] = *(const unsigned*)((const bf16*)(a.ws + WS_VB) + (size_t)row * 1024 + ch);
            sgw[u] = *(const unsigned*)(SG + (size_t)row * 1024 + ch); }
#pragma unroll
        for (int u = 0; u < 8; ++u) { const int row = row0 + u * row_step;
            const float s = x16_sum(row16_allsum(o0[u] + o1[u]));
            const float mean = s * (1.0f / 64.0f), d0 = o0[u] - mean, d1 = o1[u] - mean;
            const float q = x16_sum(row16_allsum(d0 * d0 + d1 * d1));
            const float rstd = rsqrtf(q * (1.0f / 64.0f) + GN_EPS);
            const float y0 = (d0 * rstd * gw0 + gb0 + bon[u] * __uint_as_float(vw2[u] << 16)) * __uint_as_float(sgw[u] << 16), y1 = (d1 * rstd * gw1 + gb1 + bon[u] * __uint_as_float(vw2[u] & 0xffff0000u)) * __uint_as_float(sgw[u] & 0xffff0000u);
            if (row < row_hi) *(unsigned*)(OA + (size_t)row * 1024 + ch) = pk2bf(y0, y1); }
    }
}

struct Sched2 {
    int G, c;
    __device__ bool next(int i, pg8::Unit& u) const { const int p = (i >> 1) * G + c; if (p >= 65 * 8) return false; const int hf = i & 1; u.pm = (p >> 3) + hf * 65; u.pn = (p & 7) + hf * 8; return true; }
    __device__ __forceinline__ void a_ready(const pg8::Unit&) const {}
    __device__ __forceinline__ void done(const pg8::Unit&) const {}
};
struct EpiG2 {
    static constexpr bool PERM = true, AFTER_DRAIN = false;
    const bf16* GATES; bf16* MERGED;
    __device__ __forceinline__ void operator()(const pg8::f32x4 (&acc)[2][2][4][2], const pg8::Unit& u, int wr, int wc, int fr, int fq) const {
        const int hf = u.pm >= 65 ? 1 : 0, pm = u.pm - 65 * hf, pn = u.pn - 8 * hf;
        const int row0 = pm * 256 + wr * 64 + fr, cl0 = pn * 256 + wc * 32 + fq * 8;
#pragma unroll
        for (int ai = 0; ai < 2; ++ai)
#pragma unroll
            for (int m = 0; m < 4; ++m) {
                const int row = row0 + ai * 128 + m * 16;
#pragma unroll
                for (int bj = 0; bj < 2; ++bj) {
                    const int col = cl0 + bj * 128;
                    float gt[8], pv[8];
                    unpack8(*(const u32x4*)(GATES + (size_t)row * 4096 + hf * 2048 + col), gt);
                    const pg8::f32x4 v0 = acc[ai][bj][m][0], v1 = acc[ai][bj][m][1];
                    float r[8] = {gt[0] * v0[0], gt[1] * v0[1], gt[2] * v0[2], gt[3] * v0[3], gt[4] * v1[0], gt[5] * v1[1], gt[6] * v1[2], gt[7] * v1[3]};
                    bf16* d = MERGED + (size_t)row * 2048 + col;
                    if (hf) { unpack8(*(const u32x4*)d, pv);
#pragma unroll
                        for (int i = 0; i < 8; ++i) r[i] += pv[i]; }
                    u32x4 w; w.x = pg8::cvt_pk_bf16(r[0], r[1]); w.y = pg8::cvt_pk_bf16(r[2], r[3]); w.z = pg8::cvt_pk_bf16(r[4], r[5]); w.w = pg8::cvt_pk_bf16(r[6], r[7]);
                    *(u32x4*)d = w;
                }
            }
    }
};
struct EpiG3 {
    static constexpr bool PERM = true, AFTER_DRAIN = false;
    const float* xp; const float* xs; float* y; float* sumsq;
    __device__ __forceinline__ void operator()(const pg8::f32x4 (&acc)[2][2][4][2], const pg8::Unit& u, int wr, int wc, int fr, int fq) const {
        const int row0 = u.pm * 256 + wr * 64 + fr, cl0 = u.pn * 256 + wc * 32 + fq * 8;
#pragma unroll
        for (int ai = 0; ai < 2; ++ai)
#pragma unroll
            for (int m = 0; m < 4; ++m) {
                const int row = row0 + ai * 128 + m * 16;
                float ss = 0.f;
                if (row < MT) {
                    const float* xr = row < MP ? xp + (size_t)row * D : xs + (size_t)(row - MP) * D;
#pragma unroll
                    for (int bj = 0; bj < 2; ++bj) {
                        const int col = cl0 + bj * 128;
                        const pg8::f32x4 h0 = acc[ai][bj][m][0] + *(const pg8::f32x4*)(xr + col), h1 = acc[ai][bj][m][1] + *(const pg8::f32x4*)(xr + col + 4);
                        *(pg8::f32x4*)(y + (size_t)row * D + col) = h0; *(pg8::f32x4*)(y + (size_t)row * D + col + 4) = h1;
                        ss += h0[0] * h0[0] + h0[1] * h0[1] + h0[2] * h0[2] + h0[3] * h0[3] + h1[0] * h1[0] + h1[1] * h1[1] + h1[2] * h1[2] + h1[3] * h1[3];
                    }
                }
                ss = xhalf_sum(x16_sum(ss));
                if (fq == 0 && row < MT) sumsq[(size_t)row * 32 + u.pn * 4 + wc] = ss;
            }
    }
};

struct Sched2s {
    pg8::StaticOrder S;
    __device__ bool next(int i, pg8::Unit& u) const { if (!S.next(i, u)) return false; u.pm += 65 * (u.pn >> 3); return true; }
    __device__ __forceinline__ void a_ready(const pg8::Unit&) const {}
    __device__ __forceinline__ void done(const pg8::Unit&) const {}
};
struct EpiBf {
    static constexpr bool PERM = true, AFTER_DRAIN = false;
    bf16* O; int ld;
    __device__ __forceinline__ void operator()(const pg8::f32x4 (&acc)[2][2][4][2], const pg8::Unit& u, int wr, int wc, int fr, int fq) const {
        const int pm = u.pm >= 65 ? u.pm - 65 : u.pm;
        const int row0 = pm * 256 + wr * 64 + fr, cl0 = u.pn * 256 + wc * 32 + fq * 8;
#pragma unroll
        for (int ai = 0; ai < 2; ++ai)
#pragma unroll
            for (int m = 0; m < 4; ++m) {
                const int row = row0 + ai * 128 + m * 16;
#pragma unroll
                for (int bj = 0; bj < 2; ++bj) {
                    const pg8::f32x4 v0 = acc[ai][bj][m][0], v1 = acc[ai][bj][m][1];
                    u32x4 w; w.x = pg8::cvt_pk_bf16(v0[0], v0[1]); w.y = pg8::cvt_pk_bf16(v0[2], v0[3]); w.z = pg8::cvt_pk_bf16(v1[0], v1[1]); w.w = pg8::cvt_pk_bf16(v1[2], v1[3]);
                    *(u32x4*)(O + (size_t)row * ld + cl0 + bj * 128) = w;
                }
            }
    }
};
struct SchedOne {
    pg8::Unit u0;
    __device__ bool next(int i, pg8::Unit& u) const { if (i != 0) return false; u = u0; return true; }
    __device__ __forceinline__ void a_ready(const pg8::Unit&) const {}
    __device__ __forceinline__ void done(const pg8::Unit&) const {}
};
__device__ __forceinline__ void p5_merge(const Args& a, size_t i_lo, size_t i_hi, size_t i_step) {
    const bf16* G = (const bf16*)(a.ws + WS_GATES); const bf16* P = (const bf16*)(a.ws + WS_PAB); bf16* Mg = (bf16*)(a.ws + WS_MERGED);
    for (size_t i0 = i_lo + threadIdx.x; i0 < i_hi; i0 += 2 * i_step) {
        u32x4 rg[2][4];
#pragma unroll
        for (int u = 0; u < 2; ++u) { size_t i = i0 + u * i_step; i = i < i_hi ? i : i0; const size_t row = i >> 8; const int c = (int)(i & 255) * 8;
            rg[u][0] = *(const u32x4*)(G + row * 4096 + c); rg[u][1] = *(const u32x4*)(G + row * 4096 + 2048 + c); rg[u][2] = *(const u32x4*)(P + row * 4096 + c); rg[u][3] = *(const u32x4*)(P + row * 4096 + 2048 + c); }
#pragma unroll
        for (int u = 0; u < 2; ++u) { const size_t i = i0 + u * i_step; const size_t row = i >> 8; const int c = (int)(i & 255) * 8;
            float ga[8], gb[8], pa[8], pb[8];
            unpack8(rg[u][0], ga); unpack8(rg[u][1], gb); unpack8(rg[u][2], pa); unpack8(rg[u][3], pb);
#pragma unroll
            for (int e = 0; e < 8; ++e) {
                const float da = 1.0f + __expf(-fmaxf(ga[e], -40.0f)), db = 1.0f + __expf(-fmaxf(gb[e], -40.0f)), inv = 1.0f / (da * db);
                ga[e] = db * inv; gb[e] = da * inv; }
            u32x4 w; w.x = pk2bf(ga[0] * pa[0] + gb[0] * pb[0], ga[1] * pa[1] + gb[1] * pb[1]); w.y = pk2bf(ga[2] * pa[2] + gb[2] * pb[2], ga[3] * pa[3] + gb[3] * pb[3]);
            w.z = pk2bf(ga[4] * pa[4] + gb[4] * pb[4], ga[5] * pa[5] + gb[5] * pb[5]); w.w = pk2bf(ga[6] * pa[6] + gb[6] * pb[6], ga[7] * pa[7] + gb[7] * pb[7]);
            if (i < i_hi) *(u32x4*)(Mg + row * 2048 + c) = w; }
    }
}
__device__ __forceinline__ void p7_final(const Args& a) {
    const int tid = threadIdx.x, lane = tid & 63, wave = tid >> 6;
    const bf16* DL = (const bf16*)(a.ws + WS_DELTA); const float* gout = a.in[27];
    for (int row = blockIdx.x * 8 + wave; row < MT; row += gridDim.x * 8) {
        const float* x = row < MP ? a.in[0] + (size_t)row * D : a.in[1] + (size_t)(row - MP) * D;
        float h[32]; float ss = 0.f;
#pragma unroll
        for (int i = 0; i < 4; ++i) {
            const int c = i * 512 + lane * 8; float dl[8]; unpack8(*(const u32x4*)(DL + (size_t)row * D + c), dl);
            const f32x4 x0 = *(const f32x4*)(x + c), x1 = *(const f32x4*)(x + c + 4);
            h[8 * i + 0] = x0.x + dl[0]; h[8 * i + 1] = x0.y + dl[1]; h[8 * i + 2] = x0.z + dl[2]; h[8 * i + 3] = x0.w + dl[3];
            h[8 * i + 4] = x1.x + dl[4]; h[8 * i + 5] = x1.y + dl[5]; h[8 * i + 6] = x1.z + dl[6]; h[8 * i + 7] = x1.w + dl[7];
#pragma unroll
            for (int j = 0; j < 8; ++j) ss += h[8 * i + j] * h[8 * i + j];
        }
        ss = wave_sum(ss);
        const float rs = rsqrtf(ss * (1.0f / D) + RMS_EPS);
        float* y = a.out + (size_t)row * D;
#pragma unroll
        for (int i = 0; i < 4; ++i) {
            const int c = i * 512 + lane * 8; const f32x4 g0 = *(const f32x4*)(gout + c), g1 = *(const f32x4*)(gout + c + 4);
            *(f32x4*)(y + c) = (f32x4){h[8 * i + 0] * rs * g0.x, h[8 * i + 1] * rs * g0.y, h[8 * i + 2] * rs * g0.z, h[8 * i + 3] * rs * g0.w};
            *(f32x4*)(y + c + 4) = (f32x4){h[8 * i + 4] * rs * g1.x, h[8 * i + 5] * rs * g1.y, h[8 * i + 6] * rs * g1.z, h[8 * i + 7] * rs * g1.w};
        }
    }
}

__device__ __forceinline__ void p7_norm(const Args& a) {
    const int tid = threadIdx.x, lane = tid & 63, wave = tid >> 6;
    const float* sumsq = (const float*)(a.ws + WS_SUMSQ); const float* gout = a.in[27];
    for (int row = blockIdx.x * 8 + wave; row < MT; row += gridDim.x * 8) {
        float s = lane < 32 ? sumsq[(size_t)row * 32 + lane] : 0.f; s = wave_sum(s);
        const float rs = rsqrtf(s * (1.0f / D) + RMS_EPS);
        float* y = a.out + (size_t)row * D;
#pragma unroll
        for (int i = 0; i < 8; ++i) { f32x4 v = *(f32x4*)(y + i * 256 + lane * 4); const f32x4 gg = *(const f32x4*)(gout + i * 256 + lane * 4);
            v.x *= rs * gg.x; v.y *= rs * gg.y; v.z *= rs * gg.z; v.w *= rs * gg.w; *(f32x4*)(y + i * 256 + lane * 4) = v; }
    }
}

constexpr int N_PHASES = 12;
__global__ void __launch_bounds__(512, 2) fwd(Args a) {
    extern __shared__ __align__(16) unsigned char smem[];
    LAS unsigned char* lds = (LAS unsigned char*)smem;
    const int tid = threadIdx.x;
    volatile LAS unsigned* xbw = (volatile LAS unsigned*)(lds + LDS_BYTES - 16);
    LAS int* qitem = (LAS int*)(lds + LDS_BYTES - 32);
    if (tid < 4) xbw[tid] = 0u;
    __syncthreads();
    unsigned* ctl = (unsigned*)(a.ws + WS_CTL);
    const int lo = a.ph_lo, hi = a.ph_hi;
    XcdBarrier bar; bar.bar = ctl + CW_BAR; bar.x = 0; bar.st = xbw;
    if (hi - lo > 1) bar = xcd_barrier_post(ctl + CW_BAR, xbw);
#ifndef PH_MASK
#define PH_MASK 0xffff
#endif
#define IN(k) (((PH_MASK >> (k)) & 1) && lo <= (k) && (k) < hi)
#define SEAM(k) do { if (IN(k) && IN((k) + 1)) xcd_barrier(bar); } while (0)

    if (IN(0)) p0_prologue(a, lds);
    SEAM(0);
    if (IN(1)) {
        pg8::Gemm g{(const bf16*)(a.ws + WS_XN), (const bf16*)(a.ws + WS_WIN_T), MPAD, NIN, D};
        pg8::StaticOrder S; S.init(MPAD, NIN, (int)gridDim.x, (int)blockIdx.x);
        EpiG1 E{(bf16*)(a.ws + WS_UA), (bf16*)(a.ws + WS_QG), (float*)(a.ws + WS_KVW), (bf16*)(a.ws + WS_GATES), a.out, (bf16*)(a.ws + WS_KVSB), (bf16*)(a.ws + WS_KVWB)};
        pg8::gemm_phase<EpiG1, pg8::StaticOrder, false>(lds, g, S, E, nullptr);
    }
    SEAM(1);
    if (IN(2)) p2_pre(a);
    SEAM(2);
    if (IN(3)) {
        int cur_hp = -1;
        for (int it = blockIdx.x; it < 258 * 8; it += gridDim.x) { const int tt = it < 16 ? 256 + (it >> 3) : (it - 16) >> 3, hp = it & 7;
            if (hp != cur_hp) { __syncthreads(); prep_consts(a, hp, lds); cur_hp = hp; __syncthreads(); }
            prep_pair(a, tt, hp, lds); }
        __syncthreads();
        for (int it = blockIdx.x; it < BATCH * 32; it += gridDim.x) { const int b = it >> 5, n0 = (it & 31) * 4; const int cnt = (NCMP_P - n0) < 4 ? (NCMP_P - n0) : 4; compress_item<false>(a, b, n0, cnt, (LAS float*)lds); }
    }
    SEAM(3);
    if (IN(4)) {
        constexpr int N_CH = 2 * (BATCH * AH + DB * AH), N_PA = BATCH * 4 * 32, N_SA = DB * 4;
#ifndef P3_MASK
#define P3_MASK 7
#endif
        if ((P3_MASK & 1) && (a.p3mask & 1)) {
            if (gridDim.x >= 2 * BATCH * AH) {
                const int cp = (blockIdx.x >> 5) * 8 + (blockIdx.x & 7);
                if ((blockIdx.x & 24) == 0 && cp < BATCH * AH / 2) { const int ca = 2 * cp, cbn = 2 * cp + 1;
                    chain_seq(a.ws + WS_CHUNK + (size_t)ca * 128 * CK_BYTES, a.ws + WS_CHUNK + (size_t)cbn * 128 * CK_BYTES, SEQ / 16, a.out + O_PRWKV + (size_t)ca * 4096, a.out + O_PRWKV + (size_t)cbn * 4096,
                              (float*)(a.ws + WS_ORAW) + (size_t)(ca >> 4) * SEQ * 1024 + (ca & 15) * 64, (float*)(a.ws + WS_ORAW) + (size_t)(cbn >> 4) * SEQ * 1024 + (cbn & 15) * 64, lds); }
            } else {
                for (int cp = blockIdx.x; cp < BATCH * AH / 2; cp += gridDim.x) { const int ca = 2 * cp, cbn = 2 * cp + 1;
                    chain_seq(a.ws + WS_CHUNK + (size_t)ca * 128 * CK_BYTES, a.ws + WS_CHUNK + (size_t)cbn * 128 * CK_BYTES, SEQ / 16, a.out + O_PRWKV + (size_t)ca * 4096, a.out + O_PRWKV + (size_t)cbn * 4096,
                              (float*)(a.ws + WS_ORAW) + (size_t)(ca >> 4) * SEQ * 1024 + (ca & 15) * 64, (float*)(a.ws + WS_ORAW) + (size_t)(cbn >> 4) * SEQ * 1024 + (cbn & 15) * 64, lds); }
            }
            for (;;) {
                __syncthreads();
                if (tid == 0) *qitem = (int)atomicAdd(ctl + CW_QUEUE, 1u);
                __syncthreads();
                const int it = *qitem;
                if (it >= 2 * DB * AH) break;
                const int hf = it & 1, ci = it >> 1, b = ci >> 4, h = ci & 15, row0 = MP + b * 4;
                scan_half<4>((const float*)(a.ws + WS_PREP) + ((size_t)row0 * 16 + h) * 384, DS, a.in[5] + (size_t)ci * 4096, a.out + O_SRWKV + (size_t)ci * 4096, (float*)(a.ws + WS_ORAW) + (size_t)row0 * 1024 + h * 64, hf, (LAS float*)lds);
            }
        }
        if ((P3_MASK & 4) && (a.p3mask & 4)) for (;;) {
            __syncthreads();
            if (tid == 0) *qitem = (int)atomicAdd(ctl + CW_QUEUE + 128, 1u);
            __syncthreads();
            const int ai = *qitem;
            if (ai >= N_SA) break;
            attn_sample_mfma(a, ai >> 2, ai & 3, lds);
        }
        if ((P3_MASK & 2) && (a.p3mask & 2)) {
            __syncthreads();
            if (tid == 0) *qitem = (int)atomicAdd(ctl + CW_QUEUE + 64, 1u);
            __syncthreads();
            int ai = *qitem; unsigned tacc = 0u;
            LAS int* qnext = (LAS int*)(lds + LDS_BYTES - 48);
            while (ai < N_PA) {
                int nxt = 0;
                if (tid == 0) nxt = (int)atomicAdd(ctl + CW_QUEUE + 64, 1u);
                attn_mfma_item(a, (ai & 31) >> 2, ai & 3, 31 - (ai >> 5), lds, nxt, qnext, tacc);
                __syncthreads();
                ai = *qnext;
            }
            if (tacc == 0x9e3779b9u && c_never(tid)) ctl[CW_QUEUE + 320] = tacc;
        }
    }
    SEAM(4);
    const int nsp2 = gridDim.x >= 64 ? 16 : 0, nsp3 = gridDim.x >= 64 ? 8 : 0;
    if (IN(5)) p4_post(a, MP + (int)blockIdx.x, MT, (int)gridDim.x);
    SEAM(5);
    if (IN(6)) {
        if ((int)blockIdx.x < nsp2) {
            const int hf = blockIdx.x >> 3, pn = blockIdx.x & 7;
            pg8::Gemm g{(const bf16*)(a.ws + WS_OAB), (const bf16*)(a.ws + WS_WPAB_T), 2 * MPAD, 4096, 1024};
            SchedOne S{{64 + 65 * hf, pn + 8 * hf}};
            EpiBf E{(bf16*)(a.ws + WS_PAB), 4096};
            pg8::gemm_phase<EpiBf, SchedOne, false>(lds, g, S, E, nullptr);
        } else p4_post(a, (int)blockIdx.x - nsp2, MP, (int)gridDim.x - nsp2);
    }
    SEAM(6);
    if (IN(7)) {
        pg8::Gemm g{(const bf16*)(a.ws + WS_OAB), (const bf16*)(a.ws + WS_WPAB_T), 2 * MPAD, 4096, 1024};
        Sched2s S; S.S.init(nsp2 ? MP : MPAD, 4096, (int)gridDim.x, (int)blockIdx.x);
        EpiBf E{(bf16*)(a.ws + WS_PAB), 4096};
        pg8::gemm_phase<EpiBf, Sched2s, false>(lds, g, S, E, nullptr);
        if (nsp2) p5_merge(a, (size_t)MP * 256 + (size_t)blockIdx.x * 512, (size_t)MPAD * 256, (size_t)gridDim.x * 512);
    }
    SEAM(7);
    if (IN(8) && !nsp2) p5_merge(a, (size_t)MP * 256 + (size_t)blockIdx.x * 512, (size_t)MPAD * 256, (size_t)gridDim.x * 512);
    if (!nsp2) SEAM(8);
    if (IN(9)) {
        if ((int)blockIdx.x < nsp3) {
            pg8::Gemm g{(const bf16*)(a.ws + WS_MERGED), (const bf16*)(a.ws + WS_WO_T), MPAD, D, D};
            SchedOne S{{64, (int)blockIdx.x}};
            EpiBf E{(bf16*)(a.ws + WS_DELTA), D};
            pg8::gemm_phase<EpiBf, SchedOne, false>(lds, g, S, E, nullptr);
        } else p5_merge(a, (size_t)((int)blockIdx.x - nsp3) * 512, (size_t)MP * 256, (size_t)((int)gridDim.x - nsp3) * 512);
    }
    SEAM(9);
    if (IN(10)) {
        pg8::Gemm g{(const bf16*)(a.ws + WS_MERGED), (const bf16*)(a.ws + WS_WO_T), MPAD, D, D};
        pg8::StaticOrder S; S.init(nsp3 ? MP : MPAD, D, (int)gridDim.x, (int)blockIdx.x);
        EpiBf E{(bf16*)(a.ws + WS_DELTA), D};
        pg8::gemm_phase<EpiBf, pg8::StaticOrder, false>(lds, g, S, E, nullptr);
    }
    SEAM(10);
    if (IN(11)) p7_final(a);
#undef IN
#undef SEAM
}

#ifndef MK_ONE_LAUNCH
#define MK_ONE_LAUNCH 1
#endif
extern "C" void kernel_launch(void* const* d_in, const int* in_sizes, int n_in, void* d_out, int out_size, void* d_ws, size_t ws_size, hipStream_t stream) {
    static int grid = 0;
    if (grid == 0) {
        int dev = 0, cus = 0;
        if (n_in != 28 || (size_t)out_size != O_END || ws_size < WS_END) { fprintf(stderr, "kernel_launch: unexpected shapes (n_in %d out %d ws %zu, need %zu)\n", n_in, out_size, ws_size, (size_t)WS_END); grid = -1; return; }
        if (hipGetDevice(&dev) != hipSuccess || hipDeviceGetAttribute(&cus, hipDeviceAttributeMultiprocessorCount, dev) != hipSuccess) { grid = -1; return; }
        if (hipFuncSetAttribute((const void*)fwd, hipFuncAttributeMaxDynamicSharedMemorySize, LDS_BYTES) != hipSuccess) { fprintf(stderr, "kernel_launch: hipFuncSetAttribute failed\n"); grid = -1; return; }
        int per_cu = 0;
        if (hipOccupancyMaxActiveBlocksPerMultiprocessor(&per_cu, (const void*)fwd, 512, LDS_BYTES) != hipSuccess || per_cu < 1) fprintf(stderr, "kernel_launch: occupancy query says %d\n", per_cu);
        (void)hipGetLastError();
        grid = cus;
    }
    if (grid < 0) return;
    (void)hipMemsetAsync((char*)d_ws + WS_CTL, 0, CTL_BYTES, stream);
    Args a{};
    for (int i = 0; i < 28; ++i) a.in[i] = (const float*)d_in[i];
    a.out = (float*)d_out; a.ws = (unsigned char*)d_ws;
#if MK_ONE_LAUNCH
    a.ph_lo = 0; a.ph_hi = N_PHASES; a.p3mask = 7;
    hipLaunchKernelGGL(fwd, dim3(grid), dim3(512), LDS_BYTES, stream, a);
#ifdef PROBE_PHASE
    (void)hipMemsetAsync((char*)d_ws + WS_CTL, 0, CTL_BYTES, stream);
#ifdef PROBE_P3MASK
    a.p3mask = PROBE_P3MASK;
#endif
    a.ph_lo = PROBE_PHASE; a.ph_hi = PROBE_PHASE + 1;
    hipLaunchKernelGGL(fwd, dim3(grid), dim3(512), LDS_BYTES, stream, a);
#endif
#else
    a.p3mask = 7; for (int p = 0; p < N_PHASES; ++p) { a.ph_lo = p; a.ph_hi = p + 1; hipLaunchKernelGGL(fwd, dim3(grid), dim3(512), LDS_BYTES, stream, a); }
#endif
}
```
